# Optimizing an MI355X kernel written in HIP

```python
import math
import jax, jax.numpy as jnp
from jax import lax
import numpy as np

D_MODEL = 1024
BATCH = 16
SEQ = 4096
DEPTH = 4

N_MIXERS = 3
D_FF = 4 * D_MODEL
RMS_EPS = 1e-6
Q_BLOCK = 128

N_BUCKETS = 32
MAX_DISTANCE = 128
N_BIAS_HEADS = 16

A_HEADS = 16
A_HEAD_DIM = 64
IDX_HEADS = 8
IDX_DIM = 64
TOPK_MAX = 256
A_IN = A_HEADS * A_HEAD_DIM + 2 * A_HEAD_DIM + IDX_HEADS * IDX_DIM + IDX_DIM + IDX_HEADS

B_HEADS = 16
B_KV_HEADS = 4
B_HEAD_DIM = 64
WINDOW = 128
B_IN = (B_HEADS + 2 * B_KV_HEADS) * B_HEAD_DIM

C_HEADS = 16
C_Q_RANK = 256
C_KV_RANK = 128
C_NOPE = 64
C_ROPE = 32
C_V = 64
C_QK = C_NOPE + C_ROPE
C_IN = C_Q_RANK + C_KV_RANK + C_ROPE
ROPE_THETA = 10000.0

N_A = (DEPTH + 2) // 3
N_B = (DEPTH + 1) // 3
N_C = DEPTH // 3

kernel_name = "hybrid_dsa_swa_mla_trunk"


def rms_norm(x, g):
    xf = x.astype(jnp.float32)
    y = xf * lax.rsqrt(jnp.mean(xf * xf, axis=-1, keepdims=True) + RMS_EPS)
    return (y * g.astype(jnp.float32)).astype(x.dtype)


def split_cols(t, sizes):
    return jnp.split(t, np.cumsum(sizes)[:-1].tolist(), axis=-1)


def t5_bucket(rel):
    n = jnp.maximum(rel, 0)
    max_exact = N_BUCKETS // 2
    nf = jnp.maximum(n, 1).astype(jnp.float32)
    large = max_exact + (jnp.log(nf / max_exact) / math.log(MAX_DISTANCE / max_exact)
                         * (N_BUCKETS - max_exact)).astype(jnp.int32)
    large = jnp.minimum(large, N_BUCKETS - 1)
    return jnp.where(n < max_exact, n, large)


def to_blocks(t, nb):
    return jnp.moveaxis(t.reshape(t.shape[0], nb, Q_BLOCK, *t.shape[2:]), 1, 0)


def from_blocks(t):
    t = jnp.moveaxis(t, 0, 1)
    return t.reshape(t.shape[0], t.shape[1] * t.shape[2], *t.shape[3:])


def dsa_mixer(h, w_in, q_gain, k_gain, w_out, rel_bias):
    B, L, _ = h.shape
    nb = L // Q_BLOCK
    k_sel = min(TOPK_MAX, L // 4)
    q, k, v, q_idx, k_idx, w_idx = split_cols(
        h @ w_in, [A_HEADS * A_HEAD_DIM, A_HEAD_DIM, A_HEAD_DIM, IDX_HEADS * IDX_DIM, IDX_DIM, IDX_HEADS])
    q = rms_norm(q.reshape(B, L, A_HEADS, A_HEAD_DIM), q_gain)
    k = rms_norm(k, k_gain)
    q_idx = q_idx.reshape(B, L, IDX_HEADS, IDX_DIM)
    w_idx = w_idx * IDX_HEADS ** -0.5
    key_pos = jnp.arange(L, dtype=jnp.int32)
    q_pos = key_pos.reshape(nb, Q_BLOCK)
    scale = A_HEAD_DIM ** -0.5

    def block(args):
        qb, qib, wb, pos = args
        s_idx = jnp.einsum('bqhd,bsd->bqhs', qib, k_idx) * IDX_DIM ** -0.5
        score = jnp.einsum('bqh,bqhs->bqs', wb, jax.nn.relu(s_idx)).astype(jnp.float32)
        admissible = key_pos[None, :] <= pos[:, None]
        score = jnp.where(admissible[None], score, -jnp.inf)
        _, sel = lax.top_k(score, k_sel)
        kg = jax.vmap(lambda kk, ii: kk[ii])(k, sel)
        vg = jax.vmap(lambda vv, ii: vv[ii])(v, sel)
        rel = pos[None, :, None] - sel
        bias = jnp.moveaxis(rel_bias[t5_bucket(rel)], -1, 1)
        logits = jnp.einsum('bqhd,bqjd->bhqj', qb, kg).astype(jnp.float32) * scale + bias
        logits = jnp.where((rel >= 0)[:, None], logits, -jnp.inf)
        p = jax.nn.softmax(logits, axis=-1).astype(vg.dtype)
        return jnp.einsum('bhqj,bqjd->bqhd', p, vg)

    out = lax.map(block, (to_blocks(q, nb), to_blocks(q_idx, nb), to_blocks(w_idx, nb), q_pos))
    return from_blocks(out).reshape(B, L, A_HEADS * A_HEAD_DIM) @ w_out


def swa_mixer(h, w_in, q_gain, k_gain, sinks, w_out, rel_bias):
    B, L, _ = h.shape
    nb = L // WINDOW
    group = B_HEADS // B_KV_HEADS
    q, k, v = split_cols(h @ w_in, [B_HEADS * B_HEAD_DIM, B_KV_HEADS * B_HEAD_DIM, B_KV_HEADS * B_HEAD_DIM])
    q = rms_norm(q.reshape(B, L, B_HEADS, B_HEAD_DIM), q_gain).reshape(B, L, B_KV_HEADS, group, B_HEAD_DIM)
    k = rms_norm(k.reshape(B, L, B_KV_HEADS, B_HEAD_DIM), k_gain)
    v = v.reshape(B, L, B_KV_HEADS, B_HEAD_DIM)

    def band(t):
        tb = t.reshape(B, nb, WINDOW, B_KV_HEADS, B_HEAD_DIM)
        prev = jnp.pad(tb[:, :-1], ((0, 0), (1, 0), (0, 0), (0, 0), (0, 0)))
        return jnp.moveaxis(jnp.concatenate([prev, tb], axis=2), 1, 0)

    kb, vb = band(k), band(v)
    qi = jnp.arange(WINDOW, dtype=jnp.int32)[:, None] + WINDOW
    kj = jnp.arange(2 * WINDOW, dtype=jnp.int32)[None, :]
    rel = qi - kj
    in_band = (rel >= 0) & (rel < WINDOW)
    bias = jnp.transpose(rel_bias[t5_bucket(rel)], (2, 0, 1)).reshape(B_KV_HEADS, group, WINDOW, 2 * WINDOW)
    sink = sinks.astype(jnp.float32).reshape(B_KV_HEADS, group, 1, 1)
    scale = B_HEAD_DIM ** -0.5

    def block(args):
        qb, kbb, vbb, n = args
        logits = jnp.einsum('bqkgd,bjkd->bkgqj', qb, kbb).astype(jnp.float32) * scale + bias
        ok = in_band & ((n > 0) | (kj >= WINDOW))
        logits = jnp.where(ok, logits, -jnp.inf)
        m = jnp.maximum(jnp.max(logits, axis=-1, keepdims=True), sink)
        e = jnp.exp(logits - m)
        p = e / (jnp.sum(e, axis=-1, keepdims=True) + jnp.exp(sink - m))
        return jnp.einsum('bkgqj,bjkd->bqkgd', p.astype(vbb.dtype), vbb)

    out = lax.map(block, (to_blocks(q, nb), kb, vb, jnp.arange(nb, dtype=jnp.int32)))
    return from_blocks(out).reshape(B, L, B_HEADS * B_HEAD_DIM) @ w_out


def apply_rope(t, cos, sin):
    t1, t2 = jnp.split(t, 2, axis=-1)
    return jnp.concatenate([t1 * cos - t2 * sin, t2 * cos + t1 * sin], axis=-1).astype(t.dtype)


def mla_mixer(h, positions, w_in, q_a_gain, w_q_b, kv_a_gain, w_kv_b, q_gain, k_gain, w_out):
    B, L, _ = h.shape
    nb = L // Q_BLOCK
    q_lat, kv_lat, k_rope = split_cols(h @ w_in, [C_Q_RANK, C_KV_RANK, C_ROPE])
    q = (rms_norm(q_lat, q_a_gain) @ w_q_b).reshape(B, L, C_HEADS, C_QK)
    kv = (rms_norm(kv_lat, kv_a_gain) @ w_kv_b).reshape(B, L, C_HEADS, C_NOPE + C_V)
    k_nope, v = split_cols(kv, [C_NOPE, C_V])
    k = jnp.concatenate([k_nope, jnp.broadcast_to(k_rope[:, :, None, :], (B, L, C_HEADS, C_ROPE))], axis=-1)
    q = rms_norm(q, q_gain)
    k = rms_norm(k, k_gain)
    inv_freq = ROPE_THETA ** (-jnp.arange(0, C_ROPE, 2, dtype=jnp.float32) / C_ROPE)
    ang = positions.astype(jnp.float32)[..., None] * inv_freq
    cos, sin = jnp.cos(ang)[:, :, None, :], jnp.sin(ang)[:, :, None, :]
    q = jnp.concatenate([q[..., :C_NOPE], apply_rope(q[..., C_NOPE:], cos, sin)], axis=-1)
    k = jnp.concatenate([k[..., :C_NOPE], apply_rope(k[..., C_NOPE:], cos, sin)], axis=-1)
    key_pos = jnp.arange(L, dtype=jnp.int32)
    scale = C_QK ** -0.5

    def block(args):
        qb, pos = args
        logits = jnp.einsum('bqhd,bshd->bhqs', qb, k).astype(jnp.float32) * scale
        logits = jnp.where(key_pos[None, :] <= pos[:, None], logits, -jnp.inf)
        p = jax.nn.softmax(logits, axis=-1).astype(v.dtype)
        return jnp.einsum('bhqs,bshd->bqhd', p, v)

    out = lax.map(block, (to_blocks(q, nb), key_pos.reshape(nb, Q_BLOCK)))
    return from_blocks(out).reshape(B, L, C_HEADS * C_V) @ w_out


def sqrelu_mlp(h, w_up, w_down):
    return jnp.square(jax.nn.relu(h @ w_up)) @ w_down


def setup_inputs(seed: int = 0) -> dict:
    key = jax.random.key(seed)
    ks = jax.random.split(key, 24)
    f32 = jnp.float32

    def w(k, shape, fan_in):
        return jax.random.normal(k, shape, f32) * fan_in ** -0.5

    def gain(k, shape):
        return 1.0 + 0.02 * jax.random.normal(k, shape, f32)

    x = jax.random.normal(ks[0], (BATCH, SEQ, D_MODEL), f32)
    start = jax.random.randint(ks[1], (BATCH, 1), 0, 1024, dtype=jnp.int32)
    positions = start + jnp.arange(SEQ, dtype=jnp.int32)[None, :]
    return {
        'x': x,
        'positions': positions,
        'rel_bias': 0.5 * jax.random.normal(ks[2], (N_BUCKETS, N_BIAS_HEADS), f32),
        'norm_mix': gain(ks[3], (DEPTH, D_MODEL)),
        'norm_mlp': gain(ks[4], (DEPTH, D_MODEL)),
        'w_up': w(ks[5], (DEPTH, D_MODEL, D_FF), D_MODEL),
        'w_down': w(ks[6], (DEPTH, D_FF, D_MODEL), D_FF),
        'a_w_in': w(ks[7], (N_A, D_MODEL, A_IN), D_MODEL),
        'a_q_gain': gain(ks[8], (N_A, A_HEAD_DIM)),
        'a_k_gain': gain(ks[9], (N_A, A_HEAD_DIM)),
        'a_w_out': w(ks[10], (N_A, A_HEADS * A_HEAD_DIM, D_MODEL), A_HEADS * A_HEAD_DIM),
        'b_w_in': w(ks[11], (N_B, D_MODEL, B_IN), D_MODEL),
        'b_q_gain': gain(ks[12], (N_B, B_HEAD_DIM)),
        'b_k_gain': gain(ks[13], (N_B, B_HEAD_DIM)),
        'b_sinks': jax.random.normal(ks[14], (N_B, B_HEADS), f32),
        'b_w_out': w(ks[15], (N_B, B_HEADS * B_HEAD_DIM, D_MODEL), B_HEADS * B_HEAD_DIM),
        'c_w_in': w(ks[16], (N_C, D_MODEL, C_IN), D_MODEL),
        'c_q_a_gain': gain(ks[17], (N_C, C_Q_RANK)),
        'c_w_q_b': w(ks[18], (N_C, C_Q_RANK, C_HEADS * C_QK), C_Q_RANK),
        'c_kv_a_gain': gain(ks[19], (N_C, C_KV_RANK)),
        'c_w_kv_b': w(ks[20], (N_C, C_KV_RANK, C_HEADS * (C_NOPE + C_V)), C_KV_RANK),
        'c_q_gain': gain(ks[21], (N_C, C_QK)),
        'c_k_gain': gain(ks[22], (N_C, C_QK)),
        'c_w_out': w(ks[23], (N_C, C_HEADS * C_V, D_MODEL), C_HEADS * C_V),
    }


def reference(x, positions, rel_bias, norm_mix, norm_mlp, w_up, w_down,
              a_w_in, a_q_gain, a_k_gain, a_w_out,
              b_w_in, b_q_gain, b_k_gain, b_sinks, b_w_out,
              c_w_in, c_q_a_gain, c_w_q_b, c_kv_a_gain, c_w_kv_b, c_q_gain, c_k_gain, c_w_out):
    ia = ib = ic = 0
    for i in range(DEPTH):
        h = rms_norm(x, norm_mix[i])
        kind = i % N_MIXERS
        if kind == 0:
            y = dsa_mixer(h, a_w_in[ia], a_q_gain[ia], a_k_gain[ia], a_w_out[ia], rel_bias)
            ia += 1
        elif kind == 1:
            y = swa_mixer(h, b_w_in[ib], b_q_gain[ib], b_k_gain[ib], b_sinks[ib], b_w_out[ib], rel_bias)
            ib += 1
        else:
            y = mla_mixer(h, positions, c_w_in[ic], c_q_a_gain[ic], c_w_q_b[ic], c_kv_a_gain[ic],
                          c_w_kv_b[ic], c_q_gain[ic], c_k_gain[ic], c_w_out[ic])
            ic += 1
        x = x + y
        x = x + sqrelu_mlp(rms_norm(x, norm_mlp[i]), w_up[i], w_down[i])
    return x
```

```cpp
#include <hip/hip_runtime.h>
#include <cstdio>
#include <cstdint>

namespace xl {
template <int CTRL> __device__ __forceinline__ unsigned dppu(unsigned v) { return (unsigned)__builtin_amdgcn_update_dpp(0, (int)v, CTRL, 0xf, 0xf, true); }
__device__ __forceinline__ void sw16(unsigned v, unsigned& a, unsigned& b) { auto r = __builtin_amdgcn_permlane16_swap(v, v, false, false); a = r[0]; b = r[1]; }
__device__ __forceinline__ void sw32(unsigned v, unsigned& a, unsigned& b) { auto r = __builtin_amdgcn_permlane32_swap(v, v, false, false); a = r[0]; b = r[1]; }
__device__ __forceinline__ float add1(float v) { return v + __uint_as_float(dppu<0xB1>(__float_as_uint(v))); }
__device__ __forceinline__ float add2(float v) { return v + __uint_as_float(dppu<0x4E>(__float_as_uint(v))); }
__device__ __forceinline__ float add4(float v) { return v + __uint_as_float(dppu<0x141>(__float_as_uint(v))); }
__device__ __forceinline__ float add8(float v) { return v + __uint_as_float(dppu<0x140>(__float_as_uint(v))); }
__device__ __forceinline__ float add16(float v) { unsigned a, b; sw16(__float_as_uint(v), a, b); return __uint_as_float(a) + __uint_as_float(b); }
__device__ __forceinline__ float add32(float v) { unsigned a, b; sw32(__float_as_uint(v), a, b); return __uint_as_float(a) + __uint_as_float(b); }
__device__ __forceinline__ float max16(float v) { unsigned a, b; sw16(__float_as_uint(v), a, b); return fmaxf(__uint_as_float(a), __uint_as_float(b)); }
__device__ __forceinline__ float max32(float v) { unsigned a, b; sw32(__float_as_uint(v), a, b); return fmaxf(__uint_as_float(a), __uint_as_float(b)); }
__device__ __forceinline__ float min16(float v) { unsigned a, b; sw16(__float_as_uint(v), a, b); return fminf(__uint_as_float(a), __uint_as_float(b)); }
__device__ __forceinline__ float min32(float v) { unsigned a, b; sw32(__float_as_uint(v), a, b); return fminf(__uint_as_float(a), __uint_as_float(b)); }
__device__ __forceinline__ int iadd16(int v) { unsigned a, b; sw16((unsigned)v, a, b); return (int)(a + b); }
__device__ __forceinline__ int iadd32(int v) { unsigned a, b; sw32((unsigned)v, a, b); return (int)(a + b); }
__device__ __forceinline__ unsigned or16(unsigned v) { unsigned a, b; sw16(v, a, b); return a | b; }
__device__ __forceinline__ unsigned or32(unsigned v) { unsigned a, b; sw32(v, a, b); return a | b; }
}
namespace pg8 {
#define PG8_LAS __attribute__((address_space(3)))
typedef unsigned short bf16_t;
typedef short bf16x8 __attribute__((ext_vector_type(8)));
typedef float f32x4 __attribute__((ext_vector_type(4)));
typedef unsigned u32x4 __attribute__((ext_vector_type(4)));
constexpr int BM = 256, BK = 64, HALF = 128, HTB = HALF * BK * 2  , STAGE_BYTES = 8 * HTB, NXCD = 8, WGM = 8;

__host__ __device__ __forceinline__ int lds_byte(int r, int c) { const int st = (r >> 4) * 2 + (c >> 5), rr = r & 15, cc = c & 31, ob = rr * 64 + cc * 2; return st * 1024 + (ob ^ (((ob >> 9) & 1) << 5)); }
__host__ __device__ __forceinline__ void stage_rc(int b, int& R, int& C) { const int st = b / 1024, sb = b % 1024, swz = sb ^ (((sb >> 9) & 1) << 5); R = (st >> 1) * 16 + swz / 64; C = (st & 1) * 32 + (swz % 64) / 2; }
__host__ __device__ __forceinline__ int perm32(int rho) { const int n = rho >> 4, i = rho & 15; return 8 * (i >> 2) + 4 * n + (i & 3); }

struct Unit { int pm, pn; };
struct Gemm { const bf16_t* A; const bf16_t* Bt; int M, N, K, lda, ldb; };

struct StaticOrder {
    int nM, nN, nwg, G, c;
    __host__ __device__ void init(int M, int N, int G_, int c_) { nM = M / BM; nN = N / BM; nwg = nM * nN; G = G_; c = c_; }
    __host__ __device__ bool next(int i, Unit& u) const {
        const long L = (long)i * G + c; if (L >= nwg) return false;
        int wgid = (int)L; { const int q = nwg / NXCD, r = nwg % NXCD, xcd = wgid % NXCD, off = wgid / NXCD; wgid = (xcd < r ? xcd * (q + 1) : r * (q + 1) + (xcd - r) * q) + off; }
        const int nig = WGM * nN, gid = wgid / nig, fm = gid * WGM, gsz = (nM - fm) < WGM ? (nM - fm) : WGM;
        u.pm = fm + ((wgid % nig) % gsz); u.pn = (wgid % nig) / gsz; return true;
    }
    __device__ __forceinline__ void a_ready(const Unit&) const {}
    __device__ __forceinline__ void done(const Unit&) const {}
};

__device__ __forceinline__ unsigned cvt_pk_bf16(float lo, float hi) { unsigned r; asm volatile("v_cvt_pk_bf16_f32 %0, %1, %2" : "=v"(r) : "v"(lo), "v"(hi)); return r; }
typedef float f32x2 __attribute__((ext_vector_type(2)));

__device__ __forceinline__ float row_rs(const float* st, int row, int off, int cnt, float inv_n, int fq) {
    float s = 0.f;
    if (4 * fq < cnt) { const f32x4 v = *(const f32x4*)(st + (size_t)row * 16 + off + 4 * fq); s = (v[0] + v[1]) + (v[2] + v[3]); }
    s = xl::add32(xl::add16(s));
    return 1.0f / sqrtf(s * inv_n + 1e-6f);
}
template <int ACT, bool STAT> struct EpiScale {
    static constexpr bool PERM = true, AFTER_DRAIN = false;
    bf16_t* O; int ldc; const float* st; int st_off, st_cnt; float inv_n; float* stat_out;
    __device__ __forceinline__ void operator()(const f32x4 (&acc)[2][2][4][2], const Unit& u, int wr, int wc, int fr, int fq) const {
        asm volatile("" : "+v"(fr), "+v"(fq));
        const int row0 = u.pm * BM + wr * 64 + fr, col0 = u.pn * BM + wc * 32 + 8 * fq;
#pragma unroll
        for (int ai = 0; ai < 2; ++ai)
#pragma unroll
            for (int m = 0; m < 4; ++m) {
                const int row = row0 + ai * HALF + m * 16;
                const float rs = row_rs(st, row, st_off, st_cnt, inv_n, fq);
                bf16_t* rowp = O + (size_t)row * ldc + col0;
#pragma unroll
                for (int bj = 0; bj < 2; ++bj) {
                    f32x4 v0 = acc[ai][bj][m][0] * rs, v1 = acc[ai][bj][m][1] * rs;
                    if (ACT == 1) {
#pragma unroll
                        for (int e = 0; e < 4; ++e) { const float a = fmaxf(v0[e], 0.f), b = fmaxf(v1[e], 0.f); v0[e] = a * a; v1[e] = b * b; }
                    }
                    if (STAT) {
                        float q = (v0[0] * v0[0] + v0[1] * v0[1]) + (v0[2] * v0[2] + v0[3] * v0[3]) + (v1[0] * v1[0] + v1[1] * v1[1]) + (v1[2] * v1[2] + v1[3] * v1[3]);
                        q = xl::add32(xl::add16(q));
                        if (fq == 0) stat_out[(size_t)row * 16 + (u.pn * 2 + bj) * 4 + wc] = q;
                    }
                    u32x4 w; w.x = cvt_pk_bf16(v0[0], v0[1]); w.y = cvt_pk_bf16(v0[2], v0[3]); w.z = cvt_pk_bf16(v1[0], v1[1]); w.w = cvt_pk_bf16(v1[2], v1[3]);
                    *(u32x4*)(rowp + bj * HALF) = w;
                }
            }
    }
};
struct EpiRes {
    static constexpr bool PERM = false, AFTER_DRAIN = false;
    const float* base; float* out; bf16_t* xb; float* ssq;
    __device__ __forceinline__ void operator()(const f32x4 (&acc)[2][2][4][2], const Unit& u, int wr, int wc, int fr, int fq) const {
        typedef unsigned u32x2v __attribute__((ext_vector_type(2)));
        asm volatile("" : "+v"(fr), "+v"(fq));
        const int row0 = u.pm * BM + wr * 64 + fr, col0 = u.pn * BM + wc * 32 + 4 * fq;
#pragma unroll
        for (int ai = 0; ai < 2; ++ai)
#pragma unroll
            for (int m = 0; m < 4; ++m) {
                const int row = row0 + ai * HALF + m * 16; const size_t off = (size_t)row * 1024 + col0; float q = 0.f;
#pragma unroll
                for (int bj = 0; bj < 2; ++bj)
#pragma unroll
                    for (int n = 0; n < 2; ++n) {
                        const size_t o2 = off + bj * HALF + n * 16;
                        const f32x4 b = *(const f32x4*)(base + o2); const f32x4 o = b + acc[ai][bj][m][n];
                        *(f32x4*)(out + o2) = o;
                        u32x2v w; w.x = cvt_pk_bf16(o[0], o[1]); w.y = cvt_pk_bf16(o[2], o[3]); *(u32x2v*)(xb + o2) = w;
                        q += (o[0] * o[0] + o[1] * o[1]) + (o[2] * o[2] + o[3] * o[3]);
                    }
                q = xl::add32(xl::add16(q));
                if (fq == 0) ssq[(size_t)row * 16 + u.pn * 4 + wc] = q;
                if (m & 1) asm volatile("" ::: "memory");
            }
    }
};
template <class Epi, class Sched, bool ALIGN_EPI = false, bool SP2 = false>
__device__ __forceinline__ void gemm_phase(PG8_LAS unsigned char* lds, const Gemm g, const Sched& S, const Epi& E, const int wave_id) {
    int lane_; asm volatile("v_mbcnt_lo_u32_b32 %0, -1, 0\n\tv_mbcnt_hi_u32_b32 %0, -1, %0" : "=v"(lane_));
    const int tid = wave_id * 64 + lane_;
    const int wid = wave_id, lane = tid & 63, wr = wid >> 2, wc = wid & 3, fr = lane & 15, fq = lane >> 4;
    const int K = g.K, nt = K / BK;
    unsigned voffA[2], voffB[2];
#pragma unroll
    for (int i = 0; i < 2; ++i) { int R, C; stage_rc(tid * 16 + i * 8192, R, C); const int Rb = Epi::PERM ? ((R & ~31) + perm32(R & 31)) : R;
        voffA[i] = (unsigned)(R * g.lda + C) * 2u; voffB[i] = (unsigned)(Rb * g.ldb + C) * 2u; }
    const size_t kstep = (size_t)(BK * 2);
    const size_t hstepA = (size_t)HALF * g.lda * 2, hstepB = (size_t)HALF * g.ldb * 2;
    const size_t tstepA = 2 * hstepA, tstepB = 2 * hstepB;
    const unsigned ldsw = (unsigned)wid * 1024u;
    const int aoff = lds_byte(wr * 64 + fr, fq * 8), boff = lds_byte(wc * 32 + fr, fq * 8);
#define PG8_SA(b, h) (((b) * 2 + (h)) * HTB)
#define PG8_SB(b, h) ((4 + (b) * 2 + (h)) * HTB)
#define PG8_STAGE(bufoff, gbase, voff) do { _Pragma("unroll") for (int _i = 0; _i < 2; ++_i) \
        __builtin_amdgcn_global_load_lds((const unsigned*)((const char*)(gbase) + (voff)[_i]), (PG8_LAS unsigned*)(lds + (bufoff) + ldsw + _i * 8192), 16, 0, 0); } while (0)
#define PG8_LDA(dst, b, h) do { _Pragma("unroll") for (int m = 0; m < 4; ++m) _Pragma("unroll") for (int k = 0; k < 2; ++k) dst[m][k] = *(const PG8_LAS bf16x8*)(lds + PG8_SA(b, h) + aoff + m * 2048 + k * 1024); } while (0)
#define PG8_LDB(dst, b, h) do { _Pragma("unroll") for (int n = 0; n < 2; ++n) _Pragma("unroll") for (int k = 0; k < 2; ++k) dst[n][k] = *(const PG8_LAS bf16x8*)(lds + PG8_SB(b, h) + boff + n * 2048 + k * 1024); } while (0)
#define PG8_MMA(ai, bj, At, Bt) do { __builtin_amdgcn_s_setprio(1); _Pragma("unroll") for (int m = 0; m < 4; ++m) _Pragma("unroll") for (int n = 0; n < 2; ++n) _Pragma("unroll") for (int k = 0; k < 2; ++k) \
        acc[ai][bj][m][n] = __builtin_amdgcn_mfma_f32_16x16x32_bf16(Bt[n][k], At[m][k], acc[ai][bj][m][n], 0, 0, 0); __builtin_amdgcn_s_setprio(0); } while (0)
#define PG8_WAIT_V(n) asm volatile("s_waitcnt vmcnt(" #n ")" ::: "memory")
#define PG8_WAIT_L(n) asm volatile("s_waitcnt lgkmcnt(" #n ")" ::: "memory")
#define PG8_BAR __builtin_amdgcn_s_barrier()
#define PG8_SCHED __builtin_amdgcn_sched_barrier(0)
    Unit cur, nxt; int ui = 0;
    if (!S.next(0, cur)) return;
    f32x4 acc[2][2][4][2];
#pragma unroll
    for (int a = 0; a < 2; ++a)
#pragma unroll
        for (int b = 0; b < 2; ++b)
#pragma unroll
            for (int m = 0; m < 4; ++m)
#pragma unroll
                for (int n = 0; n < 2; ++n) acc[a][b][m][n] = (f32x4){0.f, 0.f, 0.f, 0.f};
    bf16x8 At[4][2], B0[2][2], B1[2][2];
    const char* cA = (const char*)g.A + (size_t)cur.pm * tstepA; const char* cB = (const char*)g.Bt + (size_t)cur.pn * tstepB;
    S.a_ready(cur);
    if constexpr (SP2) {
        PG8_STAGE(PG8_SB(0, 0), cB, voffB); PG8_STAGE(PG8_SB(0, 1), cB + hstepB, voffB); PG8_STAGE(PG8_SA(0, 0), cA, voffA); PG8_STAGE(PG8_SA(0, 1), cA + hstepA, voffA);
        if (wr == 1) PG8_BAR;
        PG8_WAIT_V(2); PG8_BAR;
        PG8_STAGE(PG8_SB(1, 0), cB + kstep, voffB); PG8_STAGE(PG8_SA(1, 0), cA + kstep, voffA); PG8_STAGE(PG8_SB(1, 1), cB + hstepB + kstep, voffB);
        PG8_WAIT_V(6); PG8_BAR;
    } else {
        PG8_STAGE(PG8_SB(0, 0), cB, voffB); PG8_STAGE(PG8_SA(0, 0), cA, voffA); PG8_STAGE(PG8_SB(0, 1), cB + hstepB, voffB); PG8_STAGE(PG8_SA(0, 1), cA + hstepA, voffA);
        if (wr == 1) PG8_BAR;
        PG8_WAIT_V(4); PG8_BAR;
        PG8_STAGE(PG8_SB(1, 0), cB + kstep, voffB); PG8_STAGE(PG8_SA(1, 0), cA + kstep, voffA); PG8_STAGE(PG8_SB(1, 1), cB + hstepB + kstep, voffB);
        PG8_WAIT_V(6); PG8_BAR;
    }
    for (;;) {
        const bool has_next = S.next(ui + 1, nxt);
        const char* nA = has_next ? (const char*)g.A + (size_t)nxt.pm * tstepA : cA; const char* nB = has_next ? (const char*)g.Bt + (size_t)nxt.pn * tstepB : cB;
        for (int t = 0; t < nt; t += 2) {
            const bool last = (t == nt - 2);
            const char* a1 = cA + (size_t)(t + 1) * kstep;
            const char* a2 = last ? nA : cA + (size_t)(t + 2) * kstep; const char* b2 = last ? nB : cB + (size_t)(t + 2) * kstep;
            const char* a3 = a2 + kstep; const char* b3 = b2 + kstep;
            if (last && has_next) S.a_ready(nxt);
            if constexpr (SP2) {
            PG8_LDB(B0, 0, 0); PG8_LDB(B1, 0, 1); PG8_SCHED; PG8_LDA(At, 0, 0); PG8_STAGE(PG8_SA(1, 1), a1 + hstepA, voffA);
            PG8_WAIT_V(8); PG8_WAIT_L(0); PG8_BAR; PG8_MMA(0, 0, At, B0); PG8_MMA(0, 1, At, B1); PG8_BAR; PG8_SCHED;
            PG8_LDA(At, 0, 1); PG8_STAGE(PG8_SB(0, 0), b2, voffB); PG8_STAGE(PG8_SB(0, 1), b2 + hstepB, voffB); PG8_STAGE(PG8_SA(0, 0), a2, voffA);
            PG8_WAIT_V(8); PG8_WAIT_L(0); PG8_BAR; PG8_MMA(1, 0, At, B0); PG8_MMA(1, 1, At, B1); PG8_BAR; PG8_SCHED;
            PG8_LDB(B0, 1, 0); PG8_LDB(B1, 1, 1); PG8_SCHED; PG8_LDA(At, 1, 0); PG8_STAGE(PG8_SA(0, 1), a2 + hstepA, voffA);
            PG8_WAIT_V(8); PG8_WAIT_L(0); PG8_BAR; PG8_MMA(0, 0, At, B0); PG8_MMA(0, 1, At, B1); PG8_BAR; PG8_SCHED;
            PG8_LDA(At, 1, 1); PG8_STAGE(PG8_SB(1, 0), b3, voffB); PG8_STAGE(PG8_SB(1, 1), b3 + hstepB, voffB); PG8_STAGE(PG8_SA(1, 0), a3, voffA);
            PG8_WAIT_V(8); PG8_WAIT_L(0); PG8_BAR; PG8_MMA(1, 0, At, B0); PG8_MMA(1, 1, At, B1); PG8_BAR; PG8_SCHED;
            } else {
            PG8_LDB(B0, 0, 0); PG8_SCHED; PG8_LDA(At, 0, 0); PG8_STAGE(PG8_SA(1, 1), a1 + hstepA, voffA);
            PG8_WAIT_L(8); PG8_BAR; PG8_WAIT_L(0); PG8_MMA(0, 0, At, B0); PG8_BAR; PG8_SCHED;
            PG8_LDB(B1, 0, 1); PG8_STAGE(PG8_SB(0, 0), b2, voffB);
            PG8_BAR; PG8_WAIT_L(0); PG8_MMA(0, 1, At, B1); PG8_BAR;
            PG8_LDA(At, 0, 1); PG8_STAGE(PG8_SA(0, 0), a2, voffA);
            PG8_BAR; PG8_WAIT_L(0); PG8_MMA(1, 0, At, B0); PG8_BAR; PG8_SCHED;
            PG8_STAGE(PG8_SB(0, 1), b2 + hstepB, voffB);
            PG8_WAIT_V(6); PG8_BAR; PG8_MMA(1, 1, At, B1); PG8_BAR;
            PG8_LDB(B0, 1, 0); PG8_SCHED; PG8_LDA(At, 1, 0); PG8_STAGE(PG8_SA(0, 1), a2 + hstepA, voffA);
            PG8_WAIT_L(8); PG8_BAR; PG8_WAIT_L(0); PG8_MMA(0, 0, At, B0); PG8_BAR; PG8_SCHED;
            PG8_LDB(B1, 1, 1); PG8_STAGE(PG8_SB(1, 0), b3, voffB);
            PG8_BAR; PG8_WAIT_L(0); PG8_MMA(0, 1, At, B1); PG8_BAR;
            PG8_LDA(At, 1, 1); PG8_STAGE(PG8_SA(1, 0), a3, voffA);
            PG8_BAR; PG8_WAIT_L(0); PG8_MMA(1, 0, At, B0); PG8_BAR; PG8_SCHED;
            PG8_STAGE(PG8_SB(1, 1), b3 + hstepB, voffB);
            PG8_WAIT_V(6); PG8_BAR; PG8_MMA(1, 1, At, B1); PG8_BAR;
            }
        }
        if constexpr (ALIGN_EPI) { if (wr == 0) PG8_BAR; }
        if constexpr (!Epi::AFTER_DRAIN) { E(acc, cur, wr, wc, fr, fq); S.done(cur); }
        if (!has_next) break;
#pragma unroll
        for (int a = 0; a < 2; ++a)
#pragma unroll
            for (int b = 0; b < 2; ++b)
#pragma unroll
                for (int m = 0; m < 4; ++m)
#pragma unroll
                    for (int n = 0; n < 2; ++n) acc[a][b][m][n] = (f32x4){0.f, 0.f, 0.f, 0.f};
        cur = nxt; cA = nA; cB = nB; ++ui;
        if constexpr (ALIGN_EPI) { if (wr == 1) PG8_BAR; }
    }
    PG8_WAIT_V(0);
    if constexpr (!ALIGN_EPI) { if (wr == 0) PG8_BAR; }
    PG8_BAR;
    if constexpr (Epi::AFTER_DRAIN) { E.fused(acc, cur, wr, wc, fr, fq, lds, wid, lane); S.done(cur); }
#undef PG8_SA
#undef PG8_SB
#undef PG8_STAGE
#undef PG8_LDA
#undef PG8_LDB
#undef PG8_MMA
#undef PG8_WAIT_V
#undef PG8_WAIT_L
#undef PG8_BAR
#undef PG8_SCHED
}
}
#define GAS __attribute__((address_space(1)))
#define LAS __attribute__((address_space(3)))
typedef unsigned short bf16;
typedef unsigned v4u __attribute__((ext_vector_type(4)));
typedef float f32x4 __attribute__((ext_vector_type(4)));
typedef short bf16x8 __attribute__((ext_vector_type(8)));
typedef GAS unsigned gu32;
typedef GAS unsigned long long gu64;
#define RLX_AGENT __ATOMIC_RELAXED, __HIP_MEMORY_SCOPE_AGENT
#define LDS_WAIT() asm volatile("s_waitcnt lgkmcnt(0)" ::: "memory")
#define VM_WAIT() asm volatile("s_waitcnt vmcnt(0)" ::: "memory")
__device__ __forceinline__ unsigned long long rt() { return __builtin_amdgcn_s_memrealtime(); }
__device__ __forceinline__ unsigned f2bf(float f) { unsigned u = __builtin_bit_cast(unsigned, f); return (u + 0x7fffu + ((u >> 16) & 1u)) >> 16; }
__device__ __forceinline__ unsigned pk2(float lo, float hi) { return f2bf(lo) | (f2bf(hi) << 16); }
#define XB_TMO      128
#define XB_XCNT(j)  (256  + 64 * (j))
#define XB_XSUB(j)  (1280 + 64 * (j))
#define XB_XGEN(j)  (2304 + 64 * (j))
#define XB_TOP      3328
#define XB_TOPGEN   3392
#define XCD_BAR_WORDS 3456
#define XB_SPIN_CAP (1u << 18)

__device__ __forceinline__ unsigned xb_ld(unsigned* p)              { return __hip_atomic_load(p, __ATOMIC_RELAXED, __HIP_MEMORY_SCOPE_AGENT); }
__device__ __forceinline__ unsigned xb_add(unsigned* p, unsigned v) { return __hip_atomic_fetch_add(p, v, __ATOMIC_RELAXED, __HIP_MEMORY_SCOPE_AGENT); }
__device__ __forceinline__ unsigned xb_xcc_id() { return (unsigned)__builtin_amdgcn_s_getreg((3 << 11) | 20) & 0xFu; }
#define XB_SPIN(cond, bar) do { unsigned _sp = 0; while (cond) { __builtin_amdgcn_s_sleep(1); \
    if ((++_sp & 255u) == 0u) { if (xb_ld(&(bar)[XB_TMO])) break; if (_sp > XB_SPIN_CAP) { atomicAdd(&(bar)[XB_TMO], 1u); break; } } } } while (0)

struct XcdBarrier {
    unsigned* bar; unsigned x;
    volatile LAS unsigned* st;
};

__device__ __forceinline__ XcdBarrier xcd_barrier_post(unsigned* bar, volatile LAS unsigned* st) {
    XcdBarrier b; b.bar = bar; b.x = xb_xcc_id(); b.st = st;
    if (threadIdx.x == 0) (void)xb_add(&bar[XB_XCNT(b.x)], 1u);
    return b;
}
__device__ __forceinline__ void xcd_barrier_complete(unsigned* bar, unsigned x, unsigned& nloc, unsigned& nx) {
    const unsigned G = gridDim.x * gridDim.y * gridDim.z;
    unsigned sum, cnt, mine, sp = 0u;
    for (;;) {
        sum = 0u; cnt = 0u; mine = 0u;
#pragma unroll
        for (unsigned j = 0; j < 16; ++j) { const unsigned c = xb_ld(&bar[XB_XCNT(j)]); sum += c; cnt += (c > 0u) ? 1u : 0u; mine = (j == x) ? c : mine; }
        if (sum == G) break;
        __builtin_amdgcn_s_sleep(1);
        if ((++sp & 255u) == 0u) { if (xb_ld(&bar[XB_TMO])) break; if (sp > XB_SPIN_CAP) { atomicAdd(&bar[XB_TMO], 1u); break; } }
    }
    nloc = mine > 0u ? mine : 1u; nx = cnt > 0u ? cnt : 1u;
}

__device__ __forceinline__ void xcd_barrier(const XcdBarrier& b) {
    asm volatile("s_waitcnt vmcnt(0)" ::: "memory");
    __syncthreads();
    if (threadIdx.x == 0) {
        unsigned* bar = b.bar;
        __builtin_amdgcn_s_waitcnt(0);
        unsigned nloc = b.st[0], nx = b.st[1];
        if (nloc == 0u) { xcd_barrier_complete(bar, b.x, nloc, nx); b.st[0] = nloc; b.st[1] = nx; }
        const unsigned old = xb_add(&bar[XB_XSUB(b.x)], 1u);
        const unsigned gen = old / nloc;
        if (old + 1u == (gen + 1u) * nloc) {
            __builtin_amdgcn_fence(__ATOMIC_RELEASE, "agent");
            asm volatile("s_waitcnt vmcnt(0)" ::: "memory");
            const unsigned og = xb_add(&bar[XB_TOP], 1u);
            const unsigned tg = og / nx;
            if (og + 1u == (tg + 1u) * nx) xb_add(&bar[XB_TOPGEN], 1u);
            else XB_SPIN(xb_ld(&bar[XB_TOPGEN]) == tg, bar);
            __builtin_amdgcn_fence(__ATOMIC_ACQUIRE, "agent");
            xb_add(&bar[XB_XGEN(b.x)], 1u);
            asm volatile("s_waitcnt vmcnt(0)" ::: "memory");
        } else {
            XB_SPIN(xb_ld(&bar[XB_XGEN(b.x)]) == gen, bar);
            __builtin_amdgcn_fence(__ATOMIC_ACQUIRE, "agent");
            asm volatile("s_waitcnt vmcnt(0)" ::: "memory");
        }
    }
    __syncthreads();
}

typedef short s16x4 __attribute__((ext_vector_type(4)));
typedef float f32x16 __attribute__((ext_vector_type(16)));
typedef unsigned u32x2 __attribute__((ext_vector_type(2)));
typedef LAS unsigned char* ldsp;

constexpr int NWAVES = 8, NTHR = 512;
constexpr int NTOK = 65536, SEQ = 4096, NBATCH = 16, DM = 1024, DFF = 4096;
constexpr int A_N = 1792, A_NREAL = 1736;
constexpr int A_K = 1024, A_V = 1088, A_QI = 1152, A_KI = 1664, A_WI = 1728;
constexpr int B_N = 1536;
constexpr int C_N1 = 512, C_N1REAL = 416;
constexpr int C_NQ = 1536, C_NKV = 2048;
constexpr float EPS = 1e-6f, LOG2E = 1.4426950408889634f;

constexpr size_t MiB = 1u << 20;
constexpr size_t WS_CTL = 0, CTL_ZERO_BYTES = 1 * MiB;
constexpr size_t WS_WUP = 1 * MiB, WS_WDN = 33 * MiB, WS_WAIN = 65 * MiB, WS_WAOUT = 72 * MiB, WS_WBIN = 76 * MiB, WS_WBOUT = 79 * MiB;
constexpr size_t WS_WCIN = 81 * MiB, WS_WQB = 82 * MiB, WS_WKVB = 83 * MiB, WS_WCOUT = 84 * MiB;
constexpr size_t WS_CS = 86 * MiB, WS_SSQ = 94 * MiB, WS_CSTAT = 98 * MiB, WS_XB = 102 * MiB, WS_R = 230 * MiB;
constexpr size_t R_U = 0, R_PA = 0, R_MASK = 224 * MiB, R_O = 256 * MiB, R_PB = 0;
constexpr size_t R_LAT = 0, R_Q = 64 * MiB, R_KV = 256 * MiB, R_KR = 512 * MiB, R_OC = 576 * MiB;
constexpr size_t WS_END = WS_R + 704 * MiB;
constexpr int CW_BAR = 4096;

constexpr int RING_BYTES = 131072, LDSCTL_OFF = RING_BYTES, MISC_OFF = LDSCTL_OFF + 320, LDS_BYTES = 147456;

__device__ __forceinline__ int phase_tid(int wave) { int l; asm volatile("v_mbcnt_lo_u32_b32 %0, -1, 0\n\tv_mbcnt_hi_u32_b32 %0, -1, %0" : "=v"(l)); return wave * 64 + l; }
__device__ __forceinline__ float bf2f(unsigned short v) { return __uint_as_float((unsigned)v << 16); }
__device__ __forceinline__ float bflo(unsigned w) { return __uint_as_float(w << 16); }
__device__ __forceinline__ float bfhi(unsigned w) { return __uint_as_float(w & 0xffff0000u); }
__device__ __forceinline__ unsigned cvtpk(float lo, float hi) { return pg8::cvt_pk_bf16(lo, hi); }
__device__ __forceinline__ float wave_sum(float v) {
    return xl::add32(xl::add16(xl::add8(xl::add4(xl::add2(xl::add1(v))))));
}
__device__ __forceinline__ s16x4 lds_tr(const LAS void* p) {
    typedef short v4i16_t __attribute__((ext_vector_type(4)));
    return __builtin_bit_cast(s16x4, __builtin_amdgcn_ds_read_tr16_b64_v4i16((LAS v4i16_t*)p));
}
__device__ __forceinline__ bf16x8 cat8(s16x4 a, s16x4 b) { return (bf16x8){a[0], a[1], a[2], a[3], b[0], b[1], b[2], b[3]}; }

__device__ __forceinline__ int t5_bucket(int n) {
    if (n < 16) return n;
    if (n >= 128) return 31;
    int b = 16 + (int)(logf((float)n * 0.0625f) * (16.0f / 2.0794415416798357f));
    return b > 31 ? 31 : b;
}

__device__ __forceinline__ void transpose_item(const float* __restrict__ W, int K, int Nreal, bf16* WT, const float* __restrict__ gain, LAS float* scr, int item, int nblk, int lane) {
    const int kb = item / nblk, nb = item % nblk, k0 = 64 * kb, n0 = 32 * nb;
    const int n = n0 + (lane & 31);
#pragma unroll 8
    for (int i = 0; i < 32; ++i) { const int kk = 2 * i + (lane >> 5); float v = (n < Nreal) ? W[(size_t)(k0 + kk) * Nreal + n] : 0.f; if (gain) v *= gain[k0 + kk]; scr[kk * 33 + (lane & 31)] = v; }
    LDS_WAIT(); asm volatile("" ::: "memory");
    const int c = lane & 7;
#pragma unroll
    for (int j = 0; j < 4; ++j) { const int nn = (lane >> 3) + 8 * j; const LAS float* s = scr + (8 * c) * 33 + nn;
        v4u o; o.x = pk2(s[0 * 33], s[1 * 33]); o.y = pk2(s[2 * 33], s[3 * 33]); o.z = pk2(s[4 * 33], s[5 * 33]); o.w = pk2(s[6 * 33], s[7 * 33]);
        *(v4u*)(WT + (size_t)(n0 + nn) * K + k0 + 8 * c) = o; }
    LDS_WAIT(); asm volatile("" ::: "memory");
}

struct Ptrs {
    const float* in[24]; float* out; unsigned char* ws;
};

__device__ __forceinline__ void prologue(const Ptrs& P, ldsp lds, int gw, int NGW, int wave) {
    const int lane = phase_tid(wave) & 63;
    LAS float* scr = (LAS float*)(lds + wave * 16384);
    unsigned char* ws = P.ws;
#pragma unroll 1
    for (int mi = 0; mi < 20; ++mi) {
        const float* src; const float* gain = nullptr; bf16* dst; int KK = DM, NREAL = DM, NPAD = DM;
        if (mi < 4)       { src = P.in[5] + (size_t)mi * DM * DFF; NREAL = DFF; NPAD = DFF; dst = (bf16*)(ws + WS_WUP + (size_t)mi * 8 * MiB); gain = P.in[4] + mi * DM; }
        else if (mi < 8)  { const int l = mi - 4; src = P.in[6] + (size_t)l * DM * DFF; KK = DFF; dst = (bf16*)(ws + WS_WDN + (size_t)l * 8 * MiB); }
        else if (mi < 10) { const int i = mi - 8; src = P.in[7] + (size_t)i * DM * A_NREAL; NREAL = A_NREAL; NPAD = A_N; dst = (bf16*)(ws + WS_WAIN + (size_t)i * (A_N * DM * 2)); gain = P.in[3] + (i == 0 ? 0 : 3) * DM; }
        else if (mi < 12) { const int i = mi - 10; src = P.in[10] + (size_t)i * DM * DM; dst = (bf16*)(ws + WS_WAOUT + (size_t)i * 2 * MiB); }
        else if (mi == 12) { src = P.in[11]; NREAL = B_N; NPAD = B_N; dst = (bf16*)(ws + WS_WBIN); gain = P.in[3] + 1 * DM; }
        else if (mi == 13) { src = P.in[15]; dst = (bf16*)(ws + WS_WBOUT); }
        else if (mi == 14) { src = P.in[16]; NREAL = C_N1REAL; NPAD = C_N1; dst = (bf16*)(ws + WS_WCIN); gain = P.in[3] + 2 * DM; }
        else if (mi == 15) { src = P.in[18]; KK = 256; NREAL = C_NQ; NPAD = C_NQ; dst = (bf16*)(ws + WS_WQB); gain = P.in[17]; }
        else if (mi == 16) { src = P.in[20]; KK = 128; NREAL = C_NKV; NPAD = C_NKV; dst = (bf16*)(ws + WS_WKVB); gain = P.in[19]; }
        else if (mi == 17) { src = P.in[23]; dst = (bf16*)(ws + WS_WCOUT); }
        else continue;
        const int nblk = NPAD / 32, items = (KK / 64) * nblk;
#pragma unroll 1
        for (int it = gw; it < items; it += NGW) transpose_item(src, KK, NREAL, dst, gain, scr, it, nblk, lane);
    }
    {
        const float* x = P.in[0]; bf16* xb = (bf16*)(ws + WS_XB); float* ssq = (float*)(ws + WS_SSQ);
        for (int m = gw; m < NTOK; m += NGW) {
            const f32x4* xr = (const f32x4*)(x + (size_t)m * DM) + lane;
            f32x4 v[4]; float s = 0.f;
#pragma unroll
            for (int j = 0; j < 4; ++j) { v[j] = xr[64 * j]; s += (v[j][0] * v[j][0] + v[j][1] * v[j][1]) + (v[j][2] * v[j][2] + v[j][3] * v[j][3]); }
            s = wave_sum(s);
            u32x2* o8 = (u32x2*)(xb + (size_t)m * DM) + lane;
#pragma unroll
            for (int j = 0; j < 4; ++j) { u32x2 w; w.x = pk2(v[j][0], v[j][1]); w.y = pk2(v[j][2], v[j][3]); o8[64 * j] = w; }
            if (lane < 16) ssq[(size_t)m * 16 + lane] = (lane == 0) ? s : 0.f;
        }
    }
    {
        const int* pos = (const int*)P.in[1]; float* cs = (float*)(ws + WS_CS);
        const int gt = gw * 64 + lane, NGT = NGW * 64;
        for (int e = gt; e < NTOK * 16; e += NGT) {
            const int tok = e >> 4, i = e & 15;
            double inv_freq = 1.0; for (int k = 0; k < i; ++k) inv_freq *= 0.5623413251903491;
            const double rev = (double)pos[tok] * inv_freq * 0.15915494309189535;
            const float fr = (float)(rev - floor(rev));
            cs[2 * e] = __builtin_amdgcn_cosf(fr); cs[2 * e + 1] = __builtin_amdgcn_sinf(fr);
        }
    }
}

constexpr int A2_CAP = 64;
constexpr int A2_CBUF = 0, A2_FBUF = 1024, A2_MASK = 2048, A2_CMASK = 10240, A2_CAND = 18432, A2_CCNT = 26624, A2_NEED = 26688;
__device__ __forceinline__ void phase_a2(ldsp lds, bf16* PA, unsigned* maskOut, f32x4* scr  , const float* kgain, int vcu, int G, int wave) {
    const int tid = phase_tid(wave);
    const int lane = tid & 63, w = wave, j = lane & 15, g = lane >> 4;
    LAS unsigned* cbuf = (LAS unsigned*)(lds + A2_CBUF);
    LAS float* fbuf = (LAS float*)(lds + A2_FBUF);
    LAS unsigned short* mask16 = (LAS unsigned short*)(lds + A2_MASK);
    LAS unsigned* mask32 = (LAS unsigned*)(lds + A2_MASK);
    LAS unsigned short* cand16 = (LAS unsigned short*)(lds + A2_CMASK);
    LAS unsigned* cand32 = (LAS unsigned*)(lds + A2_CMASK);
    LAS float* candv = (LAS float*)(lds + A2_CAND);
    LAS unsigned* ccnt = (LAS unsigned*)(lds + A2_CCNT);
    LAS int* needv = (LAS int*)(lds + A2_NEED);
    for (int p = vcu; p < 2048; p += G) {
#pragma unroll 1
      for (int half = 0; half < 2; ++half) {
        const int b = p >> 7, pr = p & 127, qt = half ? 255 - pr : pr, t0 = 16 * qt;
        const size_t rowbase = (size_t)b * SEQ;
        if (tid < 256) {
            const int r = tid >> 4, c4 = tid & 15;
            u32x2* kp = (u32x2*)(PA + (rowbase + t0 + r) * A_N + A_K + 4 * c4);
            const u32x2 kv = *kp; float k0 = bflo(kv.x), k1 = bfhi(kv.x), k2 = bflo(kv.y), k3 = bfhi(kv.y);
            float s = (k0 * k0 + k1 * k1) + (k2 * k2 + k3 * k3);
            s = xl::add8(xl::add4(xl::add2(xl::add1(s))));
            const float rs = 1.0f / sqrtf(s * (1.0f / 64.0f) + EPS);
            const f32x4 gk = *(const f32x4*)(kgain + 4 * c4);
            u32x2 o; o.x = cvtpk(k0 * rs * gk[0], k1 * rs * gk[1]); o.y = cvtpk(k2 * rs * gk[2], k3 * rs * gk[3]); *kp = o;
        }
        if (qt < 16) {
            for (int e = tid; e < 2048; e += NTHR) { const int q = e >> 7, wi = e & 127; const int nb = t0 + q + 1 - 32 * wi;
                maskOut[(rowbase + t0 + q) * 128 + wi] = nb >= 32 ? 0xffffffffu : (nb <= 0 ? 0u : ((1u << nb) - 1u)); }
            continue;
        }
        const int NT = qt + 1;
        if (tid < 16) ccnt[tid] = 0u;
        const float NINF = -__builtin_inff();
        {
            bf16x8 qb[8][2]; float wv[8];
            const bf16* qrow = PA + (rowbase + t0 + j) * A_N;
#pragma unroll
            for (int h = 0; h < 8; ++h)
#pragma unroll
                for (int ks = 0; ks < 2; ++ks) qb[h][ks] = *(const bf16x8*)(qrow + A_QI + 64 * h + 32 * ks + 8 * g);
            const v4u wr = *(const v4u*)(qrow + A_WI);
            const float wsc = 0.35355339059327373f * 0.125f;
            wv[0] = bflo(wr.x) * wsc; wv[1] = bfhi(wr.x) * wsc; wv[2] = bflo(wr.y) * wsc; wv[3] = bfhi(wr.y) * wsc;
            wv[4] = bflo(wr.z) * wsc; wv[5] = bfhi(wr.z) * wsc; wv[6] = bflo(wr.w) * wsc; wv[7] = bfhi(wr.w) * wsc;
            const bf16* kr = PA + (rowbase + 16 * w + j) * A_N + A_KI + 8 * g;
            f32x4* sp = scr + (size_t)(w * 32) * 64 + lane;
#pragma unroll 1
            for (int i = 0; i < 32; ++i) {
                const int kt = w + 8 * i;
                f32x4 s = (f32x4){NINF, NINF, NINF, NINF};
                if (kt < NT) {
                    const bf16x8 ka0 = *(const bf16x8*)kr, ka1 = *(const bf16x8*)(kr + 32);
                    s = (f32x4){0.f, 0.f, 0.f, 0.f};
#pragma unroll
                    for (int h = 0; h < 8; ++h) {
                        f32x4 a = __builtin_amdgcn_mfma_f32_16x16x32_bf16(ka0, qb[h][0], (f32x4){0.f, 0.f, 0.f, 0.f}, 0, 0, 0);
                        a = __builtin_amdgcn_mfma_f32_16x16x32_bf16(ka1, qb[h][1], a, 0, 0, 0);
#pragma unroll
                        for (int r = 0; r < 4; ++r) s[r] += wv[h] * fmaxf(a[r], 0.f);
                    }
                    if (kt == qt) {
#pragma unroll
                        for (int r = 0; r < 4; ++r) if (4 * g + r > j) s[r] = NINF;
                    }
                }
                sp[(size_t)i * 64] = s;
                kr += (size_t)128 * A_N;
            }
        }
        asm volatile("s_waitcnt vmcnt(0)" ::: "memory");
        f32x4 sc[32];
        {
            const f32x4* sp = scr + (size_t)(w * 32) * 64 + lane;
#pragma unroll
            for (int i = 0; i < 32; ++i) sc[i] = sp[(size_t)i * 64];
        }
        float mx = NINF, mn = __builtin_inff();
#pragma unroll
        for (int i = 0; i < 32; ++i)
#pragma unroll
            for (int r = 0; r < 4; ++r) { const float s = sc[i][r]; mx = fmaxf(mx, s); mn = fminf(mn, s == NINF ? __builtin_inff() : s); }
        mx = xl::max32(xl::max16(mx));
        mn = xl::min32(xl::min16(mn));
        if (g == 0) { fbuf[j * 8 + w] = mx; fbuf[128 + j * 8 + w] = mn; }
        __syncthreads();
        {
            const f32x4 a0 = *(const LAS f32x4*)(fbuf + j * 8), a1 = *(const LAS f32x4*)(fbuf + j * 8 + 4);
            mx = fmaxf(fmaxf(fmaxf(a0[0], a0[1]), fmaxf(a0[2], a0[3])), fmaxf(fmaxf(a1[0], a1[1]), fmaxf(a1[2], a1[3])));
            const f32x4 b0 = *(const LAS f32x4*)(fbuf + 128 + j * 8), b1 = *(const LAS f32x4*)(fbuf + 128 + j * 8 + 4);
            mn = fminf(fminf(fminf(b0[0], b0[1]), fminf(b0[2], b0[3])), fminf(fminf(b1[0], b1[1]), fminf(b1[2], b1[3])));
        }
        float lo = mn, hi = mx + (fabsf(mx) * 1e-6f + 1e-30f);
        int clo = t0 + j + 1, chi = 0; bool done = false, tie = false; int par = 0;
        for (int it = 0; it < 96; ++it) {
            if (!done && clo - chi <= A2_CAP) done = true;
            const float mid = 0.5f * (lo + hi);
            if (!done && !(mid > lo && mid < hi)) { tie = true; done = true; }
            if (__all(done)) break;
            int c = 0;
#pragma unroll
            for (int i = 0; i < 32; ++i)
#pragma unroll
                for (int r = 0; r < 4; ++r) c += (sc[i][r] >= mid) ? 1 : 0;
            c = xl::iadd32(xl::iadd16(c));
            if (g == 0) cbuf[par * 128 + j * 8 + w] = (unsigned)c;
            __syncthreads();
            const v4u c0 = *(const LAS v4u*)(cbuf + par * 128 + j * 8), c1 = *(const LAS v4u*)(cbuf + par * 128 + j * 8 + 4);
            const int tot = (int)((c0.x + c0.y) + (c0.z + c0.w) + (c1.x + c1.y) + (c1.z + c1.w));
            par ^= 1;
            if (!done) { if (tot >= 256) { lo = mid; clo = tot; } else { hi = mid; chi = tot; } }
        }
        const int need = 256 - chi;
        const bool bigtie = tie && (clo - chi > A2_CAP);
        int J = -1;
        if (__any(bigtie)) {
            int jlo = -1, jhi = SEQ - 1;
            for (int it = 0; it < 13; ++it) {
                const int jm = (jlo + jhi) >> 1;
                int c = 0;
#pragma unroll 1
                for (int i = 0; i < 32; ++i) {
                    const f32x4 s4 = scr[(size_t)(w * 32 + i) * 64 + lane];
#pragma unroll
                    for (int r = 0; r < 4; ++r) c += (s4[r] == lo && (16 * (w + 8 * i) + 4 * g + r) <= jm) ? 1 : 0;
                }
                c = xl::iadd32(xl::iadd16(c));
                if (g == 0) cbuf[par * 128 + j * 8 + w] = (unsigned)c;
                __syncthreads();
                const v4u c0 = *(const LAS v4u*)(cbuf + par * 128 + j * 8), c1 = *(const LAS v4u*)(cbuf + par * 128 + j * 8 + 4);
                const int tot = (int)((c0.x + c0.y) + (c0.z + c0.w) + (c1.x + c1.y) + (c1.z + c1.w));
                par ^= 1;
                if (jhi - jlo > 1) { if (tot >= need) jhi = jm; else jlo = jm; }
            }
            J = jhi;
        }
        if (w == 0 && g == 0) needv[j] = bigtie ? 0 : need;
        {
            const float loc = bigtie ? hi : lo;
#pragma unroll
            for (int i = 0; i < 32; ++i) {
                const int kt = w + 8 * i; unsigned bs = 0u, bc = 0u;
#pragma unroll
                for (int r = 0; r < 4; ++r) { const float s = sc[i][r]; const unsigned a = (s >= hi) ? 1u : 0u, c = (s >= loc) ? 1u : 0u; bs |= a << r; bc |= (c & ~a) << r; }
                unsigned v = (bs | (bc << 16)) << (4 * g);
                v = xl::or32(xl::or16(v));
                if (g == 0) { mask16[j * 256 + kt] = (unsigned short)v; cand16[j * 256 + kt] = (unsigned short)(v >> 16); }
            }
        }
        __syncthreads();
        if (__any(bigtie)) {
#pragma unroll 1
            for (int i = 0; i < 32; ++i) {
                const f32x4 s4 = scr[(size_t)(w * 32 + i) * 64 + lane];
#pragma unroll
                for (int r = 0; r < 4; ++r) { const int idx = 16 * (w + 8 * i) + 4 * g + r;
                    if (bigtie && s4[r] == lo && idx <= J) atomicOr((unsigned*)(mask32 + j * 128 + (idx >> 5)), 1u << (idx & 31)); }
            }
        }
        {
            const int q = tid >> 5, i32 = tid & 31;
#pragma unroll 1
            for (int wi = 4 * i32; wi < 4 * i32 + 4; ++wi) {
                unsigned m = cand32[q * 128 + wi];
                while (m) {
                    const int bpos = __ffs((int)m) - 1; m &= m - 1; const int idx = 32 * wi + bpos, kt = idx >> 4;
                    const float sv = ((const float*)(scr + (size_t)((kt & 7) * 32 + (kt >> 3)) * 64 + ((idx >> 2) & 3) * 16 + q))[idx & 3];
                    const unsigned pos = atomicAdd((unsigned*)(ccnt + q), 1u);
                    if (pos < (unsigned)A2_CAP) { candv[(q * A2_CAP + pos) * 2] = sv; candv[(q * A2_CAP + pos) * 2 + 1] = __int_as_float(idx); }
                }
            }
        }
        __syncthreads();
        {
            const int q = tid >> 5, i32 = tid & 31; const int C = min((int)ccnt[q], A2_CAP), nd = needv[q];
            for (int c = i32; c < C; c += 32) {
                const float s = candv[(q * A2_CAP + c) * 2]; const int idx = __float_as_int(candv[(q * A2_CAP + c) * 2 + 1]);
                int rank = 0;
                for (int o = 0; o < C; ++o) { const float so = candv[(q * A2_CAP + o) * 2]; const int io = __float_as_int(candv[(q * A2_CAP + o) * 2 + 1]); rank += (so > s || (so == s && io < idx)) ? 1 : 0; }
                if (rank < nd) atomicOr((unsigned*)(mask32 + q * 128 + (idx >> 5)), 1u << (idx & 31));
            }
        }
        __syncthreads();
        for (int e = tid; e < 2048; e += NTHR) { const int q = e >> 7, wi = e & 127; maskOut[(rowbase + t0 + q) * 128 + wi] = mask32[q * 128 + wi]; }
        __syncthreads();
      }
    }
}

constexpr int A3_BIAS = 0, A3_WAVE0 = 8448, A3_WSTRIDE = 9728, A3_VS = 144;
__device__ __forceinline__ void phase_a3(ldsp lds, const bf16* PA, const unsigned* maskIn, bf16* O, const float* qgain, const float* rel_bias, int gw, int NGW, int wave) {
    const int tid = phase_tid(wave);
    const int lane = tid & 63, w = wave, j = lane & 15, g = lane >> 4;
    LAS float* biasT = (LAS float*)(lds + A3_BIAS);
    for (int e = tid; e < 129 * 16; e += NTHR) { const int n = e >> 4, h = e & 15; biasT[e] = rel_bias[t5_bucket(n) * 16 + h] * LOG2E; }
    __syncthreads();
    LAS unsigned short* sel = (LAS unsigned short*)(lds + A3_WAVE0 + w * A3_WSTRIDE);
    const ldsp Vl = lds + A3_WAVE0 + w * A3_WSTRIDE + 512;
    const float QS = 0.125f * LOG2E;
    f32x4 gq0, gq1, gq2, gq3;
    gq0 = *(const f32x4*)(qgain + 8 * g); gq1 = *(const f32x4*)(qgain + 8 * g + 4); gq2 = *(const f32x4*)(qgain + 32 + 8 * g); gq3 = *(const f32x4*)(qgain + 32 + 8 * g + 4);
    for (int qi = gw; qi < NTOK; qi += NGW) {
        const int b = qi >> 12, t = qi & (SEQ - 1);
        const bf16* Pb = PA + (size_t)b * SEQ * A_N;
        const unsigned long long mw = *(const unsigned long long*)(maskIn + (size_t)qi * 128 + 2 * lane);
        const int cnt = __popcll(mw);
        int pre = cnt;
#pragma unroll
        for (int o = 1; o < 64; o <<= 1) { const int v = __builtin_amdgcn_ds_bpermute((lane >= o ? lane - o : lane) << 2, pre); if (lane >= o) pre += v; }
        const int nkeys = __builtin_amdgcn_readlane(pre, 63);
        {
            int off = pre - cnt; unsigned long long m = mw;
            while (m) { const int bpos = __ffsll((long long)m) - 1; sel[off++] = (unsigned short)(64 * lane + bpos); m &= m - 1; }
        }
        for (int e = nkeys + lane; e < 256; e += 64) sel[e] = 0;
        LDS_WAIT(); asm volatile("" ::: "memory");
        bf16x8 qf0, qf1;
        {
            const bf16* qp = PA + (size_t)qi * A_N + 64 * j + 8 * g;
            const v4u r0 = *(const v4u*)qp, r1 = *(const v4u*)(qp + 32);
            float x[16] = {bflo(r0.x), bfhi(r0.x), bflo(r0.y), bfhi(r0.y), bflo(r0.z), bfhi(r0.z), bflo(r0.w), bfhi(r0.w),
                           bflo(r1.x), bfhi(r1.x), bflo(r1.y), bfhi(r1.y), bflo(r1.z), bfhi(r1.z), bflo(r1.w), bfhi(r1.w)};
            float s = 0.f;
#pragma unroll
            for (int e = 0; e < 16; ++e) s += x[e] * x[e];
            s = xl::add32(xl::add16(s));
            const float rs = QS / sqrtf(s * (1.0f / 64.0f) + EPS);
            v4u a, c;
            a.x = cvtpk(x[0] * rs * gq0[0], x[1] * rs * gq0[1]); a.y = cvtpk(x[2] * rs * gq0[2], x[3] * rs * gq0[3]); a.z = cvtpk(x[4] * rs * gq1[0], x[5] * rs * gq1[1]); a.w = cvtpk(x[6] * rs * gq1[2], x[7] * rs * gq1[3]);
            c.x = cvtpk(x[8] * rs * gq2[0], x[9] * rs * gq2[1]); c.y = cvtpk(x[10] * rs * gq2[2], x[11] * rs * gq2[3]); c.z = cvtpk(x[12] * rs * gq3[0], x[13] * rs * gq3[1]); c.w = cvtpk(x[14] * rs * gq3[2], x[15] * rs * gq3[3]);
            qf0 = __builtin_bit_cast(bf16x8, a); qf1 = __builtin_bit_cast(bf16x8, c);
        }
        const int ntile = (nkeys + 15) >> 4;
        f32x4 pr[16]; float lsum = 0.f;
#pragma unroll
        for (int kt = 0; kt < 16; ++kt) {
            pr[kt] = (f32x4){0.f, 0.f, 0.f, 0.f};
            if (kt < ntile) {
                const int ki = sel[16 * kt + j];
                const bf16* kp = Pb + (size_t)ki * A_N + A_K + 8 * g;
                const bf16x8 ka0 = *(const bf16x8*)kp, ka1 = *(const bf16x8*)(kp + 32);
                f32x4 s = __builtin_amdgcn_mfma_f32_16x16x32_bf16(ka0, qf0, (f32x4){0.f, 0.f, 0.f, 0.f}, 0, 0, 0);
                s = __builtin_amdgcn_mfma_f32_16x16x32_bf16(ka1, qf1, s, 0, 0, 0);
                const u32x2 iw = *(const LAS u32x2*)(sel + 16 * kt + 4 * g);
                const int i0 = iw.x & 0xffff, i1 = iw.x >> 16, i2 = iw.y & 0xffff, i3 = iw.y >> 16;
                const int kb = 16 * kt + 4 * g;
                float p0 = __builtin_amdgcn_exp2f(s[0] + biasT[min(t - i0, 128) * 16 + j]);
                float p1 = __builtin_amdgcn_exp2f(s[1] + biasT[min(t - i1, 128) * 16 + j]);
                float p2 = __builtin_amdgcn_exp2f(s[2] + biasT[min(t - i2, 128) * 16 + j]);
                float p3 = __builtin_amdgcn_exp2f(s[3] + biasT[min(t - i3, 128) * 16 + j]);
                if (kb + 0 >= nkeys) p0 = 0.f; if (kb + 1 >= nkeys) p1 = 0.f; if (kb + 2 >= nkeys) p2 = 0.f; if (kb + 3 >= nkeys) p3 = 0.f;
                lsum += (p0 + p1) + (p2 + p3);
                pr[kt] = (f32x4){p0, p1, p2, p3};
            }
        }
        f32x4 o[4];
#pragma unroll
        for (int nd = 0; nd < 4; ++nd) o[nd] = (f32x4){0.f, 0.f, 0.f, 0.f};
#pragma unroll
        for (int c = 0; c < 4; ++c) {
            if (4 * c < ntile) {
#pragma unroll
                for (int m = 0; m < 8; ++m) {
                    const int rr = 8 * m + (lane >> 3); const int vi = sel[64 * c + rr];
                    const v4u vv = *(const v4u*)(Pb + (size_t)vi * A_N + A_V + 8 * (lane & 7));
                    *(LAS v4u*)(Vl + rr * A3_VS + 16 * (lane & 7)) = vv;
                }
                LDS_WAIT(); asm volatile("" ::: "memory");
#pragma unroll
                for (int s2 = 0; s2 < 2; ++s2) {
                    const f32x4 pa = pr[4 * c + 2 * s2], pb = pr[4 * c + 2 * s2 + 1];
                    v4u pw; pw.x = cvtpk(pa[0], pa[1]); pw.y = cvtpk(pa[2], pa[3]); pw.z = cvtpk(pb[0], pb[1]); pw.w = cvtpk(pb[2], pb[3]);
                    const bf16x8 pfrag = __builtin_bit_cast(bf16x8, pw);
#pragma unroll
                    for (int nd = 0; nd < 4; ++nd) {
                        const ldsp a0 = Vl + (32 * s2 + 4 * g + (j >> 2)) * A3_VS + (16 * nd + 4 * (j & 3)) * 2;
                        const bf16x8 vf = cat8(lds_tr(a0), lds_tr(a0 + 16 * A3_VS));
                        o[nd] = __builtin_amdgcn_mfma_f32_16x16x32_bf16(vf, pfrag, o[nd], 0, 0, 0);
                    }
                }
                LDS_WAIT(); asm volatile("" ::: "memory");
            }
        }
        lsum = xl::add32(xl::add16(lsum));
        const float il = 1.0f / lsum;
        bf16* op = O + (size_t)qi * DM + 64 * j + 4 * g;
#pragma unroll
        for (int nd = 0; nd < 4; ++nd) { u32x2 wv; wv.x = cvtpk(o[nd][0] * il, o[nd][1] * il); wv.y = cvtpk(o[nd][2] * il, o[nd][3] * il); *(u32x2*)(op + 16 * nd) = wv; }
    }
    __syncthreads();
}

constexpr int B2_BIAS = 0, B2_K = 8192, B2_V = 8192 + 36864, B2_KS = 144;
__device__ __forceinline__ void phase_b2(ldsp lds, const bf16* PB, bf16* O, const float* qgain, const float* kgain, const float* sinks, const float* rel_bias, int vcu, int G, int wave) {
    const int tid = phase_tid(wave);
    const int lane = tid & 63, w = wave, r32 = lane & 31, hh = lane >> 5, g16 = (lane >> 4) & 1, i16 = lane & 15;
    LAS float* biasT = (LAS float*)(lds + B2_BIAS);
    for (int e = tid; e < 128 * 16; e += NTHR) { const int n = e >> 4, h = e & 15; biasT[e] = rel_bias[t5_bucket(n) * 16 + h] * LOG2E; }
    const ldsp Kl = lds + B2_K, Vl = lds + B2_V;
    const float QS = 0.125f * LOG2E;
    for (int u = vcu; u < 2048; u += G) {
        const int nb = u & 31, kvh = (u >> 5) & 3, b = u >> 7;
        const size_t rowbase = (size_t)b * SEQ;
        __syncthreads();
        {
            const f32x4 gk0 = *(const f32x4*)(kgain + 8 * (tid & 7)), gk1 = *(const f32x4*)(kgain + 8 * (tid & 7) + 4);
#pragma unroll
            for (int m = 0; m < 4; ++m) {
                const int kj = 64 * m + (tid >> 3), pc = tid & 7; const int tok = 128 * (nb - 1) + kj;
                v4u kk = (v4u){0u, 0u, 0u, 0u}, vv = (v4u){0u, 0u, 0u, 0u};
                if (tok >= 0) { const bf16* rp = PB + (rowbase + tok) * B_N; kk = *(const v4u*)(rp + 1024 + 64 * kvh + 8 * pc); vv = *(const v4u*)(rp + 1280 + 64 * kvh + 8 * pc); }
                float x[8] = {bflo(kk.x), bfhi(kk.x), bflo(kk.y), bfhi(kk.y), bflo(kk.z), bfhi(kk.z), bflo(kk.w), bfhi(kk.w)};
                float s = 0.f;
#pragma unroll
                for (int e = 0; e < 8; ++e) s += x[e] * x[e];
                s = xl::add4(xl::add2(xl::add1(s)));
                const float rs = 1.0f / sqrtf(s * (1.0f / 64.0f) + EPS);
                v4u ko; ko.x = cvtpk(x[0] * rs * gk0[0], x[1] * rs * gk0[1]); ko.y = cvtpk(x[2] * rs * gk0[2], x[3] * rs * gk0[3]); ko.z = cvtpk(x[4] * rs * gk1[0], x[5] * rs * gk1[1]); ko.w = cvtpk(x[6] * rs * gk1[2], x[7] * rs * gk1[3]);
                *(LAS v4u*)(Kl + kj * B2_KS + 16 * pc) = ko; *(LAS v4u*)(Vl + kj * B2_KS + 16 * pc) = vv;
            }
        }
        __syncthreads();
        const int hq = 4 * kvh + (w >> 1);
        const float sinkp = __builtin_amdgcn_exp2f(sinks[hq] * LOG2E);
#pragma unroll 1
        for (int qblk = 0; qblk < 2; ++qblk) {
            const int qs = 64 * (w & 1) + 32 * qblk;
            const int ql = qs + r32;
            bf16x8 qf[4];
            {
                const bf16* qp = PB + (rowbase + 128 * nb + ql) * B_N + 64 * hq + 8 * hh;
                v4u rq[4]; float s = 0.f;
#pragma unroll
                for (int ks = 0; ks < 4; ++ks) { rq[ks] = *(const v4u*)(qp + 16 * ks);
                    const float a0 = bflo(rq[ks].x), a1 = bfhi(rq[ks].x), a2 = bflo(rq[ks].y), a3 = bfhi(rq[ks].y), a4 = bflo(rq[ks].z), a5 = bfhi(rq[ks].z), a6 = bflo(rq[ks].w), a7 = bfhi(rq[ks].w);
                    s += (a0 * a0 + a1 * a1) + (a2 * a2 + a3 * a3) + (a4 * a4 + a5 * a5) + (a6 * a6 + a7 * a7); }
                s = xl::add32(s);
                const float rs = QS / sqrtf(s * (1.0f / 64.0f) + EPS);
#pragma unroll
                for (int ks = 0; ks < 4; ++ks) {
                    const f32x4 g0 = *(const f32x4*)(qgain + 16 * ks + 8 * hh), g1 = *(const f32x4*)(qgain + 16 * ks + 8 * hh + 4);
                    v4u o; o.x = cvtpk(bflo(rq[ks].x) * rs * g0[0], bfhi(rq[ks].x) * rs * g0[1]); o.y = cvtpk(bflo(rq[ks].y) * rs * g0[2], bfhi(rq[ks].y) * rs * g0[3]);
                    o.z = cvtpk(bflo(rq[ks].z) * rs * g1[0], bfhi(rq[ks].z) * rs * g1[1]); o.w = cvtpk(bflo(rq[ks].w) * rs * g1[2], bfhi(rq[ks].w) * rs * g1[3]);
                    qf[ks] = __builtin_bit_cast(bf16x8, o);
                }
            }
            f32x16 o0 = {}, o1 = {}; float lsum = 0.f;
#pragma unroll 1
            for (int kt5 = 0; kt5 < 5; ++kt5) {
                const int kt = (qs >> 5) + kt5;
                if (nb == 0 && kt < 4) continue;
                f32x16 p = {};
#pragma unroll
                for (int ks = 0; ks < 4; ++ks) {
                    const bf16x8 ka = *(const LAS bf16x8*)(Kl + (32 * kt + r32) * B2_KS + (16 * ks + 8 * hh) * 2);
                    p = __builtin_amdgcn_mfma_f32_32x32x16_bf16(ka, qf[ks], p, 0, 0, 0);
                }
#pragma unroll
                for (int r = 0; r < 16; ++r) {
                    const int kj = 32 * kt + (r & 3) + 8 * (r >> 2) + 4 * hh; const int rel = ql + 128 - kj;
                    const bool ok = (rel >= 0) && (rel < 128);
                    const float bv = biasT[(rel & 127) * 16 + hq];
                    const float e = __builtin_amdgcn_exp2f(p[r] + bv);
                    p[r] = ok ? e : 0.f; lsum += p[r];
                }
                v4u pw0, pw1;
                pw0.x = cvtpk(p[0], p[1]); pw0.y = cvtpk(p[2], p[3]); pw0.z = cvtpk(p[4], p[5]); pw0.w = cvtpk(p[6], p[7]);
                pw1.x = cvtpk(p[8], p[9]); pw1.y = cvtpk(p[10], p[11]); pw1.z = cvtpk(p[12], p[13]); pw1.w = cvtpk(p[14], p[15]);
                const bf16x8 pf0 = __builtin_bit_cast(bf16x8, pw0), pf1 = __builtin_bit_cast(bf16x8, pw1);
#pragma unroll
                for (int s = 0; s < 2; ++s) {
                    const ldsp va = Vl + (32 * kt + 16 * s + 4 * hh + (i16 >> 2)) * B2_KS + (16 * g16 + 4 * (i16 & 3)) * 2;
                    const bf16x8 v0 = cat8(lds_tr(va), lds_tr(va + 8 * B2_KS));
                    const bf16x8 v1 = cat8(lds_tr(va + 64), lds_tr(va + 8 * B2_KS + 64));
                    o0 = __builtin_amdgcn_mfma_f32_32x32x16_bf16(v0, s == 0 ? pf0 : pf1, o0, 0, 0, 0);
                    o1 = __builtin_amdgcn_mfma_f32_32x32x16_bf16(v1, s == 0 ? pf0 : pf1, o1, 0, 0, 0);
                }
            }
            lsum = xl::add32(lsum);
            const float il = 1.0f / (lsum + sinkp);
            bf16* op = O + (rowbase + 128 * nb + ql) * DM + 64 * hq + 4 * hh;
#pragma unroll
            for (int rg = 0; rg < 4; ++rg) {
                u32x2 w0; w0.x = cvtpk(o0[4 * rg] * il, o0[4 * rg + 1] * il); w0.y = cvtpk(o0[4 * rg + 2] * il, o0[4 * rg + 3] * il); *(u32x2*)(op + 8 * rg) = w0;
                u32x2 w1; w1.x = cvtpk(o1[4 * rg] * il, o1[4 * rg + 1] * il); w1.y = cvtpk(o1[4 * rg + 2] * il, o1[4 * rg + 3] * il); *(u32x2*)(op + 32 + 8 * rg) = w1;
            }
        }
    }
    __syncthreads();
}

__device__ __forceinline__ void phase_cfin(bf16* Q, bf16* KV, const bf16* LAT, bf16* KR, const float* cs, const float* qgain, const float* kgain, int gw, int NGW, int wave) {
    const int lane = phase_tid(wave) & 63;
    const int hd = lane >> 2, sub = lane & 3;
    const float QS = 0.10206207261596575f * LOG2E;
    f32x4 gqn[4], gkn[4]; f32x4 gq1, gq2, gk1, gk2;
#pragma unroll
    for (int e = 0; e < 4; ++e) { gqn[e] = *(const f32x4*)(qgain + 16 * sub + 4 * e); gkn[e] = *(const f32x4*)(kgain + 16 * sub + 4 * e); }
    gq1 = *(const f32x4*)(qgain + 64 + 4 * sub); gq2 = *(const f32x4*)(qgain + 80 + 4 * sub); gk1 = *(const f32x4*)(kgain + 64 + 4 * sub); gk2 = *(const f32x4*)(kgain + 80 + 4 * sub);
    for (int tok = gw; tok < NTOK; tok += NGW) {
        const f32x4 csa = *(const f32x4*)(cs + (size_t)tok * 32 + 8 * sub), csb = *(const f32x4*)(cs + (size_t)tok * 32 + 8 * sub + 4);
        const float cv[4] = {csa[0], csa[2], csb[0], csb[2]}, sv[4] = {csa[1], csa[3], csb[1], csb[3]};
#pragma unroll
        for (int isk = 0; isk < 2; ++isk) {
            bf16* np = isk ? (KV + (size_t)tok * C_NKV + 128 * hd + 16 * sub) : (Q + (size_t)tok * C_NQ + 96 * hd + 16 * sub);
            const bf16* r1p = isk ? (LAT + (size_t)tok * C_N1 + 384 + 4 * sub) : (Q + (size_t)tok * C_NQ + 96 * hd + 64 + 4 * sub);
            const v4u n0 = *(const v4u*)np, n1 = *(const v4u*)(np + 8);
            const u32x2 t1 = *(const u32x2*)r1p, t2 = *(const u32x2*)(r1p + 16);
            float x[16] = {bflo(n0.x), bfhi(n0.x), bflo(n0.y), bfhi(n0.y), bflo(n0.z), bfhi(n0.z), bflo(n0.w), bfhi(n0.w), bflo(n1.x), bfhi(n1.x), bflo(n1.y), bfhi(n1.y), bflo(n1.z), bfhi(n1.z), bflo(n1.w), bfhi(n1.w)};
            float a[4] = {bflo(t1.x), bfhi(t1.x), bflo(t1.y), bfhi(t1.y)}, c[4] = {bflo(t2.x), bfhi(t2.x), bflo(t2.y), bfhi(t2.y)};
            float s = 0.f;
#pragma unroll
            for (int e = 0; e < 16; ++e) s += x[e] * x[e];
#pragma unroll
            for (int e = 0; e < 4; ++e) s += a[e] * a[e] + c[e] * c[e];
            s = xl::add2(xl::add1(s));
            const float rs = (isk ? 1.0f : QS) / sqrtf(s * (1.0f / 96.0f) + EPS);
            v4u o0, o1;
            const f32x4* gn = isk ? gkn : gqn;
            o0.x = cvtpk(x[0] * rs * gn[0][0], x[1] * rs * gn[0][1]); o0.y = cvtpk(x[2] * rs * gn[0][2], x[3] * rs * gn[0][3]); o0.z = cvtpk(x[4] * rs * gn[1][0], x[5] * rs * gn[1][1]); o0.w = cvtpk(x[6] * rs * gn[1][2], x[7] * rs * gn[1][3]);
            o1.x = cvtpk(x[8] * rs * gn[2][0], x[9] * rs * gn[2][1]); o1.y = cvtpk(x[10] * rs * gn[2][2], x[11] * rs * gn[2][3]); o1.z = cvtpk(x[12] * rs * gn[3][0], x[13] * rs * gn[3][1]); o1.w = cvtpk(x[14] * rs * gn[3][2], x[15] * rs * gn[3][3]);
            const f32x4 g1 = isk ? gk1 : gq1, g2 = isk ? gk2 : gq2;
            float r1[4], r2[4];
#pragma unroll
            for (int e = 0; e < 4; ++e) { const float u1 = a[e] * rs * g1[e], u2 = c[e] * rs * g2[e]; r1[e] = u1 * cv[e] - u2 * sv[e]; r2[e] = u2 * cv[e] + u1 * sv[e]; }
            u32x2 w1, w2; w1.x = cvtpk(r1[0], r1[1]); w1.y = cvtpk(r1[2], r1[3]); w2.x = cvtpk(r2[0], r2[1]); w2.y = cvtpk(r2[2], r2[3]);
            *(v4u*)np = o0; *(v4u*)(np + 8) = o1;
            bf16* rop = isk ? (KR + (size_t)tok * 512 + 32 * hd + 4 * sub) : (Q + (size_t)tok * C_NQ + 96 * hd + 64 + 4 * sub);
            *(u32x2*)rop = w1; *(u32x2*)(rop + 16) = w2;
        }
    }
}

constexpr int C3_KS = 208, C3_VS = 144, C3_KB = 64 * C3_KS, C3_VB = 64 * C3_VS, C3_K = 0, C3_V = 2 * C3_KB;
__device__ __forceinline__ void phase_c3(ldsp lds, const bf16* Q, const bf16* KV, const bf16* KR, bf16* O, int vcu, int G, int wave) {
    const int tid = phase_tid(wave);
    const int lane = tid & 63, w = wave, r32 = lane & 31, hh = lane >> 5, g16 = (lane >> 4) & 1, i16 = lane & 15;
    const int srow = tid >> 3, spc = tid & 7, rrow = (tid >> 2) & 63, rpc = tid & 3;
    for (int p = vcu; p < 2048; p += G) {
#pragma unroll 1
      for (int half = 0; half < 2; ++half) {
        const int bh = p >> 3, b = bh >> 4, h = bh & 15, qb = half ? 15 - (p & 7) : (p & 7);
        const size_t rowbase = (size_t)b * SEQ;
        const int NT = 4 * (qb + 1), tw = 4 * qb + (w >> 1);
        const bf16* kvb = KV + rowbase * C_NKV + 128 * h; const bf16* krb = KR + rowbase * 512 + 32 * h;
        bf16x8 qf[6];
        {
            const bf16* qp = Q + (rowbase + 256 * qb + 32 * w + r32) * C_NQ + 96 * h + 8 * hh;
#pragma unroll
            for (int ks = 0; ks < 6; ++ks) qf[ks] = *(const bf16x8*)(qp + 16 * ks);
        }
        v4u sk, sv, sr = (v4u){0u, 0u, 0u, 0u};
        sk = *(const v4u*)(kvb + (size_t)srow * C_NKV + 8 * spc); sv = *(const v4u*)(kvb + (size_t)srow * C_NKV + 64 + 8 * spc);
        if (tid < 256) sr = *(const v4u*)(krb + (size_t)rrow * 512 + 8 * rpc);
        *(LAS v4u*)(lds + C3_K + srow * C3_KS + 16 * spc) = sk; *(LAS v4u*)(lds + C3_V + srow * C3_VS + 16 * spc) = sv;
        if (tid < 256) *(LAS v4u*)(lds + C3_K + rrow * C3_KS + 128 + 16 * rpc) = sr;
        f32x16 o0 = {}, o1 = {}; float lsum = 0.f;
        const int qloc = 32 * w + r32;
#pragma unroll 1
        for (int t = 0; t < NT; ++t) {
            __syncthreads();
            const int cur = t & 1, nxt = cur ^ 1;
            if (t + 1 < NT) {
                const size_t kr0 = (size_t)(64 * (t + 1) + srow) * C_NKV;
                sk = *(const v4u*)(kvb + kr0 + 8 * spc); sv = *(const v4u*)(kvb + kr0 + 64 + 8 * spc);
                if (tid < 256) sr = *(const v4u*)(krb + (size_t)(64 * (t + 1) + rrow) * 512 + 8 * rpc);
            }
            if (t <= tw) {
                const ldsp Kb = lds + C3_K + cur * C3_KB, Vb = lds + C3_V + cur * C3_VB;
                f32x16 p0 = {}, p1 = {};
#pragma unroll
                for (int ks = 0; ks < 6; ++ks) {
                    const bf16x8 k0 = *(const LAS bf16x8*)(Kb + r32 * C3_KS + (16 * ks + 8 * hh) * 2);
                    const bf16x8 k1 = *(const LAS bf16x8*)(Kb + (32 + r32) * C3_KS + (16 * ks + 8 * hh) * 2);
                    p0 = __builtin_amdgcn_mfma_f32_32x32x16_bf16(k0, qf[ks], p0, 0, 0, 0);
                    p1 = __builtin_amdgcn_mfma_f32_32x32x16_bf16(k1, qf[ks], p1, 0, 0, 0);
                }
                const bool diag = (t == tw);
                const int kq = qloc - 64 * (t - 4 * qb);
#pragma unroll
                for (int r = 0; r < 16; ++r) {
                    const int kl = (r & 3) + 8 * (r >> 2) + 4 * hh;
                    float e0 = __builtin_amdgcn_exp2f(p0[r]), e1 = __builtin_amdgcn_exp2f(p1[r]);
                    if (diag) { if (kl > kq) e0 = 0.f; if (kl + 32 > kq) e1 = 0.f; }
                    p0[r] = e0; p1[r] = e1; lsum += e0 + e1;
                }
                v4u pw[4];
                pw[0].x = cvtpk(p0[0], p0[1]); pw[0].y = cvtpk(p0[2], p0[3]); pw[0].z = cvtpk(p0[4], p0[5]); pw[0].w = cvtpk(p0[6], p0[7]);
                pw[1].x = cvtpk(p0[8], p0[9]); pw[1].y = cvtpk(p0[10], p0[11]); pw[1].z = cvtpk(p0[12], p0[13]); pw[1].w = cvtpk(p0[14], p0[15]);
                pw[2].x = cvtpk(p1[0], p1[1]); pw[2].y = cvtpk(p1[2], p1[3]); pw[2].z = cvtpk(p1[4], p1[5]); pw[2].w = cvtpk(p1[6], p1[7]);
                pw[3].x = cvtpk(p1[8], p1[9]); pw[3].y = cvtpk(p1[10], p1[11]); pw[3].z = cvtpk(p1[12], p1[13]); pw[3].w = cvtpk(p1[14], p1[15]);
#pragma unroll
                for (int ks = 0; ks < 4; ++ks) {
                    const ldsp va = Vb + (16 * ks + 4 * hh + (i16 >> 2)) * C3_VS + (16 * g16 + 4 * (i16 & 3)) * 2;
                    const bf16x8 v0 = cat8(lds_tr(va), lds_tr(va + 8 * C3_VS));
                    const bf16x8 v1 = cat8(lds_tr(va + 64), lds_tr(va + 8 * C3_VS + 64));
                    const bf16x8 pf = __builtin_bit_cast(bf16x8, pw[ks]);
                    o0 = __builtin_amdgcn_mfma_f32_32x32x16_bf16(v0, pf, o0, 0, 0, 0);
                    o1 = __builtin_amdgcn_mfma_f32_32x32x16_bf16(v1, pf, o1, 0, 0, 0);
                }
            }
            if (t + 1 < NT) {
                *(LAS v4u*)(lds + C3_K + nxt * C3_KB + srow * C3_KS + 16 * spc) = sk; *(LAS v4u*)(lds + C3_V + nxt * C3_VB + srow * C3_VS + 16 * spc) = sv;
                if (tid < 256) *(LAS v4u*)(lds + C3_K + nxt * C3_KB + rrow * C3_KS + 128 + 16 * rpc) = sr;
            }
        }
        lsum = xl::add32(lsum);
        const float il = 1.0f / lsum;
        bf16* op = O + (rowbase + 256 * qb + qloc) * DM + 64 * h + 4 * hh;
#pragma unroll
        for (int rg = 0; rg < 4; ++rg) {
            u32x2 w0; w0.x = cvtpk(o0[4 * rg] * il, o0[4 * rg + 1] * il); w0.y = cvtpk(o0[4 * rg + 2] * il, o0[4 * rg + 3] * il); *(u32x2*)(op + 8 * rg) = w0;
            u32x2 w1; w1.x = cvtpk(o1[4 * rg] * il, o1[4 * rg + 1] * il); w1.y = cvtpk(o1[4 * rg + 2] * il, o1[4 * rg + 3] * il); *(u32x2*)(op + 32 + 8 * rg) = w1;
        }
        __syncthreads();
      }
    }
}

#ifndef MK_SINGLE
#define MK_SINGLE 0
#endif
struct Args { const float* in[24]; float* out; unsigned char* ws; int ph_lo, ph_hi; };

typedef __attribute__((address_space(4))) const Args* karg_t;
#define PH_BEGIN karg_t A_ = ap; int bx = bx0, G = G0, vcu = vcu0, gw = gw0, NGW = NGW0, wave = wave0; asm volatile("" : "+s"(A_), "+s"(bx), "+s"(G), "+s"(vcu), "+s"(gw), "+s"(NGW), "+s"(wave)); (void)bx; (void)G; (void)vcu; (void)gw; (void)NGW; unsigned char* const ws = A_->ws; unsigned char* const R = ws + WS_R; (void)R; \
    bf16* const xb = (bf16*)(ws + WS_XB); float* const ssq = (float*)(ws + WS_SSQ); (void)xb; (void)ssq;
__global__ void __launch_bounds__(NTHR, 2) mk_fwd(Args args) {
    extern __shared__ __attribute__((aligned(16))) unsigned char lds_raw[];
    const ldsp lds = (ldsp)lds_raw;
    const int tid0 = threadIdx.x, wave0 = __builtin_amdgcn_readfirstlane(tid0 >> 6);
    const int G0 = gridDim.x, bx0 = blockIdx.x;
    const int vcu0 = (G0 % 8 == 0) ? (bx0 % 8) * (G0 / 8) + bx0 / 8 : bx0;
    const int gw0 = vcu0 * NWAVES + wave0, NGW0 = G0 * NWAVES;
    const karg_t ap = (karg_t)__builtin_amdgcn_kernarg_segment_ptr();
    for (int u = tid0; u < (LDS_BYTES - LDSCTL_OFF) / 4; u += NTHR) ((LAS unsigned*)(lds + LDSCTL_OFF))[u] = 0u;
    __syncthreads();
    XcdBarrier bar; bar.bar = (unsigned*)(args.ws + WS_CTL) + CW_BAR; bar.x = 0; bar.st = nullptr;
    if (MK_SINGLE) bar = xcd_barrier_post((unsigned*)(args.ws + WS_CTL) + CW_BAR, (volatile LAS unsigned*)(lds + MISC_OFF + 32));
    const int lo = args.ph_lo, hi = args.ph_hi; int ph = 0;
#define RUN (lo <= ph && ph < hi)
#define SEAM() do { if (MK_SINGLE && lo <= ph && ph + 1 < hi) xcd_barrier(bar); ++ph; } while (0)

    if (RUN) { PH_BEGIN Ptrs P; for (int i = 0; i < 24; ++i) P.in[i] = A_->in[i]; P.out = A_->out; P.ws = ws; prologue(P, lds, gw, NGW, wave); }
    SEAM();

#pragma unroll
    for (int L = 0; L < 4; ++L) {
        const int kind = L % 3;
        if (kind == 0) {
            const int ia = (L == 0) ? 0 : 1;
            if (RUN) {
                PH_BEGIN
                pg8::Gemm g{xb, (const bf16*)(ws + WS_WAIN + (size_t)ia * (A_N * DM * 2)), NTOK, A_N, DM, DM, DM}; pg8::StaticOrder S; S.init(NTOK, A_N, G, bx);
                pg8::EpiScale<0, false> E{(bf16*)(R + R_PA), A_N, ssq, 0, 16, 1.0f / 1024.0f, nullptr};
                pg8::gemm_phase<pg8::EpiScale<0, false>, pg8::StaticOrder, true, true>(lds, g, S, E, wave);
            }
            SEAM();
            if (RUN) { PH_BEGIN phase_a2(lds, (bf16*)(R + R_PA), (unsigned*)(R + R_MASK), (f32x4*)(R + R_O) + (size_t)bx * 16384, A_->in[9] + ia * 64, vcu, G, wave); }
            SEAM();
            if (RUN) { PH_BEGIN phase_a3(lds, (const bf16*)(R + R_PA), (const unsigned*)(R + R_MASK), (bf16*)(R + R_O), A_->in[8] + ia * 64, A_->in[2], gw, NGW, wave); }
            SEAM();
            if (RUN) {
                PH_BEGIN
                pg8::Gemm g{(const bf16*)(R + R_O), (const bf16*)(ws + WS_WAOUT + (size_t)ia * 2 * MiB), NTOK, DM, DM, DM, DM}; pg8::StaticOrder S; S.init(NTOK, DM, G, bx);
                pg8::EpiRes E{(L == 0) ? A_->in[0] : (const float*)A_->out, A_->out, xb, ssq};
                pg8::gemm_phase<pg8::EpiRes, pg8::StaticOrder, true, true>(lds, g, S, E, wave);
            }
            SEAM();
        } else if (kind == 1) {
            if (RUN) {
                PH_BEGIN
                pg8::Gemm g{xb, (const bf16*)(ws + WS_WBIN), NTOK, B_N, DM, DM, DM}; pg8::StaticOrder S; S.init(NTOK, B_N, G, bx);
                pg8::EpiScale<0, false> E{(bf16*)(R + R_PB), B_N, ssq, 0, 16, 1.0f / 1024.0f, nullptr};
                pg8::gemm_phase<pg8::EpiScale<0, false>, pg8::StaticOrder, true, true>(lds, g, S, E, wave);
            }
            SEAM();
            if (RUN) { PH_BEGIN phase_b2(lds, (const bf16*)(R + R_PB), (bf16*)(R + R_O), A_->in[12], A_->in[13], A_->in[14], A_->in[2], vcu, G, wave); }
            SEAM();
            if (RUN) {
                PH_BEGIN
                pg8::Gemm g{(const bf16*)(R + R_O), (const bf16*)(ws + WS_WBOUT), NTOK, DM, DM, DM, DM}; pg8::StaticOrder S; S.init(NTOK, DM, G, bx);
                pg8::EpiRes E{(const float*)A_->out, A_->out, xb, ssq};
                pg8::gemm_phase<pg8::EpiRes, pg8::StaticOrder, true, true>(lds, g, S, E, wave);
            }
            SEAM();
        } else {
            if (RUN) {
                PH_BEGIN
                pg8::Gemm g{xb, (const bf16*)(ws + WS_WCIN), NTOK, C_N1, DM, DM, DM}; pg8::StaticOrder S; S.init(NTOK, C_N1, G, bx);
                pg8::EpiScale<0, true> E{(bf16*)(R + R_LAT), C_N1, ssq, 0, 16, 1.0f / 1024.0f, (float*)(ws + WS_CSTAT)};
                pg8::gemm_phase<pg8::EpiScale<0, true>, pg8::StaticOrder, true, true>(lds, g, S, E, wave);
            }
            SEAM();
            if (RUN) {
                { PH_BEGIN
                  pg8::Gemm g{(const bf16*)(R + R_LAT), (const bf16*)(ws + WS_WQB), NTOK, C_NQ, 256, C_N1, 256}; pg8::StaticOrder S; S.init(NTOK, C_NQ, G, bx);
                  pg8::EpiScale<0, false> E{(bf16*)(R + R_Q), C_NQ, (const float*)(ws + WS_CSTAT), 0, 8, 1.0f / 256.0f, nullptr};
                  pg8::gemm_phase<pg8::EpiScale<0, false>, pg8::StaticOrder, true, true>(lds, g, S, E, wave); }
                __syncthreads();
                { PH_BEGIN
                  pg8::Gemm g{(const bf16*)(R + R_LAT) + 256, (const bf16*)(ws + WS_WKVB), NTOK, C_NKV, 128, C_N1, 128}; pg8::StaticOrder S; S.init(NTOK, C_NKV, G, bx);
                  pg8::EpiScale<0, false> E{(bf16*)(R + R_KV), C_NKV, (const float*)(ws + WS_CSTAT), 8, 4, 1.0f / 128.0f, nullptr};
                  pg8::gemm_phase<pg8::EpiScale<0, false>, pg8::StaticOrder, true, true>(lds, g, S, E, wave); }
            }
            SEAM();
            if (RUN) { PH_BEGIN phase_cfin((bf16*)(R + R_Q), (bf16*)(R + R_KV), (const bf16*)(R + R_LAT), (bf16*)(R + R_KR), (const float*)(ws + WS_CS), A_->in[21], A_->in[22], gw, NGW, wave); }
            SEAM();
            if (RUN) { PH_BEGIN phase_c3(lds, (const bf16*)(R + R_Q), (const bf16*)(R + R_KV), (const bf16*)(R + R_KR), (bf16*)(R + R_OC), vcu, G, wave); }
            SEAM();
            if (RUN) {
                PH_BEGIN
                pg8::Gemm g{(const bf16*)(R + R_OC), (const bf16*)(ws + WS_WCOUT), NTOK, DM, DM, DM, DM}; pg8::StaticOrder S; S.init(NTOK, DM, G, bx);
                pg8::EpiRes E{(const float*)A_->out, A_->out, xb, ssq};
                pg8::gemm_phase<pg8::EpiRes, pg8::StaticOrder, true, true>(lds, g, S, E, wave);
            }
            SEAM();
        }
        if (RUN) {
            PH_BEGIN
            pg8::Gemm g{xb, (const bf16*)(ws + WS_WUP + (size_t)L * 8 * MiB), NTOK, DFF, DM, DM, DM}; pg8::StaticOrder S; S.init(NTOK, DFF, G, bx);
            pg8::EpiScale<1, false> E{(bf16*)(R + R_U), DFF, ssq, 0, 16, 1.0f / 1024.0f, nullptr};
            pg8::gemm_phase<pg8::EpiScale<1, false>, pg8::StaticOrder, true, true>(lds, g, S, E, wave);
        }
        SEAM();
        if (RUN) {
            PH_BEGIN
            pg8::Gemm g{(const bf16*)(R + R_U), (const bf16*)(ws + WS_WDN + (size_t)L * 8 * MiB), NTOK, DM, DFF, DFF, DFF}; pg8::StaticOrder S; S.init(NTOK, DM, G, bx);
            pg8::EpiRes E{(const float*)A_->out, A_->out, xb, ssq};
            pg8::gemm_phase<pg8::EpiRes, pg8::StaticOrder, true, true>(lds, g, S, E, wave);
        }
        SEAM();
    }
#undef RUN
#undef SEAM
}

constexpr int N_PHASES = 1 + (4 + 2) + (3 + 2) + (5 + 2) + (4 + 2);

extern "C" void kernel_launch(void* const* d_in, const int* in_sizes, int n_in, void* d_out, int out_size, void* d_ws, size_t ws_size, hipStream_t stream) {
    static int grid = 0;
    if (grid == 0) {
        if (n_in != 24 || in_sizes[0] != NTOK * DM || out_size != NTOK * DM || ws_size < WS_END) {
            fprintf(stderr, "kernel_launch: unexpected problem shape (n_in %d, in0 %d, out %d, ws %zu < %zu); nothing launched\n", n_in, n_in > 0 ? in_sizes[0] : -1, out_size, ws_size, (size_t)WS_END); grid = -1; return; }
        int dev = 0, cus = 0, per_cu = 0;
        if (hipGetDevice(&dev) != hipSuccess || hipDeviceGetAttribute(&cus, hipDeviceAttributeMultiprocessorCount, dev) != hipSuccess) { grid = -1; return; }
        if (hipFuncSetAttribute((const void*)mk_fwd, hipFuncAttributeMaxDynamicSharedMemorySize, LDS_BYTES) != hipSuccess) { fprintf(stderr, "kernel_launch: hipFuncSetAttribute failed\n"); grid = -1; return; }
        if (hipOccupancyMaxActiveBlocksPerMultiprocessor(&per_cu, (const void*)mk_fwd, NTHR, LDS_BYTES) != hipSuccess || per_cu < 1)
            fprintf(stderr, "kernel_launch: note: occupancy query reports %d workgroups per CU\n", per_cu);
        (void)hipGetLastError();
        grid = cus;
    }
    if (grid < 0) return;
    if (hipMemsetAsync((char*)d_ws + WS_CTL, 0, CTL_ZERO_BYTES, stream) != hipSuccess) return;
    Args a{};
    for (int i = 0; i < 24; ++i) a.in[i] = (const float*)d_in[i];
    a.out = (float*)d_out; a.ws = (unsigned char*)d_ws;
#if MK_SINGLE
    a.ph_lo = 0; a.ph_hi = N_PHASES;
    hipLaunchKernelGGL(mk_fwd, dim3(grid), dim3(NTHR), LDS_BYTES, stream, a);
#else
    for (int k = 0; k < N_PHASES; ++k) { a.ph_lo = k; a.ph_hi = k + 1; hipLaunchKernelGGL(mk_fwd, dim3(grid), dim3(NTHR), LDS_BYTES, stream, a); }
#endif
}
```

```cpp
#include <hip/hip_runtime.h>
#include <cstdio>
#include <cstdint>

namespace xl {
template <int CTRL> __device__ __forceinline__ unsigned dppu(unsigned v) { return (unsigned)__builtin_amdgcn_update_dpp(0, (int)v, CTRL, 0xf, 0xf, true); }
__device__ __forceinline__ void sw16(unsigned v, unsigned& a, unsigned& b) { auto r = __builtin_amdgcn_permlane16_swap(v, v, false, false); a = r[0]; b = r[1]; }
__device__ __forceinline__ void sw32(unsigned v, unsigned& a, unsigned& b) { auto r = __builtin_amdgcn_permlane32_swap(v, v, false, false); a = r[0]; b = r[1]; }
__device__ __forceinline__ float add1(float v) { return v + __uint_as_float(dppu<0xB1>(__float_as_uint(v))); }
__device__ __forceinline__ float add2(float v) { return v + __uint_as_float(dppu<0x4E>(__float_as_uint(v))); }
__device__ __forceinline__ float add4(float v) { return v + __uint_as_float(dppu<0x141>(__float_as_uint(v))); }
__device__ __forceinline__ float add8(float v) { return v + __uint_as_float(dppu<0x140>(__float_as_uint(v))); }
__device__ __forceinline__ float max1(float v) { return fmaxf(v, __uint_as_float(dppu<0xB1>(__float_as_uint(v)))); }
__device__ __forceinline__ float max2(float v) { return fmaxf(v, __uint_as_float(dppu<0x4E>(__float_as_uint(v)))); }
__device__ __forceinline__ float max4(float v) { return fmaxf(v, __uint_as_float(dppu<0x141>(__float_as_uint(v)))); }
__device__ __forceinline__ float max8(float v) { return fmaxf(v, __uint_as_float(dppu<0x140>(__float_as_uint(v)))); }
__device__ __forceinline__ float min1(float v) { return fminf(v, __uint_as_float(dppu<0xB1>(__float_as_uint(v)))); }
__device__ __forceinline__ float min2(float v) { return fminf(v, __uint_as_float(dppu<0x4E>(__float_as_uint(v)))); }
__device__ __forceinline__ float min4(float v) { return fminf(v, __uint_as_float(dppu<0x141>(__float_as_uint(v)))); }
__device__ __forceinline__ float min8(float v) { return fminf(v, __uint_as_float(dppu<0x140>(__float_as_uint(v)))); }
__device__ __forceinline__ int iadd1(int v) { return v + (int)dppu<0xB1>((unsigned)v); }
__device__ __forceinline__ int iadd2(int v) { return v + (int)dppu<0x4E>((unsigned)v); }
__device__ __forceinline__ int iadd4(int v) { return v + (int)dppu<0x141>((unsigned)v); }
__device__ __forceinline__ int iadd8(int v) { return v + (int)dppu<0x140>((unsigned)v); }
__device__ __forceinline__ unsigned or1(unsigned v) { return v | dppu<0xB1>(v); }
__device__ __forceinline__ unsigned or2(unsigned v) { return v | dppu<0x4E>(v); }
__device__ __forceinline__ unsigned or4(unsigned v) { return v | dppu<0x141>(v); }
__device__ __forceinline__ float add16(float v) { unsigned a, b; sw16(__float_as_uint(v), a, b); return __uint_as_float(a) + __uint_as_float(b); }
__device__ __forceinline__ float add32(float v) { unsigned a, b; sw32(__float_as_uint(v), a, b); return __uint_as_float(a) + __uint_as_float(b); }
__device__ __forceinline__ float max16(float v) { unsigned a, b; sw16(__float_as_uint(v), a, b); return fmaxf(__uint_as_float(a), __uint_as_float(b)); }
__device__ __forceinline__ float max32(float v) { unsigned a, b; sw32(__float_as_uint(v), a, b); return fmaxf(__uint_as_float(a), __uint_as_float(b)); }
__device__ __forceinline__ float min16(float v) { unsigned a, b; sw16(__float_as_uint(v), a, b); return fminf(__uint_as_float(a), __uint_as_float(b)); }
__device__ __forceinline__ float min32(float v) { unsigned a, b; sw32(__float_as_uint(v), a, b); return fminf(__uint_as_float(a), __uint_as_float(b)); }
__device__ __forceinline__ int iadd16(int v) { unsigned a, b; sw16((unsigned)v, a, b); return (int)(a + b); }
__device__ __forceinline__ int iadd32(int v) { unsigned a, b; sw32((unsigned)v, a, b); return (int)(a + b); }
__device__ __forceinline__ unsigned or16(unsigned v) { unsigned a, b; sw16(v, a, b); return a | b; }
__device__ __forceinline__ unsigned or32(unsigned v) { unsigned a, b; sw32(v, a, b); return a | b; }
}
namespace pg8 {
#define PG8_LAS __attribute__((address_space(3)))
typedef unsigned short bf16_t;
typedef short bf16x8 __attribute__((ext_vector_type(8)));
typedef float f32x4 __attribute__((ext_vector_type(4)));
typedef unsigned u32x4 __attribute__((ext_vector_type(4)));
constexpr int BM = 256, BK = 64, HALF = 128, HTB = HALF * BK * 2  , STAGE_BYTES = 8 * HTB, NXCD = 8, WGM = 8;

__host__ __device__ __forceinline__ int lds_byte(int r, int c) { const int st = (r >> 4) * 2 + (c >> 5), rr = r & 15, cc = c & 31, ob = rr * 64 + cc * 2; return st * 1024 + (ob ^ (((ob >> 9) & 1) << 5)); }
__host__ __device__ __forceinline__ void stage_rc(int b, int& R, int& C) { const int st = b / 1024, sb = b % 1024, swz = sb ^ (((sb >> 9) & 1) << 5); R = (st >> 1) * 16 + swz / 64; C = (st & 1) * 32 + (swz % 64) / 2; }
__host__ __device__ __forceinline__ int perm32(int rho) { const int n = rho >> 4, i = rho & 15; return 8 * (i >> 2) + 4 * n + (i & 3); }

struct Unit { int pm, pn; };
struct Gemm { const bf16_t* A; const bf16_t* Bt; int M, N, K, lda, ldb; };

struct StaticOrder {
    int nM, nN, nwg, G, c;
    __host__ __device__ void init(int M, int N, int G_, int c_) { nM = M / BM; nN = N / BM; nwg = nM * nN; G = G_; c = c_; }
    __host__ __device__ bool next(int i, Unit& u) const {
        const long L = (long)i * G + c; if (L >= nwg) return false;
        int wgid = (int)L; { const int q = nwg / NXCD, r = nwg % NXCD, xcd = wgid % NXCD, off = wgid / NXCD; wgid = (xcd < r ? xcd * (q + 1) : r * (q + 1) + (xcd - r) * q) + off; }
        const int nig = WGM * nN, gid = wgid / nig, fm = gid * WGM, gsz = (nM - fm) < WGM ? (nM - fm) : WGM;
        u.pm = fm + ((wgid % nig) % gsz); u.pn = (wgid % nig) / gsz; return true;
    }
    __device__ __forceinline__ void a_ready(const Unit&) const {}
    __device__ __forceinline__ void done(const Unit&) const {}
};

__device__ __forceinline__ unsigned cvt_pk_bf16(float lo, float hi) { unsigned r; asm volatile("v_cvt_pk_bf16_f32 %0, %1, %2" : "=v"(r) : "v"(lo), "v"(hi)); return r; }
typedef float f32x2 __attribute__((ext_vector_type(2)));

__device__ __forceinline__ void row_rs8(float (&rsv)[2][4], const float* st, int row0, int off, int cnt, float inv_n, int fq) {
    const bool in = 4 * fq < cnt;
    const float msk = in ? 1.0f : 0.0f;
    const float* p = st + (size_t)row0 * 16 + off + (in ? 4 * fq : 0);
    f32x4 v[2][4];
#pragma unroll
    for (int ai = 0; ai < 2; ++ai)
#pragma unroll
        for (int m = 0; m < 4; ++m) v[ai][m] = *(const f32x4*)(p + (size_t)(ai * HALF + m * 16) * 16);
    __builtin_amdgcn_sched_barrier(0);
#pragma unroll
    for (int ai = 0; ai < 2; ++ai)
#pragma unroll
        for (int m = 0; m < 4; ++m) {
            float s = ((v[ai][m][0] + v[ai][m][1]) + (v[ai][m][2] + v[ai][m][3])) * msk;
            s = xl::add32(xl::add16(s));
            rsv[ai][m] = __builtin_amdgcn_rsqf(s * inv_n + 1e-6f);
        }
}
template <int ACT, bool STAT> struct EpiScale {
    static constexpr bool PERM = true, AFTER_DRAIN = false;
    bf16_t* O; int ldc; const float* st; int st_off, st_cnt; float inv_n; float* stat_out; int nt;
    __device__ __forceinline__ bool stores16() const { return true; }
    __device__ __forceinline__ void operator()(const f32x4 (&acc)[2][2][4][2], const Unit& u, int wr, int wc, int fr, int fq) const {
        asm volatile("" : "+v"(fr), "+v"(fq));
        const int row0 = u.pm * BM + wr * 64 + fr, col0 = u.pn * BM + wc * 64 + 8 * fq;
        float rsv[2][4];
        row_rs8(rsv, st, row0, st_off, st_cnt, inv_n, fq);
        asm volatile("" ::: "memory");
#pragma unroll
        for (int ai = 0; ai < 2; ++ai)
#pragma unroll
            for (int m = 0; m < 4; ++m) {
                const int row = row0 + ai * HALF + m * 16;
                const float rs = rsv[ai][m];
                bf16_t* rowp = O + (size_t)row * ldc + col0;
#pragma unroll
                for (int bj = 0; bj < 2; ++bj) {
                    f32x4 v0 = acc[ai][bj][m][0] * rs, v1 = acc[ai][bj][m][1] * rs;
                    if (ACT == 1) {
#pragma unroll
                        for (int e = 0; e < 4; ++e) { const float a = fmaxf(v0[e], 0.f), b = fmaxf(v1[e], 0.f); v0[e] = a * a; v1[e] = b * b; }
                    }
                    if (STAT) {
                        float q = (v0[0] * v0[0] + v0[1] * v0[1]) + (v0[2] * v0[2] + v0[3] * v0[3]) + (v1[0] * v1[0] + v1[1] * v1[1]) + (v1[2] * v1[2] + v1[3] * v1[3]);
                        q = xl::add32(xl::add16(q));
                        if (fq == 0) stat_out[(size_t)row * 16 + u.pn * 8 + wc * 2 + bj] = q;
                    }
                    u32x4 w; w.x = cvt_pk_bf16(v0[0], v0[1]); w.y = cvt_pk_bf16(v0[2], v0[3]); w.z = cvt_pk_bf16(v1[0], v1[1]); w.w = cvt_pk_bf16(v1[2], v1[3]);
                    if (ACT == 1 || nt) __builtin_nontemporal_store(w, (u32x4*)(rowp + bj * 32));
                    else *(u32x4*)(rowp + bj * 32) = w;
                }
            }
    }
};
struct EpiSq {
    static constexpr bool PERM = true, AFTER_DRAIN = false;
    bf16_t* O; int ldc;
    __device__ __forceinline__ bool stores16() const { return true; }
    __device__ __forceinline__ void operator()(const f32x4 (&acc)[2][2][4][2], const Unit& u, int wr, int wc, int fr, int fq) const {
        asm volatile("" : "+v"(fr), "+v"(fq));
        const int row0 = u.pm * BM + wr * 64 + fr, col0 = u.pn * BM + wc * 64 + 8 * fq;
#pragma unroll
        for (int ai = 0; ai < 2; ++ai)
#pragma unroll
            for (int m = 0; m < 4; ++m) {
                bf16_t* rowp = O + (size_t)(row0 + ai * HALF + m * 16) * ldc + col0;
#pragma unroll
                for (int bj = 0; bj < 2; ++bj) {
                    f32x4 v0 = acc[ai][bj][m][0], v1 = acc[ai][bj][m][1];
#pragma unroll
                    for (int e = 0; e < 4; ++e) { const float a = fmaxf(v0[e], 0.f), b = fmaxf(v1[e], 0.f); v0[e] = a * a; v1[e] = b * b; }
                    u32x4 w; w.x = cvt_pk_bf16(v0[0], v0[1]); w.y = cvt_pk_bf16(v0[2], v0[3]); w.z = cvt_pk_bf16(v1[0], v1[1]); w.w = cvt_pk_bf16(v1[2], v1[3]);
                    __builtin_nontemporal_store(w, (u32x4*)(rowp + bj * 32));
                }
            }
    }
};
struct EpiRes {
    static constexpr bool PERM = true, AFTER_DRAIN = false;
    bf16_t* xb; float* ssq; float* outf; int dry;
    __device__ __forceinline__ bool stores16() const { return dry == 0; }
    const float* sin;
    __device__ __forceinline__ void operator()(const f32x4 (&acc)[2][2][4][2], const Unit& u, int wr, int wc, int fr, int fq) const {
        if (dry) return;
        asm volatile("" : "+v"(fr), "+v"(fq));
        const int row0 = u.pm * BM + wr * 64 + fr, col0 = u.pn * BM + wc * 64 + 8 * fq;
#pragma unroll
        for (int ai = 0; ai < 2; ++ai) {
            u32x4 pre[4][2];
            f32x4 sv[4]; float r2[4] = {1.f, 1.f, 1.f, 1.f};
            if (sin) {
#pragma unroll
                for (int m = 0; m < 4; ++m) sv[m] = *(const f32x4*)(sin + (size_t)(row0 + ai * HALF + m * 16) * 16 + 4 * fq);
            }
#pragma unroll
            for (int m = 0; m < 4; ++m)
#pragma unroll
                for (int bj = 0; bj < 2; ++bj) pre[m][bj] = *(const u32x4*)(xb + (size_t)(row0 + ai * HALF + m * 16) * 1024 + col0 + bj * 32);
            if (sin) {
#pragma unroll
                for (int m = 0; m < 4; ++m) { float s = (sv[m][0] + sv[m][1]) + (sv[m][2] + sv[m][3]); s = xl::add32(xl::add16(s)); r2[m] = __builtin_amdgcn_rcpf(s * (1.0f / 1024.0f) + 1e-6f); }
            }
#pragma unroll
            for (int m = 0; m < 4; ++m) {
                const int row = row0 + ai * HALF + m * 16; const size_t off = (size_t)row * 1024 + col0; float q = 0.f;
#pragma unroll
                for (int bj = 0; bj < 2; ++bj) {
                    const u32x4 p = pre[m][bj];
                    f32x4 o0 = acc[ai][bj][m][0] * r2[m], o1 = acc[ai][bj][m][1] * r2[m];
                    o0[0] += __uint_as_float(p.x << 16); o0[1] += __uint_as_float(p.x & 0xffff0000u); o0[2] += __uint_as_float(p.y << 16); o0[3] += __uint_as_float(p.y & 0xffff0000u);
                    o1[0] += __uint_as_float(p.z << 16); o1[1] += __uint_as_float(p.z & 0xffff0000u); o1[2] += __uint_as_float(p.w << 16); o1[3] += __uint_as_float(p.w & 0xffff0000u);
                    q += ((o0[0] * o0[0] + o0[1] * o0[1]) + (o0[2] * o0[2] + o0[3] * o0[3])) + ((o1[0] * o1[0] + o1[1] * o1[1]) + (o1[2] * o1[2] + o1[3] * o1[3]));
                    u32x4 w; w.x = cvt_pk_bf16(o0[0], o0[1]); w.y = cvt_pk_bf16(o0[2], o0[3]); w.z = cvt_pk_bf16(o1[0], o1[1]); w.w = cvt_pk_bf16(o1[2], o1[3]);
                    if (outf) { __builtin_nontemporal_store(o0, (f32x4*)(outf + off + bj * 32)); __builtin_nontemporal_store(o1, (f32x4*)(outf + off + bj * 32 + 4)); }
                    else *(u32x4*)(xb + off + bj * 32) = w;
                }
                q = xl::add32(xl::add16(q));
                if (fq == 0 && !outf) ssq[(size_t)row * 16 + u.pn * 4 + wc] = q;
            }
            asm volatile("" ::: "memory");
        }
    }
};
template <class Epi, class Sched, bool ALIGN_EPI = false, bool SP2 = false>
__device__ __forceinline__ void gemm_phase(PG8_LAS unsigned char* lds, const Gemm g, const Sched& S, const Epi& E, const int wave_id) {
    int lane_; asm volatile("v_mbcnt_lo_u32_b32 %0, -1, 0\n\tv_mbcnt_hi_u32_b32 %0, -1, %0" : "=v"(lane_));
    const int tid = wave_id * 64 + lane_;
    const int wid = wave_id, lane = tid & 63, wr = wid >> 2, wc = wid & 3, fr = lane & 15, fq = lane >> 4;
    const int K = g.K, nt = K / BK;
    unsigned voffA[2], voffB[2];
#pragma unroll
    for (int i = 0; i < 2; ++i) { int R, C; stage_rc(tid * 16 + i * 8192, R, C); const int Rb = Epi::PERM ? ((R & ~31) + perm32(R & 31)) : R;
        voffA[i] = (unsigned)(R * g.lda + C) * 2u; voffB[i] = (unsigned)(Rb * g.ldb + C) * 2u; }
    const size_t kstep = (size_t)(BK * 2);
    const size_t hstepA = (size_t)HALF * g.lda * 2, hstepB = (size_t)HALF * g.ldb * 2;
    const size_t tstepA = 2 * hstepA, tstepB = 2 * hstepB;
    const unsigned ldsw = (unsigned)wid * 1024u;
    const int aoff = lds_byte(wr * 64 + fr, fq * 8), boff = lds_byte(wc * 32 + fr, fq * 8);
#define PG8_SA(b, h) (((b) * 2 + (h)) * HTB)
#define PG8_SB(b, h) ((4 + (b) * 2 + (h)) * HTB)
#define PG8_STAGE(bufoff, gbase, voff) do { _Pragma("unroll") for (int _i = 0; _i < 2; ++_i) \
        __builtin_amdgcn_global_load_lds((const unsigned*)((const char*)(gbase) + (voff)[_i]), (PG8_LAS unsigned*)(lds + (bufoff) + ldsw + _i * 8192), 16, 0, 0); } while (0)
#define PG8_LDA(dst, b, h) do { _Pragma("unroll") for (int m = 0; m < 4; ++m) _Pragma("unroll") for (int k = 0; k < 2; ++k) dst[m][k] = *(const PG8_LAS bf16x8*)(lds + PG8_SA(b, h) + aoff + m * 2048 + k * 1024); } while (0)
#define PG8_LDB(dst, b, h) do { _Pragma("unroll") for (int n = 0; n < 2; ++n) _Pragma("unroll") for (int k = 0; k < 2; ++k) dst[n][k] = *(const PG8_LAS bf16x8*)(lds + PG8_SB(b, h) + boff + n * 2048 + k * 1024); } while (0)
#define PG8_MMA(ai, bj, At, Bt) do { __builtin_amdgcn_s_setprio(1); _Pragma("unroll") for (int m = 0; m < 4; ++m) _Pragma("unroll") for (int n = 0; n < 2; ++n) _Pragma("unroll") for (int k = 0; k < 2; ++k) \
        acc[ai][bj][m][n] = __builtin_amdgcn_mfma_f32_16x16x32_bf16(Bt[n][k], At[m][k], acc[ai][bj][m][n], 0, 0, 0); __builtin_amdgcn_s_setprio(0); } while (0)
#define PG8_WAIT_V(n) asm volatile("s_waitcnt vmcnt(" #n ")" ::: "memory")
#define PG8_WAIT_V_RLX(r) asm volatile("s_cmp_lg_u32 %0, 0\n\ts_cbranch_scc0 .Lpgw8_%=\n\ts_waitcnt vmcnt(24)\n\ts_branch .Lpgwe_%=\n.Lpgw8_%=:\n\ts_waitcnt vmcnt(8)\n.Lpgwe_%=:" :: "s"(r) : "memory", "scc")
#define PG8_WAIT_L(n) asm volatile("s_waitcnt lgkmcnt(" #n ")" ::: "memory")
#define PG8_BAR __builtin_amdgcn_s_barrier()
#define PG8_SCHED __builtin_amdgcn_sched_barrier(0)
    Unit cur, nxt; int ui = 0;
    if (!S.next(0, cur)) return;
    f32x4 acc[2][2][4][2];
#pragma unroll
    for (int a = 0; a < 2; ++a)
#pragma unroll
        for (int b = 0; b < 2; ++b)
#pragma unroll
            for (int m = 0; m < 4; ++m)
#pragma unroll
                for (int n = 0; n < 2; ++n) acc[a][b][m][n] = (f32x4){0.f, 0.f, 0.f, 0.f};
    bf16x8 At[4][2], B0[2][2], B1[2][2];
    const char* cA = (const char*)g.A + (size_t)cur.pm * tstepA; const char* cB = (const char*)g.Bt + (size_t)cur.pn * tstepB;
    S.a_ready(cur);
    if constexpr (SP2) {
        PG8_STAGE(PG8_SB(0, 0), cB, voffB); PG8_STAGE(PG8_SB(0, 1), cB + hstepB, voffB); PG8_STAGE(PG8_SA(0, 0), cA, voffA); PG8_STAGE(PG8_SA(0, 1), cA + hstepA, voffA);
        if (wr == 1) PG8_BAR;
        PG8_WAIT_V(2); PG8_BAR;
        PG8_STAGE(PG8_SB(1, 0), cB + kstep, voffB); PG8_STAGE(PG8_SA(1, 0), cA + kstep, voffA); PG8_STAGE(PG8_SB(1, 1), cB + hstepB + kstep, voffB);
        PG8_WAIT_V(6); PG8_BAR;
    } else {
        PG8_STAGE(PG8_SB(0, 0), cB, voffB); PG8_STAGE(PG8_SA(0, 0), cA, voffA); PG8_STAGE(PG8_SB(0, 1), cB + hstepB, voffB); PG8_STAGE(PG8_SA(0, 1), cA + hstepA, voffA);
        if (wr == 1) PG8_BAR;
        PG8_WAIT_V(4); PG8_BAR;
        PG8_STAGE(PG8_SB(1, 0), cB + kstep, voffB); PG8_STAGE(PG8_SA(1, 0), cA + kstep, voffA); PG8_STAGE(PG8_SB(1, 1), cB + hstepB + kstep, voffB);
        PG8_WAIT_V(6); PG8_BAR;
    }
    bool after_epi = false;
    for (;;) {
        const bool has_next = S.next(ui + 1, nxt);
        const char* nA = has_next ? (const char*)g.A + (size_t)nxt.pm * tstepA : cA; const char* nB = has_next ? (const char*)g.Bt + (size_t)nxt.pn * tstepB : cB;
        for (int t = 0; t < nt; t += 2) {
            const bool last = (t == nt - 2);
            const char* a1 = cA + (size_t)(t + 1) * kstep;
            const char* a2 = last ? nA : cA + (size_t)(t + 2) * kstep; const char* b2 = last ? nB : cB + (size_t)(t + 2) * kstep;
            const char* a3 = a2 + kstep; const char* b3 = b2 + kstep;
            if (last && has_next) S.a_ready(nxt);
            if constexpr (SP2) {
            const int rlx = __builtin_amdgcn_readfirstlane((after_epi && (t == 0)) ? 1 : 0);
            PG8_LDB(B0, 0, 0); PG8_LDB(B1, 0, 1); PG8_SCHED; PG8_LDA(At, 0, 0); PG8_STAGE(PG8_SA(1, 1), a1 + hstepA, voffA);
            PG8_WAIT_V_RLX(rlx);
            PG8_WAIT_L(0); PG8_BAR; PG8_MMA(0, 0, At, B0); PG8_MMA(0, 1, At, B1); PG8_BAR; PG8_SCHED;
            PG8_LDA(At, 0, 1); PG8_STAGE(PG8_SB(0, 0), b2, voffB); PG8_STAGE(PG8_SB(0, 1), b2 + hstepB, voffB); PG8_STAGE(PG8_SA(0, 0), a2, voffA);
            PG8_WAIT_V_RLX(rlx);
            PG8_WAIT_L(0); PG8_BAR; PG8_MMA(1, 0, At, B0); PG8_MMA(1, 1, At, B1); PG8_BAR; PG8_SCHED;
            PG8_LDB(B0, 1, 0); PG8_LDB(B1, 1, 1); PG8_SCHED; PG8_LDA(At, 1, 0); PG8_STAGE(PG8_SA(0, 1), a2 + hstepA, voffA);
            PG8_WAIT_V(8); PG8_WAIT_L(0); PG8_BAR; PG8_MMA(0, 0, At, B0); PG8_MMA(0, 1, At, B1); PG8_BAR; PG8_SCHED;
            PG8_LDA(At, 1, 1); PG8_STAGE(PG8_SB(1, 0), b3, voffB); PG8_STAGE(PG8_SB(1, 1), b3 + hstepB, voffB); PG8_STAGE(PG8_SA(1, 0), a3, voffA);
            PG8_WAIT_V(8); PG8_WAIT_L(0); PG8_BAR; PG8_MMA(1, 0, At, B0); PG8_MMA(1, 1, At, B1); PG8_BAR; PG8_SCHED;
            } else {
            PG8_LDB(B0, 0, 0); PG8_SCHED; PG8_LDA(At, 0, 0); PG8_STAGE(PG8_SA(1, 1), a1 + hstepA, voffA);
            PG8_WAIT_L(8); PG8_BAR; PG8_WAIT_L(0); PG8_MMA(0, 0, At, B0); PG8_BAR; PG8_SCHED;
            PG8_LDB(B1, 0, 1); PG8_STAGE(PG8_SB(0, 0), b2, voffB);
            PG8_BAR; PG8_WAIT_L(0); PG8_MMA(0, 1, At, B1); PG8_BAR;
            PG8_LDA(At, 0, 1); PG8_STAGE(PG8_SA(0, 0), a2, voffA);
            PG8_BAR; PG8_WAIT_L(0); PG8_MMA(1, 0, At, B0); PG8_BAR; PG8_SCHED;
            PG8_STAGE(PG8_SB(0, 1), b2 + hstepB, voffB);
            PG8_WAIT_V(6); PG8_BAR; PG8_MMA(1, 1, At, B1); PG8_BAR;
            PG8_LDB(B0, 1, 0); PG8_SCHED; PG8_LDA(At, 1, 0); PG8_STAGE(PG8_SA(0, 1), a2 + hstepA, voffA);
            PG8_WAIT_L(8); PG8_BAR; PG8_WAIT_L(0); PG8_MMA(0, 0, At, B0); PG8_BAR; PG8_SCHED;
            PG8_LDB(B1, 1, 1); PG8_STAGE(PG8_SB(1, 0), b3, voffB);
            PG8_BAR; PG8_WAIT_L(0); PG8_MMA(0, 1, At, B1); PG8_BAR;
            PG8_LDA(At, 1, 1); PG8_STAGE(PG8_SA(1, 0), a3, voffA);
            PG8_BAR; PG8_WAIT_L(0); PG8_MMA(1, 0, At, B0); PG8_BAR; PG8_SCHED;
            PG8_STAGE(PG8_SB(1, 1), b3 + hstepB, voffB);
            PG8_WAIT_V(6); PG8_BAR; PG8_MMA(1, 1, At, B1); PG8_BAR;
            }
        }
        if constexpr (ALIGN_EPI) { if (wr == 0) PG8_BAR; }
        if constexpr (!Epi::AFTER_DRAIN) { int le_; asm volatile("v_mbcnt_lo_u32_b32 %0, -1, 0\n\tv_mbcnt_hi_u32_b32 %0, -1, %0" : "=v"(le_)); E(acc, cur, wr, wc, le_ & 15, le_ >> 4); S.done(cur); }
        if (!has_next) break;
#pragma unroll
        for (int a = 0; a < 2; ++a)
#pragma unroll
            for (int b = 0; b < 2; ++b)
#pragma unroll
                for (int m = 0; m < 4; ++m)
#pragma unroll
                    for (int n = 0; n < 2; ++n) acc[a][b][m][n] = (f32x4){0.f, 0.f, 0.f, 0.f};
        cur = nxt; cA = nA; cB = nB; ++ui; after_epi = E.stores16();
        if constexpr (ALIGN_EPI) { if (wr == 1) PG8_BAR; }
    }
    PG8_WAIT_V(0);
    if constexpr (!ALIGN_EPI) { if (wr == 0) PG8_BAR; }
    PG8_BAR;
    if constexpr (Epi::AFTER_DRAIN) { E.fused(acc, cur, wr, wc, fr, fq, lds, wid, lane); S.done(cur); }
#undef PG8_SA
#undef PG8_SB
#undef PG8_STAGE
#undef PG8_LDA
#undef PG8_LDB
#undef PG8_MMA
#undef PG8_WAIT_V
#undef PG8_WAIT_V_RLX
#undef PG8_WAIT_L
#undef PG8_BAR
#undef PG8_SCHED
}
}
#define GAS __attribute__((address_space(1)))
#define LAS __attribute__((address_space(3)))
typedef unsigned short bf16;
typedef unsigned v4u __attribute__((ext_vector_type(4)));
typedef float f32x4 __attribute__((ext_vector_type(4)));
typedef short bf16x8 __attribute__((ext_vector_type(8)));
typedef GAS unsigned gu32;
typedef GAS unsigned long long gu64;
#define RLX_AGENT __ATOMIC_RELAXED, __HIP_MEMORY_SCOPE_AGENT
#define LDS_WAIT() asm volatile("s_waitcnt lgkmcnt(0)" ::: "memory")
#define VM_WAIT() asm volatile("s_waitcnt vmcnt(0)" ::: "memory")
__device__ __forceinline__ unsigned long long rt() { return __builtin_amdgcn_s_memrealtime(); }
__device__ __forceinline__ unsigned f2bf(float f) { unsigned u = __builtin_bit_cast(unsigned, f); return (u + 0x7fffu + ((u >> 16) & 1u)) >> 16; }
__device__ __forceinline__ unsigned pk2(float lo, float hi) { return f2bf(lo) | (f2bf(hi) << 16); }
#define XB_TMO      128
#define XB_XCNT(j)  (256  + 64 * (j))
#define XB_XSUB(j)  (1280 + 64 * (j))
#define XB_XGEN(j)  (2304 + 64 * (j))
#define XB_TOP      3328
#define XB_TOPGEN   3392
#define XCD_BAR_WORDS 3456
#define XB_SPIN_CAP (1u << 18)

__device__ __forceinline__ unsigned xb_ld(unsigned* p)              { return __hip_atomic_load(p, __ATOMIC_RELAXED, __HIP_MEMORY_SCOPE_AGENT); }
__device__ __forceinline__ unsigned xb_add(unsigned* p, unsigned v) { return __hip_atomic_fetch_add(p, v, __ATOMIC_RELAXED, __HIP_MEMORY_SCOPE_AGENT); }
__device__ __forceinline__ unsigned xb_xcc_id() { return (unsigned)__builtin_amdgcn_s_getreg((3 << 11) | 20) & 0xFu; }
#define XB_SPIN(cond, bar) do { unsigned _sp = 0; while (cond) { __builtin_amdgcn_s_sleep(1); \
    if ((++_sp & 255u) == 0u) { if (xb_ld(&(bar)[XB_TMO])) break; if (_sp > XB_SPIN_CAP) { atomicAdd(&(bar)[XB_TMO], 1u); break; } } } } while (0)

struct XcdBarrier {
    unsigned* bar; unsigned x;
    volatile LAS unsigned* st;
};

__device__ __forceinline__ XcdBarrier xcd_barrier_post(unsigned* bar, volatile LAS unsigned* st) {
    XcdBarrier b; b.bar = bar; b.x = xb_xcc_id(); b.st = st;
    if (threadIdx.x == 0) (void)xb_add(&bar[XB_XCNT(b.x)], 1u);
    return b;
}
__device__ __forceinline__ void xcd_barrier_complete(unsigned* bar, unsigned x, unsigned& nloc, unsigned& nx) {
    const unsigned G = gridDim.x * gridDim.y * gridDim.z;
    unsigned sum, cnt, mine, sp = 0u;
    for (;;) {
        sum = 0u; cnt = 0u; mine = 0u;
#pragma unroll
        for (unsigned j = 0; j < 16; ++j) { const unsigned c = xb_ld(&bar[XB_XCNT(j)]); sum += c; cnt += (c > 0u) ? 1u : 0u; mine = (j == x) ? c : mine; }
        if (sum == G) break;
        __builtin_amdgcn_s_sleep(1);
        if ((++sp & 255u) == 0u) { if (xb_ld(&bar[XB_TMO])) break; if (sp > XB_SPIN_CAP) { atomicAdd(&bar[XB_TMO], 1u); break; } }
    }
    nloc = mine > 0u ? mine : 1u; nx = cnt > 0u ? cnt : 1u;
}

__device__ __forceinline__ void xcd_barrier(const XcdBarrier& b) {
    asm volatile("s_waitcnt vmcnt(0)" ::: "memory");
    __syncthreads();
    if (threadIdx.x == 0) {
        unsigned* bar = b.bar;
        __builtin_amdgcn_s_waitcnt(0);
        unsigned nloc = b.st[0], nx = b.st[1];
        if (nloc == 0u) { xcd_barrier_complete(bar, b.x, nloc, nx); b.st[0] = nloc; b.st[1] = nx; }
        const unsigned old = xb_add(&bar[XB_XSUB(b.x)], 1u);
        const unsigned gen = old / nloc;
        if (old + 1u == (gen + 1u) * nloc) {
            __builtin_amdgcn_fence(__ATOMIC_RELEASE, "agent");
            asm volatile("s_waitcnt vmcnt(0)" ::: "memory");
            const unsigned og = xb_add(&bar[XB_TOP], 1u);
            const unsigned tg = og / nx;
            if (og + 1u == (tg + 1u) * nx) xb_add(&bar[XB_TOPGEN], 1u);
            else XB_SPIN(xb_ld(&bar[XB_TOPGEN]) == tg, bar);
            __builtin_amdgcn_fence(__ATOMIC_ACQUIRE, "agent");
            xb_add(&bar[XB_XGEN(b.x)], 1u);
            asm volatile("s_waitcnt vmcnt(0)" ::: "memory");
        } else {
            XB_SPIN(xb_ld(&bar[XB_XGEN(b.x)]) == gen, bar);
            __builtin_amdgcn_fence(__ATOMIC_ACQUIRE, "agent");
            asm volatile("s_waitcnt vmcnt(0)" ::: "memory");
        }
    }
    __syncthreads();
}

typedef short s16x4 __attribute__((ext_vector_type(4)));
typedef float f32x16 __attribute__((ext_vector_type(16)));
typedef unsigned u32x2 __attribute__((ext_vector_type(2)));
typedef LAS unsigned char* ldsp;

constexpr int NWAVES = 8, NTHR = 512;
constexpr int NTOK = 65536, SEQ = 4096, NBATCH = 16, DM = 1024, DFF = 4096;
constexpr int A_N = 1792, A_NREAL = 1736;
constexpr int A_K = 1024, A_V = 1088, A_QI = 1152, A_KI = 1664, A_WI = 1728;
constexpr int B_N = 1536;
constexpr int C_N1 = 512, C_N1REAL = 416;
constexpr int C_NQ = 1536, C_NKV = 2048;
constexpr float EPS = 1e-6f, LOG2E = 1.4426950408889634f;

constexpr size_t MiB = 1u << 20;
constexpr size_t WS_CTL = 0, CTL_ZERO_BYTES = 1 * MiB;
constexpr size_t WS_WUP = 1 * MiB, WS_WDN = 33 * MiB, WS_WAIN = 65 * MiB, WS_WAOUT = 72 * MiB, WS_WBIN = 76 * MiB, WS_WBOUT = 79 * MiB;
constexpr size_t WS_WCIN = 81 * MiB, WS_WQB = 82 * MiB, WS_WKVB = 83 * MiB, WS_WCOUT = 84 * MiB;
constexpr size_t WS_CS = 86 * MiB, WS_SSQ = 94 * MiB, WS_CSTAT = 98 * MiB, WS_XB = 102 * MiB, WS_R = 230 * MiB;
constexpr size_t R_U = 0, R_PA = 0, R_MASK = 224 * MiB, R_O = 256 * MiB, R_PB = 0, R_KN = 384 * MiB, R_VN = 392 * MiB;
constexpr size_t R_LAT = 0, R_Q = 64 * MiB, R_KV = 256 * MiB, R_KR = 512 * MiB, R_OC = 576 * MiB;
constexpr size_t WS_SSQ2 = WS_R + 704 * MiB;
constexpr size_t WS_END = WS_SSQ2 + 4 * MiB;
constexpr int CW_BAR = 4096;

constexpr int RING_BYTES = 131072, LDS_BYTES = 163840, LDSCTL_OFF = LDS_BYTES - 512, MISC_OFF = LDSCTL_OFF + 320;

__device__ __forceinline__ int phase_tid(int wave) { int l; asm volatile("v_mbcnt_lo_u32_b32 %0, -1, 0\n\tv_mbcnt_hi_u32_b32 %0, -1, %0" : "=v"(l)); return wave * 64 + l; }
__device__ __forceinline__ float bf2f(unsigned short v) { return __uint_as_float((unsigned)v << 16); }
__device__ __forceinline__ float bflo(unsigned w) { return __uint_as_float(w << 16); }
__device__ __forceinline__ float bfhi(unsigned w) { return __uint_as_float(w & 0xffff0000u); }
__device__ __forceinline__ unsigned cvtpk(float lo, float hi) { return pg8::cvt_pk_bf16(lo, hi); }
__device__ __forceinline__ float wave_sum(float v) {
    return xl::add32(xl::add16(xl::add8(xl::add4(xl::add2(xl::add1(v))))));
}
__device__ __forceinline__ s16x4 lds_tr(const LAS void* p) {
    typedef short v4i16_t __attribute__((ext_vector_type(4)));
    return __builtin_bit_cast(s16x4, __builtin_amdgcn_ds_read_tr16_b64_v4i16((LAS v4i16_t*)p));
}
__device__ __forceinline__ bf16x8 cat8(s16x4 a, s16x4 b) { return (bf16x8){a[0], a[1], a[2], a[3], b[0], b[1], b[2], b[3]}; }

__device__ __forceinline__ int t5_bucket(int n) {
    if (n < 16) return n;
    if (n >= 128) return 31;
    int b = 16 + (int)(logf((float)n * 0.0625f) * (16.0f / 2.0794415416798357f));
    return b > 31 ? 31 : b;
}

__device__ __forceinline__ void transpose_item(const float* __restrict__ W, int K, int Kreal, int Nreal, bf16* WT, const float* __restrict__ gain, LAS float* scr, int item, int nblk, int lane) {
    const int kb = item / nblk, nb = item % nblk, k0 = 64 * kb, n0 = 64 * nb;
    const int nq = n0 + 4 * (lane & 15);
    const bool vec = ((Nreal & 3) == 0) && (nq + 3 < Nreal);
    f32x4 vv[16]; float gg[16];
#pragma unroll
    for (int i = 0; i < 16; ++i) {
        const int kk = 4 * i + (lane >> 4); vv[i] = (f32x4){0.f, 0.f, 0.f, 0.f}; gg[i] = 1.0f;
        if (k0 + kk < Kreal) {
            const float* rp = W + (size_t)(k0 + kk) * Nreal + nq;
            if (vec) vv[i] = *(const f32x4*)rp;
            else { if (nq + 0 < Nreal) vv[i][0] = rp[0]; if (nq + 1 < Nreal) vv[i][1] = rp[1]; if (nq + 2 < Nreal) vv[i][2] = rp[2]; if (nq + 3 < Nreal) vv[i][3] = rp[3]; }
            if (gain) gg[i] = gain[k0 + kk];
        }
    }
#pragma unroll
    for (int i = 0; i < 16; ++i) {
        const int kk = 4 * i + (lane >> 4);
        *(LAS f32x4*)(scr + kk * 68 + ((4 * (lane & 15) + 4 * (kk >> 3)) & 63)) = vv[i] * gg[i];
    }
    LDS_WAIT(); asm volatile("" ::: "memory");
    const int c = lane & 7;
#pragma unroll
    for (int j = 0; j < 8; ++j) { const int nn = (lane >> 3) + 8 * j; const LAS float* s = scr + (8 * c) * 68 + ((nn + 4 * c) & 63);
        v4u o; o.x = pk2(s[0 * 68], s[1 * 68]); o.y = pk2(s[2 * 68], s[3 * 68]); o.z = pk2(s[4 * 68], s[5 * 68]); o.w = pk2(s[6 * 68], s[7 * 68]);
        const int ncol = n0 + nn, cl = ncol & 255;
        const int brow = (ncol & ~255) + 128 * ((cl & 63) >> 5) + 32 * (cl >> 6) + (cl & 31);
        *(v4u*)(WT + (size_t)brow * K + k0 + 8 * c) = o; }
    LDS_WAIT(); asm volatile("" ::: "memory");
}

struct Ptrs {
    const float* in[24]; float* out; unsigned char* ws;
};

__device__ __forceinline__ void prologue(const Ptrs& P, ldsp lds, int gw, int NGW, int wave) {
    const int lane = phase_tid(wave) & 63;
    LAS float* scr = (LAS float*)(lds + wave * 17408);
    unsigned char* ws = P.ws;
    {
        constexpr int I_UP = 16 * 64, I_DN = 64 * 16, I_AIN = 16 * (A_N / 64), I_SQ = 16 * 16, I_BIN = 16 * (B_N / 64), I_CIN = 16 * (C_N1 / 64), I_QB = 4 * (C_NQ / 64), I_KVB = 2 * (C_NKV / 64);
        constexpr int E0 = 4 * I_UP, E1 = E0 + 4 * I_DN, E2 = E1 + 2 * I_AIN, E3 = E2 + 2 * I_SQ, E4 = E3 + I_BIN, E5 = E4 + I_SQ, E6 = E5 + I_CIN, E7 = E6 + I_QB, E8 = E7 + I_KVB, E9 = E8 + I_SQ;
#pragma unroll 1
        for (int it = gw; it < E9; it += NGW) {
            const float* src; const float* gain = nullptr; bf16* dst; int KK = DM, NREAL = DM, NPAD = DM, li, KREAL = 0;
            if (it < E0)      { const int l = it / I_UP; li = it - l * I_UP; src = P.in[5] + (size_t)l * DM * DFF; NREAL = DFF; NPAD = DFF; dst = (bf16*)(ws + WS_WUP + (size_t)l * 8 * MiB); gain = P.in[4] + l * DM; }
            else if (it < E1) { const int l = (it - E0) / I_DN; li = it - E0 - l * I_DN; src = P.in[6] + (size_t)l * DM * DFF; KK = DFF; dst = (bf16*)(ws + WS_WDN + (size_t)l * 8 * MiB); }
            else if (it < E2) { const int i = (it - E1) / I_AIN; li = it - E1 - i * I_AIN; src = P.in[7] + (size_t)i * DM * A_NREAL; NREAL = A_NREAL; NPAD = A_N; dst = (bf16*)(ws + WS_WAIN + (size_t)i * (A_N * DM * 2)); gain = P.in[3] + (i == 0 ? 0 : 3) * DM; }
            else if (it < E3) { const int i = (it - E2) / I_SQ; li = it - E2 - i * I_SQ; src = P.in[10] + (size_t)i * DM * DM; dst = (bf16*)(ws + WS_WAOUT + (size_t)i * 2 * MiB); }
            else if (it < E4) { li = it - E3; src = P.in[11]; NREAL = B_N; NPAD = B_N; dst = (bf16*)(ws + WS_WBIN); gain = P.in[3] + 1 * DM; }
            else if (it < E5) { li = it - E4; src = P.in[15]; dst = (bf16*)(ws + WS_WBOUT); }
            else if (it < E6) { li = it - E5; src = P.in[16]; NREAL = C_N1REAL; NPAD = C_N1; dst = (bf16*)(ws + WS_WCIN); gain = P.in[3] + 2 * DM; }
            else if (it < E7) { li = it - E6; src = P.in[18]; KK = 256; NREAL = C_NQ; NPAD = C_NQ; dst = (bf16*)(ws + WS_WQB); gain = P.in[17]; }
            else if (it < E8) { li = it - E7; src = P.in[20]; KK = 128; NREAL = C_NKV; NPAD = C_NKV; dst = (bf16*)(ws + WS_WKVB); gain = P.in[19]; }
            else              { li = it - E8; src = P.in[23]; dst = (bf16*)(ws + WS_WCOUT); }
            transpose_item(src, KK, KREAL ? KREAL : KK, NREAL, dst, gain, scr, li, NPAD / 64, lane);
        }
    }
    {
        const float* x = P.in[0]; bf16* xb = (bf16*)(ws + WS_XB); float* ssq = (float*)(ws + WS_SSQ);
        for (int m0 = gw; m0 < NTOK; m0 += 2 * NGW) {
            f32x4 v[2][4];
#pragma unroll
            for (int rr = 0; rr < 2; ++rr) { const int m = m0 + rr * NGW; if (m < NTOK) { const f32x4* xr = (const f32x4*)(x + (size_t)m * DM) + lane;
#pragma unroll
                for (int j = 0; j < 4; ++j) v[rr][j] = xr[64 * j]; } }
#pragma unroll
            for (int rr = 0; rr < 2; ++rr) { const int m = m0 + rr * NGW; if (m < NTOK) {
                float s = 0.f;
#pragma unroll
                for (int j = 0; j < 4; ++j) s += (v[rr][j][0] * v[rr][j][0] + v[rr][j][1] * v[rr][j][1]) + (v[rr][j][2] * v[rr][j][2] + v[rr][j][3] * v[rr][j][3]);
                s = wave_sum(s);
                u32x2* o8 = (u32x2*)(xb + (size_t)m * DM) + lane;
#pragma unroll
                for (int j = 0; j < 4; ++j) { u32x2 w; w.x = pk2(v[rr][j][0], v[rr][j][1]); w.y = pk2(v[rr][j][2], v[rr][j][3]); o8[64 * j] = w; }
                if (lane < 16) ssq[(size_t)m * 16 + lane] = (lane == 0) ? s : 0.f; } }
        }
    }
    {
        const int* pos = (const int*)P.in[1]; float* cs = (float*)(ws + WS_CS);
        const int gt = gw * 64 + lane, NGT = NGW * 64;
        const int i = gt & 15;
        double inv_freq = 1.0; for (int k = 0; k < i; ++k) inv_freq *= 0.5623413251903491;
        for (int e0 = gt; e0 < NTOK * 16; e0 += 8 * NGT) {
            int pv[8];
#pragma unroll
            for (int u = 0; u < 8; ++u) { const int e = e0 + u * NGT; pv[u] = (e < NTOK * 16) ? pos[e >> 4] : 0; }
#pragma unroll
            for (int u = 0; u < 8; ++u) { const int e = e0 + u * NGT;
                if (e < NTOK * 16) {
                    const double rev = (double)pv[u] * inv_freq * 0.15915494309189535;
                    const float fr = (float)(rev - floor(rev));
                    pg8::f32x2 o; o[0] = __builtin_amdgcn_cosf(fr); o[1] = __builtin_amdgcn_sinf(fr);
                    *(pg8::f32x2*)(cs + 2 * (size_t)e) = o; } }
        }
    }
}

constexpr int A2_CAP = 64;
#ifndef A2DUP
#define A2DUP 0
#endif
constexpr int A2_QS = 8208;
constexpr int A2_T = 0, A2_MASK = 16 * A2_QS, A2_CAND = A2_MASK + 8192, A2_CCNT = A2_CAND + 8192;
__device__ __forceinline__ void phase_a2(ldsp lds, bf16* PA, unsigned* maskOut, f32x4* scr  , bf16* KN, bf16* VN  , const float* kgain, int vcu, int G, int wave) {
    const int w = wave;
    LAS unsigned* mask32 = (LAS unsigned*)(lds + A2_MASK);
    LAS unsigned long long* candk = (LAS unsigned long long*)(lds + A2_CAND);
    LAS unsigned* ccnt = (LAS unsigned*)(lds + A2_CCNT);
    { const int tid = phase_tid(wave); if (tid < 16) ccnt[tid] = 0u; }
    __syncthreads();
    int sbuf = 0;
    unsigned pm0 = 0u, pm1 = 0u, pm2 = 0u, pm3 = 0u; int prow = -1;
#define A2_FLUSH() do { if (prow >= 0) { const int m_ = phase_tid(wave) & 31; unsigned* mp_ = maskOut + (size_t)prow * 128 + m_; mp_[0] = pm0; mp_[32] = pm1; mp_[64] = pm2; mp_[96] = pm3; prow = -1; } } while (0)
    for (int p = vcu; p < 2048; p += G) {
#pragma unroll 1
      for (int half = 0; half < 2; ++half) {
        const int b = p >> 7, pr = p & 127, qt = half ? 255 - pr : pr, t0 = 16 * qt;
        const size_t rowbase = (size_t)b * SEQ;
        const int NT = qt + 1;
        const float NINF = -__builtin_inff();
        const f32x4* scrb = scr + (size_t)sbuf * 16384;
        _Pragma("unroll 1") for (int rp_ = 0; rp_ < 1 + (A2DUP & 1); ++rp_)
        {
            const int tid = phase_tid(wave); const int lane = tid & 63, j = lane & 15, g = lane >> 4; (void)lane; (void)j; (void)g;
            const int r16 = (tid >> 4) & 15, c4 = tid & 15;
            const u32x2 kvraw = *(const u32x2*)(PA + (rowbase + t0 + r16) * A_N + (tid < 256 ? A_K : A_V) + 4 * c4);
            const int nslots = (qt < 16) ? 0 : ((NT - w + 7) >> 3);
            const GAS bf16* kp = (const GAS bf16*)(PA + (rowbase + 16 * w + j) * A_N + A_KI + 8 * g);
            bf16x8 ring[4][2];
#pragma unroll
            for (int u = 0; u < 4; ++u) { ring[u][0] = *(const GAS bf16x8*)kp; ring[u][1] = *(const GAS bf16x8*)(kp + 32); kp += (size_t)128 * A_N; asm volatile("" : "+v"(kp)); }
            bf16x8 qb[8][2]; float wh[8]; v4u wr = (v4u){0u, 0u, 0u, 0u};
            if (qt >= 16) {
                const bf16* qrow = PA + (rowbase + t0 + j) * A_N;
#pragma unroll
                for (int h = 0; h < 8; ++h)
#pragma unroll
                    for (int ks = 0; ks < 2; ++ks) qb[h][ks] = *(const bf16x8*)(qrow + A_QI + 64 * h + 32 * ks + 8 * g);
                wr = *(const v4u*)(qrow + A_WI);
            }
            A2_FLUSH();
            if (tid < 256) {
                float k0 = bflo(kvraw.x), k1 = bfhi(kvraw.x), k2 = bflo(kvraw.y), k3 = bfhi(kvraw.y);
                float s = (k0 * k0 + k1 * k1) + (k2 * k2 + k3 * k3);
                s = xl::add8(xl::add4(xl::add2(xl::add1(s))));
                const float rs = 1.0f / sqrtf(s * (1.0f / 64.0f) + EPS);
                const f32x4 gk = *(const f32x4*)(kgain + 4 * c4);
                u32x2 o; o.x = cvtpk(k0 * rs * gk[0], k1 * rs * gk[1]); o.y = cvtpk(k2 * rs * gk[2], k3 * rs * gk[3]); *(u32x2*)(KN + (rowbase + t0 + r16) * 64 + 4 * c4) = o;
            } else {
                *(u32x2*)(VN + (rowbase + t0 + r16) * 64 + 4 * c4) = kvraw;
            }
            if (qt < 16) {
                for (int e = tid; e < 2048; e += NTHR) { const int q = e >> 7, wi = e & 127; const int nb = t0 + q + 1 - 32 * wi;
                    maskOut[(rowbase + t0 + q) * 128 + wi] = nb >= 32 ? 0xffffffffu : (nb <= 0 ? 0u : ((1u << nb) - 1u)); }
                break;
            }
            const float wsc = 0.5f * 0.35355339059327373f * 0.125f;
            wh[0] = bflo(wr.x) * wsc; wh[1] = bfhi(wr.x) * wsc; wh[2] = bflo(wr.y) * wsc; wh[3] = bfhi(wr.y) * wsc;
            wh[4] = bflo(wr.z) * wsc; wh[5] = bfhi(wr.z) * wsc; wh[6] = bflo(wr.w) * wsc; wh[7] = bfhi(wr.w) * wsc;
            bf16x8 ql[2];
#pragma unroll
            for (int ks = 0; ks < 2; ++ks) {
                float acc8[8] = {0.f, 0.f, 0.f, 0.f, 0.f, 0.f, 0.f, 0.f};
#pragma unroll
                for (int h = 0; h < 8; ++h) { const v4u qw = __builtin_bit_cast(v4u, qb[h][ks]);
                    acc8[0] += wh[h] * bflo(qw.x); acc8[1] += wh[h] * bfhi(qw.x); acc8[2] += wh[h] * bflo(qw.y); acc8[3] += wh[h] * bfhi(qw.y);
                    acc8[4] += wh[h] * bflo(qw.z); acc8[5] += wh[h] * bfhi(qw.z); acc8[6] += wh[h] * bflo(qw.w); acc8[7] += wh[h] * bfhi(qw.w); }
                v4u o; o.x = cvtpk(acc8[0], acc8[1]); o.y = cvtpk(acc8[2], acc8[3]); o.z = cvtpk(acc8[4], acc8[5]); o.w = cvtpk(acc8[6], acc8[7]);
                ql[ks] = __builtin_bit_cast(bf16x8, o);
            }
            GAS char* spw = (GAS char*)(scr + (size_t)sbuf * 16384) + (size_t)w * 64; asm volatile("" : "+s"(spw));
            const unsigned voff = (unsigned)j * 16384u + (unsigned)g * 16u;
            const unsigned toff = (unsigned)j * A2_QS + (unsigned)g * 16u + (unsigned)w * 64u;
            const int ngroups = (((NT + 7) >> 3) + 3) >> 2;
#define A2_TILE(i_, u_, STORE_) do { \
                    const int kt_ = w + 8 * (i_); \
                    const bf16x8 ka0 = ring[u_][0], ka1 = ring[u_][1]; \
                    f32x4 s = __builtin_amdgcn_mfma_f32_16x16x32_bf16(ka0, ql[0], (f32x4){0.f, 0.f, 0.f, 0.f}, 0, 0, 0); \
                    s = __builtin_amdgcn_mfma_f32_16x16x32_bf16(ka1, ql[1], s, 0, 0, 0); \
                    _Pragma("unroll") for (int h = 0; h < 8; ++h) { \
                        f32x4 a = __builtin_amdgcn_mfma_f32_16x16x32_bf16(ka0, qb[h][0], (f32x4){0.f, 0.f, 0.f, 0.f}, 0, 0, 0); \
                        a = __builtin_amdgcn_mfma_f32_16x16x32_bf16(ka1, qb[h][1], a, 0, 0, 0); \
                          \
                        _Pragma("unroll") for (int r = 0; r < 4; ++r) { float t_ = __builtin_fmaf(__builtin_fabsf(a[r]), wh[h], s[r]); asm volatile("" : "+v"(t_)); s[r] = t_; } } \
                    if (kt_ >= qt) { asm volatile("" ::: "memory");     \
                        _Pragma("unroll") for (int r = 0; r < 4; ++r) if (kt_ > qt || 4 * g + r > j) s[r] = NINF; } \
                    __builtin_amdgcn_sched_barrier(0);        \
                    ring[u_][0] = *(const GAS bf16x8*)kp; ring[u_][1] = *(const GAS bf16x8*)(kp + 32); \
                    __builtin_amdgcn_sched_barrier(0); \
                    STORE_; \
                    kp += (size_t)128 * A_N; asm volatile("" : "+v"(kp)); } while (0)
            const int ng_lds = ngroups < 4 ? ngroups : 4;
#pragma unroll 1
            for (int gi = 0; gi < ng_lds; ++gi) {
#pragma unroll
                for (int u = 0; u < 4; ++u) A2_TILE(4 * gi + u, u, *(LAS f32x4*)(lds + A2_T + toff + (unsigned)(4 * gi + u) * 512u) = s);
            }
#pragma unroll 1
            for (int gi = 4; gi < ngroups; ++gi) {
#pragma unroll
                for (int u = 0; u < 4; ++u) A2_TILE(4 * gi + u, u, *(GAS f32x4*)(spw + (size_t)(4 * gi + u) * 512 + voff) = s);
            }
#undef A2_TILE
        }
        if (qt < 16) continue;
        asm volatile("s_waitcnt vmcnt(0)" ::: "memory");
        __syncthreads();
        _Pragma("unroll 1") for (int rp_ = 0; rp_ < 1 + ((A2DUP >> 1) & 1); ++rp_)
        {
            const int tid = phase_tid(wave); const int lane = tid & 63, hq0 = lane >> 5, m0 = lane & 31, q0 = 2 * w + hq0;
#define A2_SQ ((const GAS f32x4*)scrb + (size_t)q0 * 1024 + m0)
            const int imax = (NT + 7) >> 3;
            f32x4 sc[32];
            {
                const LAS f32x4* tq = (const LAS f32x4*)(lds + A2_T + (unsigned)q0 * A2_QS) + m0;
#pragma unroll
                for (int gi = 0; gi < 8; ++gi) {
                    if (4 * gi < imax) {
#pragma unroll
                        for (int ii = 0; ii < 4; ++ii) { if (gi < 4) sc[4 * gi + ii] = tq[(4 * gi + ii) * 32]; else sc[4 * gi + ii] = A2_SQ[(4 * gi + ii) * 32]; }
                    } else {
#pragma unroll
                        for (int ii = 0; ii < 4; ++ii) sc[4 * gi + ii] = (f32x4){NINF, NINF, NINF, NINF};
                    }
                }
            }
            asm volatile("s_waitcnt lgkmcnt(0)" ::: "memory");
            __syncthreads();
            float mx = NINF, mn = __builtin_inff();
#pragma unroll
            for (int gi = 0; gi < 8; ++gi) {
                if (4 * gi < imax) {
#pragma unroll
                    for (int ii = 0; ii < 4; ++ii) { const int i = 4 * gi + ii; const f32x4 v = sc[i];
                        mx = fmaxf(fmaxf(mx, fmaxf(v[0], v[1])), fmaxf(v[2], v[3]));
                        if (i >= imax - 2) {
#pragma unroll
                            for (int r = 0; r < 4; ++r) mn = fminf(mn, v[r] == NINF ? __builtin_inff() : v[r]);
                        } else mn = fminf(fminf(mn, fminf(v[0], v[1])), fminf(v[2], v[3]));
                    }
                }
            }
            mx = xl::max16(xl::max8(xl::max4(xl::max2(xl::max1(mx))))); mn = xl::min16(xl::min8(xl::min4(xl::min2(xl::min1(mn)))));
            float lo = mn, hi = mx + (fabsf(mx) * 1e-6f + 1e-30f);
            int clo = t0 + q0 + 1, chi = 0; bool done = false, tie = false;
            for (int it = 0; it < 96; ++it) {
                if (!done && clo - chi <= A2_CAP) done = true;
                const float mid = 0.5f * (lo + hi);
                if (!done && !(mid > lo && mid < hi)) { tie = true; done = true; }
                if (__all(done)) break;
                int c0 = 0, c1 = 0, c2 = 0, c3 = 0;
#define A2_CNT16(A_) do { unsigned long long m0_, m1_, m2_; \
                    asm("v_cmp_ge_f32_e64 %[m0], %[a0], %[mid]\n\tv_cmp_ge_f32_e64 %[m1], %[a1], %[mid]\n\tv_cmp_ge_f32_e64 %[m2], %[a2], %[mid]\n\tv_addc_co_u32_e64 %[c0], %[m0], 0, %[c0], %[m0]\n\tv_cmp_ge_f32_e64 %[m0], %[a3], %[mid]\n\tv_addc_co_u32_e64 %[c1], %[m1], 0, %[c1], %[m1]\n\tv_cmp_ge_f32_e64 %[m1], %[a4], %[mid]\n\tv_addc_co_u32_e64 %[c2], %[m2], 0, %[c2], %[m2]\n\tv_cmp_ge_f32_e64 %[m2], %[a5], %[mid]\n\tv_addc_co_u32_e64 %[c3], %[m0], 0, %[c3], %[m0]\n\tv_cmp_ge_f32_e64 %[m0], %[a6], %[mid]\n\tv_addc_co_u32_e64 %[c0], %[m1], 0, %[c0], %[m1]\n\tv_cmp_ge_f32_e64 %[m1], %[a7], %[mid]\n\tv_addc_co_u32_e64 %[c1], %[m2], 0, %[c1], %[m2]\n\tv_cmp_ge_f32_e64 %[m2], %[a8], %[mid]\n\tv_addc_co_u32_e64 %[c2], %[m0], 0, %[c2], %[m0]\n\tv_cmp_ge_f32_e64 %[m0], %[a9], %[mid]\n\tv_addc_co_u32_e64 %[c3], %[m1], 0, %[c3], %[m1]\n\tv_cmp_ge_f32_e64 %[m1], %[a10], %[mid]\n\tv_addc_co_u32_e64 %[c0], %[m2], 0, %[c0], %[m2]\n\tv_cmp_ge_f32_e64 %[m2], %[a11], %[mid]\n\tv_addc_co_u32_e64 %[c1], %[m0], 0, %[c1], %[m0]\n\tv_cmp_ge_f32_e64 %[m0], %[a12], %[mid]\n\tv_addc_co_u32_e64 %[c2], %[m1], 0, %[c2], %[m1]\n\tv_cmp_ge_f32_e64 %[m1], %[a13], %[mid]\n\tv_addc_co_u32_e64 %[c3], %[m2], 0, %[c3], %[m2]\n\tv_cmp_ge_f32_e64 %[m2], %[a14], %[mid]\n\tv_addc_co_u32_e64 %[c0], %[m0], 0, %[c0], %[m0]\n\tv_cmp_ge_f32_e64 %[m0], %[a15], %[mid]\n\tv_addc_co_u32_e64 %[c1], %[m1], 0, %[c1], %[m1]\n\tv_addc_co_u32_e64 %[c2], %[m2], 0, %[c2], %[m2]\n\tv_addc_co_u32_e64 %[c3], %[m0], 0, %[c3], %[m0]" \
                        : [c0] "+v"(c0), [c1] "+v"(c1), [c2] "+v"(c2), [c3] "+v"(c3), [m0] "=&s"(m0_), [m1] "=&s"(m1_), [m2] "=&s"(m2_) \
                        : [a0] "v"(A_[0][0]), [a1] "v"(A_[0][1]), [a2] "v"(A_[0][2]), [a3] "v"(A_[0][3]), [a4] "v"(A_[1][0]), [a5] "v"(A_[1][1]), [a6] "v"(A_[1][2]), [a7] "v"(A_[1][3]), [a8] "v"(A_[2][0]), [a9] "v"(A_[2][1]), [a10] "v"(A_[2][2]), [a11] "v"(A_[2][3]), [a12] "v"(A_[3][0]), [a13] "v"(A_[3][1]), [a14] "v"(A_[3][2]), [a15] "v"(A_[3][3]), [mid] "v"(mid)); } while (0)
#pragma unroll
                for (int gi = 0; gi < 8; ++gi) {
                    if (4 * gi < imax) { const f32x4 (&G_)[4] = *(const f32x4 (*)[4])&sc[4 * gi]; A2_CNT16(G_); }
                }
#undef A2_CNT16
                int c = (c0 + c1) + (c2 + c3);
                c = xl::iadd16(xl::iadd8(xl::iadd4(xl::iadd2(xl::iadd1(c)))));
                if (!done) { if (c >= 256) { lo = mid; clo = c; } else { hi = mid; chi = c; } }
            }
            const int need = 256 - chi;
            const int lane2 = phase_tid(wave) & 63, m = lane2 & 31, q = 2 * w + (lane2 >> 5);
            const bool bigtie = tie && (clo - chi > A2_CAP);
            int J = -1;
            if (__any(bigtie)) {
                { GAS f32x4* sqw = (GAS f32x4*)A2_SQ;
#pragma unroll
                for (int i = 0; i < 16; ++i) sqw[i * 32] = sc[i]; }
                asm volatile("s_waitcnt vmcnt(0)" ::: "memory");
                int jlo = -1, jhi = SEQ - 1;
                for (int it = 0; it < 13; ++it) {
                    const int jm = (jlo + jhi) >> 1;
                    int c = 0;
#pragma unroll 1
                    for (int i = 0; i < 32; ++i) {
                        const f32x4 s4 = A2_SQ[i * 32];
#pragma unroll
                        for (int r = 0; r < 4; ++r) c += (s4[r] == lo && (4 * (i * 32 + m) + r) <= jm) ? 1 : 0;
                    }
                    c = xl::iadd16(xl::iadd8(xl::iadd4(xl::iadd2(xl::iadd1(c)))));
                    if (jhi - jlo > 1) { if (c >= need) jhi = jm; else jlo = jm; }
                }
                J = jhi;
            }
            {
                const float loc = bigtie ? hi : lo;
#pragma unroll
                for (int gi = 0; gi < 8; ++gi) {
                    if (4 * gi < imax) {
#pragma unroll
                        for (int ii = 0; ii < 4; ++ii) {
                            const int i = 4 * gi + ii;
                            unsigned bs = 0u, bc = 0u;
#pragma unroll
                            for (int r = 0; r < 4; ++r) { const float s = sc[i][r]; const unsigned a = (s >= hi) ? 1u : 0u, c = (s >= loc) ? 1u : 0u; bs |= a << r; bc |= (c & ~a) << r; }
                            unsigned v = bs << (4 * (m & 7));
                            v = xl::or4(xl::or2(xl::or1(v)));
                            if ((m & 7) == 0) mask32[q * 128 + 4 * i + (m >> 3)] = v;
                            if (bc) {
#pragma unroll
                                for (int r = 0; r < 4; ++r) if ((bc >> r) & 1u) {
                                    const unsigned pos = atomicAdd((unsigned*)(ccnt + q), 1u);
                                    if (pos < (unsigned)A2_CAP) {
                                        const unsigned sb_ = __float_as_uint(sc[i][r] + 0.0f), sk_ = sb_ ^ ((unsigned)((int)sb_ >> 31) | 0x80000000u);
                                        candk[q * A2_CAP + pos] = ((unsigned long long)sk_ << 32) | (unsigned long long)(~(unsigned)(4 * (i * 32 + m) + r)); }
                                }
                            }
                        }
                    } else {
#pragma unroll
                        for (int ii = 0; ii < 4; ++ii) if ((m & 7) == 0) mask32[q * 128 + 4 * (4 * gi + ii) + (m >> 3)] = 0u;
                    }
                }
            }
            LDS_WAIT(); asm volatile("" ::: "memory");
            if (__any(bigtie)) {
#pragma unroll 1
                for (int i = 0; i < 32; ++i) {
                    const f32x4 s4 = A2_SQ[i * 32];
#pragma unroll
                    for (int r = 0; r < 4; ++r) { const int idx = 4 * (i * 32 + m) + r;
                        if (bigtie && s4[r] == lo && idx <= J) atomicOr((unsigned*)(mask32 + q * 128 + (idx >> 5)), 1u << (idx & 31)); }
                }
            }
            {
                const int C = min((int)ccnt[q], A2_CAP), nd = bigtie ? 0 : need;
                LAS unsigned long long* cl = candk + q * A2_CAP;
                unsigned long long z_ = 0ull; asm volatile("" : "+v"(z_));
                if (m >= C) cl[m] = z_;
                if (m + 32 >= C) cl[m + 32] = z_;
                LDS_WAIT(); asm volatile("" ::: "memory");
                const unsigned long long me0 = cl[m], me1 = cl[m + 32];
                int rank0 = 0, rank1 = 0;
                for (int o0 = 0; o0 < C; o0 += 8) {
                    unsigned long long e_[8];
#pragma unroll
                    for (int k = 0; k < 8; ++k) e_[k] = cl[o0 + k];
                    unsigned long long m0_, m1_, m2_;
                    asm("v_cmp_gt_u64_e64 %[m0], %[o0], %[me0]\n\tv_cmp_gt_u64_e64 %[m1], %[o0], %[me1]\n\tv_cmp_gt_u64_e64 %[m2], %[o1], %[me0]\n\tv_addc_co_u32_e64 %[r0], %[m0], 0, %[r0], %[m0]\n\tv_cmp_gt_u64_e64 %[m0], %[o1], %[me1]\n\tv_addc_co_u32_e64 %[r1], %[m1], 0, %[r1], %[m1]\n\tv_cmp_gt_u64_e64 %[m1], %[o2], %[me0]\n\tv_addc_co_u32_e64 %[r0], %[m2], 0, %[r0], %[m2]\n\tv_cmp_gt_u64_e64 %[m2], %[o2], %[me1]\n\tv_addc_co_u32_e64 %[r1], %[m0], 0, %[r1], %[m0]\n\tv_cmp_gt_u64_e64 %[m0], %[o3], %[me0]\n\tv_addc_co_u32_e64 %[r0], %[m1], 0, %[r0], %[m1]\n\tv_cmp_gt_u64_e64 %[m1], %[o3], %[me1]\n\tv_addc_co_u32_e64 %[r1], %[m2], 0, %[r1], %[m2]\n\tv_cmp_gt_u64_e64 %[m2], %[o4], %[me0]\n\tv_addc_co_u32_e64 %[r0], %[m0], 0, %[r0], %[m0]\n\tv_cmp_gt_u64_e64 %[m0], %[o4], %[me1]\n\tv_addc_co_u32_e64 %[r1], %[m1], 0, %[r1], %[m1]\n\tv_cmp_gt_u64_e64 %[m1], %[o5], %[me0]\n\tv_addc_co_u32_e64 %[r0], %[m2], 0, %[r0], %[m2]\n\tv_cmp_gt_u64_e64 %[m2], %[o5], %[me1]\n\tv_addc_co_u32_e64 %[r1], %[m0], 0, %[r1], %[m0]\n\tv_cmp_gt_u64_e64 %[m0], %[o6], %[me0]\n\tv_addc_co_u32_e64 %[r0], %[m1], 0, %[r0], %[m1]\n\tv_cmp_gt_u64_e64 %[m1], %[o6], %[me1]\n\tv_addc_co_u32_e64 %[r1], %[m2], 0, %[r1], %[m2]\n\tv_cmp_gt_u64_e64 %[m2], %[o7], %[me0]\n\tv_addc_co_u32_e64 %[r0], %[m0], 0, %[r0], %[m0]\n\tv_cmp_gt_u64_e64 %[m0], %[o7], %[me1]\n\tv_addc_co_u32_e64 %[r1], %[m1], 0, %[r1], %[m1]\n\tv_addc_co_u32_e64 %[r0], %[m2], 0, %[r0], %[m2]\n\tv_addc_co_u32_e64 %[r1], %[m0], 0, %[r1], %[m0]"
                        : [r0] "+v"(rank0), [r1] "+v"(rank1), [m0] "=&s"(m0_), [m1] "=&s"(m1_), [m2] "=&s"(m2_)
                        : [o0] "v"(e_[0]), [o1] "v"(e_[1]), [o2] "v"(e_[2]), [o3] "v"(e_[3]), [o4] "v"(e_[4]), [o5] "v"(e_[5]), [o6] "v"(e_[6]), [o7] "v"(e_[7]), [me0] "v"(me0), [me1] "v"(me1));
                }
                if (m < C && rank0 < nd) { const int idx = (int)~(unsigned)me0; atomicOr((unsigned*)(mask32 + q * 128 + (idx >> 5)), 1u << (idx & 31)); }
                if (m + 32 < C && rank1 < nd) { const int idx = (int)~(unsigned)me1; atomicOr((unsigned*)(mask32 + q * 128 + (idx >> 5)), 1u << (idx & 31)); }
            }
            LDS_WAIT(); asm volatile("" ::: "memory");
            pm0 = mask32[q * 128 + m]; pm1 = mask32[q * 128 + m + 32]; pm2 = mask32[q * 128 + m + 64]; pm3 = mask32[q * 128 + m + 96]; prow = (int)(rowbase + t0 + q);
            if (m == 0) ccnt[q] = 0u;
            LDS_WAIT(); asm volatile("" ::: "memory");
        }
        sbuf ^= 1;
      }
    }
    A2_FLUSH();
    __syncthreads();
}
#undef A2_FLUSH
#undef A2_SQ

constexpr int A3_BIAS = 0, A3_GAIN = 8448, A3_WAVE0 = 8704, A3_WSTRIDE = 10240, A3_VS = 144;
__device__ __forceinline__ void phase_a3(ldsp lds, const bf16* PA, const bf16* KN, const bf16* VN, const unsigned* maskIn, bf16* O, const float* qgain, const float* rel_bias, int gw, int NGW, int wave) {
    const int tid = phase_tid(wave);
    const int lane = tid & 63, w = wave, j = lane & 15, g = lane >> 4;
    LAS float* biasT = (LAS float*)(lds + A3_BIAS);
    for (int e = tid; e < 129 * 16; e += NTHR) { const int n = e >> 4, h = e & 15; biasT[e] = rel_bias[t5_bucket(n) * 16 + h] * LOG2E; }
    LAS float* gainT = (LAS float*)(lds + A3_GAIN);
    if (tid < 64) gainT[tid] = qgain[tid];
    __syncthreads();
    const ldsp selb = lds + A3_WAVE0 + w * A3_WSTRIDE;
    const ldsp Vl = lds + A3_WAVE0 + w * A3_WSTRIDE + 1024;
    const ldsp Kl = Vl + 32 * A3_VS;
    const float QS = 0.125f * LOG2E;
    unsigned long long mw_n = 0ull; v4u r0_n = (v4u){0u, 0u, 0u, 0u}, r1_n = (v4u){0u, 0u, 0u, 0u};
    const unsigned moff = (unsigned)lane * 8u, qoff = (unsigned)(64 * j + 8 * g) * 2u, koff = (unsigned)g * 16u, voff = (unsigned)(lane & 7) * 16u;
#define A3_REQM(qq) do { unsigned mo_ = moff; asm volatile("" : "+v"(mo_));     \
        mw_n = *(const unsigned long long*)((const char*)(maskIn + (size_t)(qq) * 128) + mo_); } while (0)
#define A3_REQQ(qq) do { unsigned qo_ = qoff; asm volatile("" : "+v"(qo_)); const char* qp_ = (const char*)(PA + (size_t)(qq) * A_N); r0_n = *(const v4u*)(qp_ + qo_); r1_n = *(const v4u*)(qp_ + qo_ + 64); } while (0)
#define A3_BUILD(mw_, sel_, nk_) do { const int cnt_ = __popcll(mw_); int pre_ = cnt_; int ln_ = lane; asm volatile("" : "+v"(ln_));     \
        _Pragma("unroll") for (int o_ = 1; o_ < 64; o_ <<= 1) { const int v_ = __builtin_amdgcn_ds_bpermute((ln_ >= o_ ? ln_ - o_ : ln_) << 2, pre_); if (ln_ >= o_) pre_ += v_; } \
        nk_ = __builtin_amdgcn_readlane(pre_, 63); \
        { int off_ = pre_ - cnt_; unsigned long long m_ = (mw_); while (m_) { const int bpos_ = __ffsll((long long)m_) - 1; (sel_)[off_++] = (unsigned short)(64 * ln_ + bpos_); m_ &= m_ - 1; } } \
        for (int e_ = nk_ + ln_; e_ < 256; e_ += 64) (sel_)[e_] = 0; } while (0)
    v4u kb[4][4]; v4u vb[4][4];
#define A3_LOADKV(sel_, Kb_, Vb_, c, bf) do { \
        _Pragma("unroll") for (int m = 0; m < 4; ++m) { const unsigned vo = (unsigned)(sel_)[32 * (c) + 8 * m + (lane >> 3)] * 128u + voff; kb[bf][m] = *(const v4u*)((Kb_) + vo); vb[bf][m] = *(const v4u*)((Vb_) + vo); } } while (0)
    int nkeys_n = 0;
    if (gw < NTOK) {
        A3_REQM(gw); A3_REQQ(gw);
        LAS unsigned short* s0_ = (LAS unsigned short*)selb;
        A3_BUILD(mw_n, s0_, nkeys_n);
        LDS_WAIT(); asm volatile("" ::: "memory");
        const int b0_ = gw >> 12; const char* Kb0 = (const char*)(KN + (size_t)b0_ * SEQ * 64); const char* Vb0 = (const char*)(VN + (size_t)b0_ * SEQ * 64);
        A3_LOADKV(s0_, Kb0, Vb0, 0, 0); A3_LOADKV(s0_, Kb0, Vb0, 1, 1); A3_LOADKV(s0_, Kb0, Vb0, 2, 2);
    }
    int par = 0;
#pragma unroll 1
    for (int qi = gw; qi < NTOK; qi += NGW) {
        const int b = qi >> 12, t = qi & (SEQ - 1);
        const char* Kb = (const char*)(KN + (size_t)b * SEQ * 64); const char* Vb = (const char*)(VN + (size_t)b * SEQ * 64);
        const v4u r0 = r0_n, r1 = r1_n; const int nkeys = nkeys_n;
        LAS unsigned short* sel = (LAS unsigned short*)(selb + 512 * par); LAS unsigned short* seln = (LAS unsigned short*)(selb + 512 * (par ^ 1));
        const int qn = (qi + NGW < NTOK) ? qi + NGW : qi;
        const int bn = qn >> 12; const char* Kbn = (const char*)(KN + (size_t)bn * SEQ * 64); const char* Vbn = (const char*)(VN + (size_t)bn * SEQ * 64);
        A3_REQM(qn);
        bf16x8 qf0, qf1;
        {
            const f32x4 gq0 = *(const LAS f32x4*)(gainT + 8 * g), gq1 = *(const LAS f32x4*)(gainT + 8 * g + 4), gq2 = *(const LAS f32x4*)(gainT + 32 + 8 * g), gq3 = *(const LAS f32x4*)(gainT + 32 + 8 * g + 4);
            float x[16] = {bflo(r0.x), bfhi(r0.x), bflo(r0.y), bfhi(r0.y), bflo(r0.z), bfhi(r0.z), bflo(r0.w), bfhi(r0.w),
                           bflo(r1.x), bfhi(r1.x), bflo(r1.y), bfhi(r1.y), bflo(r1.z), bfhi(r1.z), bflo(r1.w), bfhi(r1.w)};
            float s = 0.f;
#pragma unroll
            for (int e = 0; e < 16; ++e) s += x[e] * x[e];
            s = xl::add32(xl::add16(s));
            const float rs = QS / sqrtf(s * (1.0f / 64.0f) + EPS);
            v4u a, c;
            a.x = cvtpk(x[0] * rs * gq0[0], x[1] * rs * gq0[1]); a.y = cvtpk(x[2] * rs * gq0[2], x[3] * rs * gq0[3]); a.z = cvtpk(x[4] * rs * gq1[0], x[5] * rs * gq1[1]); a.w = cvtpk(x[6] * rs * gq1[2], x[7] * rs * gq1[3]);
            c.x = cvtpk(x[8] * rs * gq2[0], x[9] * rs * gq2[1]); c.y = cvtpk(x[10] * rs * gq2[2], x[11] * rs * gq2[3]); c.z = cvtpk(x[12] * rs * gq3[0], x[13] * rs * gq3[1]); c.w = cvtpk(x[14] * rs * gq3[2], x[15] * rs * gq3[3]);
            qf0 = __builtin_bit_cast(bf16x8, a); qf1 = __builtin_bit_cast(bf16x8, c);
        }
        f32x4 o[4]; float lsum = 0.f;
#pragma unroll
        for (int nd = 0; nd < 4; ++nd) o[nd] = (f32x4){0.f, 0.f, 0.f, 0.f};
#pragma unroll
        for (int c = 0; c < 8; ++c) {
            if (c == 4) { A3_BUILD(mw_n, seln, nkeys_n); LDS_WAIT(); asm volatile("" ::: "memory"); }
            if (c == 6) A3_REQQ(qn);
            if (c < 5) A3_LOADKV(sel, Kb, Vb, c + 3, (c + 3) & 3);
            else A3_LOADKV(seln, Kbn, Vbn, c - 5, (c + 3) & 3);
#pragma unroll
            for (int m = 0; m < 4; ++m) { *(LAS v4u*)(Kl + (8 * m + (lane >> 3)) * A3_VS + 16 * (lane & 7)) = kb[c & 3][m]; *(LAS v4u*)(Vl + (8 * m + (lane >> 3)) * A3_VS + 16 * (lane & 7)) = vb[c & 3][m]; }
            LDS_WAIT(); asm volatile("" ::: "memory");
            f32x4 pr[2];
#pragma unroll
            for (int tt = 0; tt < 2; ++tt) {
                const bf16x8 kf0 = *(const LAS bf16x8*)(Kl + (16 * tt + j) * A3_VS + 16 * g), kf1 = *(const LAS bf16x8*)(Kl + (16 * tt + j) * A3_VS + 64 + 16 * g);
                f32x4 s = __builtin_amdgcn_mfma_f32_16x16x32_bf16(kf0, qf0, (f32x4){0.f, 0.f, 0.f, 0.f}, 0, 0, 0);
                s = __builtin_amdgcn_mfma_f32_16x16x32_bf16(kf1, qf1, s, 0, 0, 0);
                const int kbase = 32 * c + 16 * tt + 4 * g;
                const u32x2 iw = *(const LAS u32x2*)(sel + kbase);
                const int i0 = iw.x & 0xffff, i1 = iw.x >> 16, i2 = iw.y & 0xffff, i3 = iw.y >> 16;
                float p0 = __builtin_amdgcn_exp2f(s[0] + biasT[min(t - i0, 128) * 16 + j]);
                float p1 = __builtin_amdgcn_exp2f(s[1] + biasT[min(t - i1, 128) * 16 + j]);
                float p2 = __builtin_amdgcn_exp2f(s[2] + biasT[min(t - i2, 128) * 16 + j]);
                float p3 = __builtin_amdgcn_exp2f(s[3] + biasT[min(t - i3, 128) * 16 + j]);
                if (kbase + 0 >= nkeys) p0 = 0.f; if (kbase + 1 >= nkeys) p1 = 0.f; if (kbase + 2 >= nkeys) p2 = 0.f; if (kbase + 3 >= nkeys) p3 = 0.f;
                lsum += (p0 + p1) + (p2 + p3);
                pr[tt] = (f32x4){p0, p1, p2, p3};
            }
            {
                v4u pw; pw.x = cvtpk(pr[0][0], pr[0][1]); pw.y = cvtpk(pr[0][2], pr[0][3]); pw.z = cvtpk(pr[1][0], pr[1][1]); pw.w = cvtpk(pr[1][2], pr[1][3]);
                const bf16x8 pfrag = __builtin_bit_cast(bf16x8, pw);
#pragma unroll
                for (int nd = 0; nd < 4; ++nd) {
                    const ldsp a0 = Vl + (4 * g + (j >> 2)) * A3_VS + (16 * nd + 4 * (j & 3)) * 2;
                    const bf16x8 vf = cat8(lds_tr(a0), lds_tr(a0 + 16 * A3_VS));
                    o[nd] = __builtin_amdgcn_mfma_f32_16x16x32_bf16(vf, pfrag, o[nd], 0, 0, 0);
                }
            }
            LDS_WAIT(); asm volatile("" ::: "memory");
        }
        lsum = xl::add32(xl::add16(lsum));
        const float il = 1.0f / lsum;
        char* op = (char*)(O + (size_t)qi * DM); unsigned ooff = (unsigned)(64 * j + 4 * g) * 2u; asm volatile("" : "+v"(ooff));
#pragma unroll
        for (int nd = 0; nd < 4; ++nd) { u32x2 wv; wv.x = cvtpk(o[nd][0] * il, o[nd][1] * il); wv.y = cvtpk(o[nd][2] * il, o[nd][3] * il); *(u32x2*)(op + ooff + 32 * nd) = wv; }
        par ^= 1;
    }
#undef A3_LOADKV
#undef A3_BUILD
#undef A3_REQM
#undef A3_REQQ
    __syncthreads();
}

constexpr int B2_BIAS = 0, B2_K = 8192, B2_V = 8192 + 36864, B2_KS = 144, B2_GAIN = 8192 + 2 * 36864;
__device__ __forceinline__ void phase_b2(ldsp lds, const bf16* PB, bf16* O, const float* qgain, const float* kgain, const float* sinks, const float* rel_bias, int vcu, int G, int wave) {
    const int tid = phase_tid(wave);
    const int lane = tid & 63, w = wave, r32 = lane & 31, hh = lane >> 5, g16 = (lane >> 4) & 1, i16 = lane & 15;
    LAS float* biasT = (LAS float*)(lds + B2_BIAS);
    for (int e = tid; e < 128 * 16; e += NTHR) { const int n = e & 127, h = e >> 7; biasT[e] = rel_bias[t5_bucket(n) * 16 + h] * LOG2E; }
    LAS float* gT = (LAS float*)(lds + B2_GAIN);
    if (tid < 64) { gT[tid] = qgain[tid]; gT[64 + tid] = kgain[tid]; } if (tid < 16) gT[128 + tid] = sinks[tid];
    const ldsp Kl = lds + B2_K, Vl = lds + B2_V;
    const float QS = 0.125f * LOG2E;
    v4u kreg[4], vreg[4];
#define B2_LOADKV(uu) do { const int nb_ = (uu) & 31, kvh_ = ((uu) >> 5) & 3, b_ = (uu) >> 7; \
        _Pragma("unroll") for (int m = 0; m < 4; ++m) { const int kj = 64 * m + (tid >> 3), pc = tid & 7; const int tok = 128 * (nb_ - 1) + kj; \
              \
            const bf16* rp = PB + ((size_t)b_ * SEQ + (tok < 0 ? tok + 128 : tok)) * B_N; kreg[m] = *(const v4u*)(rp + 1024 + 64 * kvh_ + 8 * pc); vreg[m] = *(const v4u*)(rp + 1280 + 64 * kvh_ + 8 * pc); } } while (0)
    if (vcu < 2048) B2_LOADKV(vcu);
    v4u rq[4] = {(v4u){0u, 0u, 0u, 0u}, (v4u){0u, 0u, 0u, 0u}, (v4u){0u, 0u, 0u, 0u}, (v4u){0u, 0u, 0u, 0u}};
#define B2_LOADQ(uu, qb_) do { const int nb_ = (uu) & 31, kvh_ = ((uu) >> 5) & 3, b_ = (uu) >> 7; \
        const bf16* qp_ = PB + ((size_t)b_ * SEQ + 128 * nb_ + 64 * (w & 1) + 32 * (qb_) + r32) * B_N + 64 * (4 * kvh_ + (w >> 1)) + 8 * hh; \
        _Pragma("unroll") for (int ks = 0; ks < 4; ++ks) rq[ks] = *(const v4u*)(qp_ + 16 * ks); } while (0)
    if (vcu < 2048) B2_LOADQ(vcu, 0);
    for (int u = vcu; u < 2048; u += G) {
        const int nb = u & 31, kvh = (u >> 5) & 3, b = u >> 7;
        const size_t rowbase = (size_t)b * SEQ;
        __syncthreads();
        {
            const f32x4 gk0 = *(const LAS f32x4*)(gT + 64 + 8 * (tid & 7)), gk1 = *(const LAS f32x4*)(gT + 64 + 8 * (tid & 7) + 4);
#pragma unroll
            for (int m = 0; m < 4; ++m) {
                const int kj = 64 * m + (tid >> 3), pc = tid & 7;
                const v4u kk = kreg[m], vv = vreg[m];
                float x[8] = {bflo(kk.x), bfhi(kk.x), bflo(kk.y), bfhi(kk.y), bflo(kk.z), bfhi(kk.z), bflo(kk.w), bfhi(kk.w)};
                float s = 0.f;
#pragma unroll
                for (int e = 0; e < 8; ++e) s += x[e] * x[e];
                s = xl::add4(xl::add2(xl::add1(s)));
                const float rs = 1.0f / sqrtf(s * (1.0f / 64.0f) + EPS);
                v4u ko; ko.x = cvtpk(x[0] * rs * gk0[0], x[1] * rs * gk0[1]); ko.y = cvtpk(x[2] * rs * gk0[2], x[3] * rs * gk0[3]); ko.z = cvtpk(x[4] * rs * gk1[0], x[5] * rs * gk1[1]); ko.w = cvtpk(x[6] * rs * gk1[2], x[7] * rs * gk1[3]);
                *(LAS v4u*)(Kl + kj * B2_KS + 16 * pc) = ko; *(LAS v4u*)(Vl + kj * B2_KS + 16 * pc) = vv;
            }
        }
        const int un = (u + G < 2048) ? u + G : u;
        B2_LOADKV(un);
        __syncthreads();
        const int hq = 4 * kvh + (w >> 1);
        const float sinkp = __builtin_amdgcn_exp2f(gT[128 + hq] * LOG2E);
#pragma unroll 1
        for (int qblk = 0; qblk < 2; ++qblk) {
            const int qs = 64 * (w & 1) + 32 * qblk;
            const int ql = qs + r32;
            bf16x8 qf[4];
            {
                float s = 0.f;
#pragma unroll
                for (int ks = 0; ks < 4; ++ks) {
                    const float a0 = bflo(rq[ks].x), a1 = bfhi(rq[ks].x), a2 = bflo(rq[ks].y), a3 = bfhi(rq[ks].y), a4 = bflo(rq[ks].z), a5 = bfhi(rq[ks].z), a6 = bflo(rq[ks].w), a7 = bfhi(rq[ks].w);
                    s += (a0 * a0 + a1 * a1) + (a2 * a2 + a3 * a3) + (a4 * a4 + a5 * a5) + (a6 * a6 + a7 * a7); }
                s = xl::add32(s);
                const float rs = QS / sqrtf(s * (1.0f / 64.0f) + EPS);
#pragma unroll
                for (int ks = 0; ks < 4; ++ks) {
                    const f32x4 g0 = *(const LAS f32x4*)(gT + 16 * ks + 8 * hh), g1 = *(const LAS f32x4*)(gT + 16 * ks + 8 * hh + 4);
                    v4u o; o.x = cvtpk(bflo(rq[ks].x) * rs * g0[0], bfhi(rq[ks].x) * rs * g0[1]); o.y = cvtpk(bflo(rq[ks].y) * rs * g0[2], bfhi(rq[ks].y) * rs * g0[3]);
                    o.z = cvtpk(bflo(rq[ks].z) * rs * g1[0], bfhi(rq[ks].z) * rs * g1[1]); o.w = cvtpk(bflo(rq[ks].w) * rs * g1[2], bfhi(rq[ks].w) * rs * g1[3]);
                    qf[ks] = __builtin_bit_cast(bf16x8, o);
                }
                asm volatile("" ::: "memory");
                if (qblk == 0) B2_LOADQ(u, 1); else B2_LOADQ(un, 0);
            }
            f32x16 o0 = {}, o1 = {}; float lsum = 0.f;
#pragma unroll 1
            for (int kt5 = 0; kt5 < 5; ++kt5) {
                const int kt = (qs >> 5) + kt5;
                if (nb == 0 && kt < 4) continue;
                f32x16 p = {};
#pragma unroll
                for (int ks = 0; ks < 4; ++ks) {
                    const bf16x8 ka = *(const LAS bf16x8*)(Kl + (32 * kt + r32) * B2_KS + (16 * ks + 8 * hh) * 2);
                    p = __builtin_amdgcn_mfma_f32_32x32x16_bf16(ka, qf[ks], p, 0, 0, 0);
                }
#pragma unroll
                for (int r = 0; r < 16; ++r) {
                    const int kj = 32 * kt + (r & 3) + 8 * (r >> 2) + 4 * hh; const int rel = ql + 128 - kj;
                    const float bv = biasT[hq * 128 + (rel & 127)];
                    p[r] = __builtin_amdgcn_exp2f(p[r] + bv);
                }
                if (kt5 == 0 || kt5 == 4) {
                    asm volatile("" ::: "memory");
#pragma unroll
                    for (int r = 0; r < 16; ++r) {
                        const int kj = 32 * kt + (r & 3) + 8 * (r >> 2) + 4 * hh; const int rel = ql + 128 - kj;
                        p[r] = ((rel >= 0) && (rel < 128)) ? p[r] : 0.f;
                    }
                }
#pragma unroll
                for (int r = 0; r < 16; ++r) lsum += p[r];
                v4u pw0, pw1;
                pw0.x = cvtpk(p[0], p[1]); pw0.y = cvtpk(p[2], p[3]); pw0.z = cvtpk(p[4], p[5]); pw0.w = cvtpk(p[6], p[7]);
                pw1.x = cvtpk(p[8], p[9]); pw1.y = cvtpk(p[10], p[11]); pw1.z = cvtpk(p[12], p[13]); pw1.w = cvtpk(p[14], p[15]);
                const bf16x8 pf0 = __builtin_bit_cast(bf16x8, pw0), pf1 = __builtin_bit_cast(bf16x8, pw1);
#pragma unroll
                for (int s = 0; s < 2; ++s) {
                    const ldsp va = Vl + (32 * kt + 16 * s + 4 * hh + (i16 >> 2)) * B2_KS + (16 * g16 + 4 * (i16 & 3)) * 2;
                    const bf16x8 v0 = cat8(lds_tr(va), lds_tr(va + 8 * B2_KS));
                    const bf16x8 v1 = cat8(lds_tr(va + 64), lds_tr(va + 8 * B2_KS + 64));
                    o0 = __builtin_amdgcn_mfma_f32_32x32x16_bf16(v0, s == 0 ? pf0 : pf1, o0, 0, 0, 0);
                    o1 = __builtin_amdgcn_mfma_f32_32x32x16_bf16(v1, s == 0 ? pf0 : pf1, o1, 0, 0, 0);
                }
            }
            lsum = xl::add32(lsum);
            const float il = 1.0f / (lsum + sinkp);
            bf16* op = O + (rowbase + 128 * nb + ql) * DM + 64 * hq + 8 * hh;
#define OUT16(acc, p_, il_, dst_) do { v4u w_; { const unsigned e0_ = cvtpk(acc[8 * (p_)] * il_, acc[8 * (p_) + 1] * il_), e1_ = cvtpk(acc[8 * (p_) + 2] * il_, acc[8 * (p_) + 3] * il_); \
            const unsigned d0_ = cvtpk(acc[8 * (p_) + 4] * il_, acc[8 * (p_) + 5] * il_), d1_ = cvtpk(acc[8 * (p_) + 6] * il_, acc[8 * (p_) + 7] * il_); \
              \
            const auto s0_ = __builtin_amdgcn_permlane32_swap(e0_, d0_, false, false); const auto s1_ = __builtin_amdgcn_permlane32_swap(e1_, d1_, false, false); \
            w_.x = s0_[0]; w_.y = s1_[0]; w_.z = s0_[1]; w_.w = s1_[1]; } *(v4u*)(dst_) = w_; } while (0)
#pragma unroll
            for (int p2 = 0; p2 < 2; ++p2) { OUT16(o0, p2, il, op + 16 * p2); OUT16(o1, p2, il, op + 32 + 16 * p2); }
#undef OUT16
        }
    }
    __syncthreads();
}
#undef B2_LOADKV
#undef B2_LOADQ

__device__ __forceinline__ void phase_cfin(bf16* Q, bf16* KV, const bf16* LAT, bf16* KR, const float* cs, const float* qgain, const float* kgain, int gw, int NGW, int wave) {
    const int lane = phase_tid(wave) & 63;
    const int hd = lane >> 2, sub = lane & 3;
    const float QS = 0.10206207261596575f * LOG2E;
    f32x4 gqn[4], gkn[4]; f32x4 gq1, gq2, gk1, gk2;
#pragma unroll
    for (int e = 0; e < 4; ++e) { gqn[e] = *(const f32x4*)(qgain + 16 * sub + 4 * e); gkn[e] = *(const f32x4*)(kgain + 16 * sub + 4 * e); }
    gq1 = *(const f32x4*)(qgain + 64 + 4 * sub); gq2 = *(const f32x4*)(qgain + 80 + 4 * sub); gk1 = *(const f32x4*)(kgain + 64 + 4 * sub); gk2 = *(const f32x4*)(kgain + 80 + 4 * sub);
    f32x4 csa_n = {}, csb_n = {}; v4u n0_n = (v4u){0u, 0u, 0u, 0u}, n1_n = (v4u){0u, 0u, 0u, 0u}; u32x2 t1_n = {0u, 0u}, t2_n = {0u, 0u};
#define CF_LOAD(tk) do { csa_n = *(const f32x4*)(cs + (size_t)(tk) * 32 + 8 * sub); csb_n = *(const f32x4*)(cs + (size_t)(tk) * 32 + 8 * sub + 4); \
        const bf16* np_ = KV + (size_t)(tk) * C_NKV + 128 * hd + 16 * sub; const bf16* r1p_ = LAT + (size_t)(tk) * C_N1 + 384 + 4 * sub; \
        n0_n = *(const v4u*)np_; n1_n = *(const v4u*)(np_ + 8); t1_n = *(const u32x2*)r1p_; t2_n = *(const u32x2*)(r1p_ + 16); } while (0)
    if (gw < NTOK) CF_LOAD(gw);
    for (int tok = gw; tok < NTOK; tok += NGW) {
        const f32x4 csa = csa_n, csb = csb_n;
        const float cv[4] = {csa[0], csa[2], csb[0], csb[2]}, sv[4] = {csa[1], csa[3], csb[1], csb[3]};
        v4u n0s[2], n1s[2]; u32x2 t1s[2], t2s[2];
        n0s[1] = n0_n; n1s[1] = n1_n; t1s[1] = t1_n; t2s[1] = t2_n;
        if (tok + NGW < NTOK) CF_LOAD(tok + NGW);
#pragma unroll
        for (int isk = 1; isk < 2; ++isk) {
            bf16* np = isk ? (KV + (size_t)tok * C_NKV + 128 * hd + 16 * sub) : (Q + (size_t)tok * C_NQ + 96 * hd + 16 * sub);
            const v4u n0 = n0s[isk], n1 = n1s[isk]; const u32x2 t1 = t1s[isk], t2 = t2s[isk];
            float x[16] = {bflo(n0.x), bfhi(n0.x), bflo(n0.y), bfhi(n0.y), bflo(n0.z), bfhi(n0.z), bflo(n0.w), bfhi(n0.w), bflo(n1.x), bfhi(n1.x), bflo(n1.y), bfhi(n1.y), bflo(n1.z), bfhi(n1.z), bflo(n1.w), bfhi(n1.w)};
            float a[4] = {bflo(t1.x), bfhi(t1.x), bflo(t1.y), bfhi(t1.y)}, c[4] = {bflo(t2.x), bfhi(t2.x), bflo(t2.y), bfhi(t2.y)};
            float s = 0.f;
#pragma unroll
            for (int e = 0; e < 16; ++e) s += x[e] * x[e];
#pragma unroll
            for (int e = 0; e < 4; ++e) s += a[e] * a[e] + c[e] * c[e];
            s = xl::add2(xl::add1(s));
            const float rs = (isk ? 1.0f : QS) / sqrtf(s * (1.0f / 96.0f) + EPS);
            v4u o0, o1;
            const f32x4* gn = isk ? gkn : gqn;
            o0.x = cvtpk(x[0] * rs * gn[0][0], x[1] * rs * gn[0][1]); o0.y = cvtpk(x[2] * rs * gn[0][2], x[3] * rs * gn[0][3]); o0.z = cvtpk(x[4] * rs * gn[1][0], x[5] * rs * gn[1][1]); o0.w = cvtpk(x[6] * rs * gn[1][2], x[7] * rs * gn[1][3]);
            o1.x = cvtpk(x[8] * rs * gn[2][0], x[9] * rs * gn[2][1]); o1.y = cvtpk(x[10] * rs * gn[2][2], x[11] * rs * gn[2][3]); o1.z = cvtpk(x[12] * rs * gn[3][0], x[13] * rs * gn[3][1]); o1.w = cvtpk(x[14] * rs * gn[3][2], x[15] * rs * gn[3][3]);
            const f32x4 g1 = isk ? gk1 : gq1, g2 = isk ? gk2 : gq2;
            float r1[4], r2[4];
#pragma unroll
            for (int e = 0; e < 4; ++e) { const float u1 = a[e] * rs * g1[e], u2 = c[e] * rs * g2[e]; r1[e] = u1 * cv[e] - u2 * sv[e]; r2[e] = u2 * cv[e] + u1 * sv[e]; }
            u32x2 w1, w2; w1.x = cvtpk(r1[0], r1[1]); w1.y = cvtpk(r1[2], r1[3]); w2.x = cvtpk(r2[0], r2[1]); w2.y = cvtpk(r2[2], r2[3]);
            *(v4u*)np = o0; *(v4u*)(np + 8) = o1;
            bf16* rop = isk ? (KR + (size_t)tok * 512 + 32 * hd + 4 * sub) : (Q + (size_t)tok * C_NQ + 96 * hd + 64 + 4 * sub);
            *(u32x2*)rop = w1; *(u32x2*)(rop + 16) = w2;
        }
    }
}

#undef CF_LOAD
constexpr int C3_KS = 208, C3_VS = 64, C3_VH = 4096 + 64, C3_KB = 64 * C3_KS, C3_VB = 2 * 4096 + 128, C3_K = 0, C3_V = 3 * C3_KB;
__device__ __forceinline__ void phase_c3(ldsp lds, const bf16* Q, const bf16* KV, const bf16* KR, bf16* O, const float* cs, const float* qgain, int vcu, int G, int wave) {
    const int tid = phase_tid(wave);
    const int lane = tid & 63, w = wave, r32 = lane & 31, hh = lane >> 5, g16 = (lane >> 4) & 1, i16 = lane & 15;
    const int srow = tid >> 3, spc = tid & 7, rrow = (tid >> 2) & 63, rpc = tid & 3;
    v4u po0 = (v4u){0u, 0u, 0u, 0u}, po1 = po0, po2 = po0, po3 = po0; char* pop = nullptr; unsigned poo = 0u;
#define C3_FLUSH() do { if (pop) { *(v4u*)(pop + poo) = po0; *(v4u*)(pop + poo + 64) = po1; *(v4u*)(pop + poo + 32) = po2; *(v4u*)(pop + poo + 96) = po3; pop = nullptr; } } while (0)
    for (int p = vcu; p < 2048; p += G) {
#pragma unroll 1
      for (int half = 0; half < 2; ++half) {
        const int bh = p >> 3, b = bh >> 4, h = bh & 15, qb = half ? 15 - (p & 7) : (p & 7);
        const size_t rowbase = (size_t)b * SEQ;
        const int NT = 4 * (qb + 1), tw = 4 * qb + (w >> 1);
        const bf16* kvb = KV + rowbase * C_NKV + 128 * h; const bf16* krb = KR + rowbase * 512 + 32 * h;
        v4u skA, svA, srA = (v4u){0u, 0u, 0u, 0u};
        const unsigned kvo = (unsigned)(srow * C_NKV + 8 * spc) * 2u, kro = (unsigned)(rrow * 512 + 8 * rpc) * 2u;
#define C3_LOAD(T, sk_, sv_, sr_) do { const char* kb_ = (const char*)(kvb + (size_t)(64 * (T)) * C_NKV); sk_ = *(const v4u*)(kb_ + kvo); sv_ = *(const v4u*)(kb_ + kvo + 128); \
            if (tid < 256) sr_ = *(const v4u*)((const char*)(krb + (size_t)(64 * (T)) * 512) + kro); } while (0)
#define C3_STORE(SLOT, sk_, sv_, sr_) do { *(LAS v4u*)(lds + C3_K + (SLOT) * C3_KB + srow * C3_KS + 16 * spc) = sk_; *(LAS v4u*)(lds + C3_V + (SLOT) * C3_VB + (spc >> 2) * C3_VH + srow * C3_VS + 16 * (spc & 3)) = sv_; \
            if (tid < 256) *(LAS v4u*)(lds + C3_K + (SLOT) * C3_KB + rrow * C3_KS + 128 + 16 * rpc) = sr_; } while (0)
        C3_LOAD(0, skA, svA, srA);
        bf16x8 qf[6];
        {
            const char* qp = (const char*)(Q + (rowbase + 256 * qb + 32 * w) * C_NQ + 96 * h); const unsigned qo = (unsigned)(r32 * C_NQ + 8 * hh) * 2u;
            v4u qr[6];
#pragma unroll
            for (int ks = 0; ks < 6; ++ks) qr[ks] = *(const v4u*)(qp + qo + 32 * ks);
            const float* csp = cs + (rowbase + 256 * qb + 32 * w + r32) * 32 + 16 * hh;
            f32x4 csv[4];
#pragma unroll
            for (int e = 0; e < 4; ++e) csv[e] = *(const f32x4*)(csp + 4 * e);
            C3_FLUSH();
            float x[6][8]; float ss = 0.f;
#pragma unroll
            for (int ks = 0; ks < 6; ++ks) {
                x[ks][0] = bflo(qr[ks].x); x[ks][1] = bfhi(qr[ks].x); x[ks][2] = bflo(qr[ks].y); x[ks][3] = bfhi(qr[ks].y);
                x[ks][4] = bflo(qr[ks].z); x[ks][5] = bfhi(qr[ks].z); x[ks][6] = bflo(qr[ks].w); x[ks][7] = bfhi(qr[ks].w);
#pragma unroll
                for (int e = 0; e < 8; ++e) ss += x[ks][e] * x[ks][e];
            }
            ss = xl::add32(ss);
            const float rs = (0.10206207261596575f * LOG2E) / sqrtf(ss * (1.0f / 96.0f) + EPS);
#pragma unroll
            for (int ks = 0; ks < 6; ++ks) {
                const f32x4 g0 = *(const f32x4*)(qgain + 16 * ks + 8 * hh), g1 = *(const f32x4*)(qgain + 16 * ks + 8 * hh + 4);
#pragma unroll
                for (int e = 0; e < 4; ++e) { x[ks][e] *= rs * g0[e]; x[ks][4 + e] *= rs * g1[e]; }
            }
#pragma unroll
            for (int e = 0; e < 8; ++e) { const float cc = csv[e >> 1][2 * (e & 1)], sn = csv[e >> 1][2 * (e & 1) + 1]; const float a = x[4][e], b2 = x[5][e]; x[4][e] = a * cc - b2 * sn; x[5][e] = b2 * cc + a * sn; }
#pragma unroll
            for (int ks = 0; ks < 6; ++ks) { v4u o; o.x = cvtpk(x[ks][0], x[ks][1]); o.y = cvtpk(x[ks][2], x[ks][3]); o.z = cvtpk(x[ks][4], x[ks][5]); o.w = cvtpk(x[ks][6], x[ks][7]); qf[ks] = __builtin_bit_cast(bf16x8, o); }
        }
        C3_STORE(0, skA, svA, srA);
        f32x16 o0 = {}, o1 = {}; float lsum = 0.f;
        const int qloc = 32 * w + r32;
        f32x16 s0 = {}, s1 = {};
#define C3_KF(ks_) *(const LAS bf16x8*)(Kb_ + r32 * C3_KS + (16 * (ks_) + 8 * hh) * 2)
#define C3_KG(ks_) *(const LAS bf16x8*)(Kb_ + (32 + r32) * C3_KS + (16 * (ks_) + 8 * hh) * 2)
#define C3_QK(SLOT, n0_, n1_) do { const ldsp Kb_ = lds + C3_K + (SLOT) * C3_KB; \
              \
            bf16x8 fa0_ = C3_KF(0), fa1_ = C3_KG(0), fa2_ = C3_KF(1), fa3_ = C3_KG(1); \
            bf16x8 fb0_ = C3_KF(2), fb1_ = C3_KG(2), fb2_ = C3_KF(3), fb3_ = C3_KG(3); \
            __builtin_amdgcn_sched_barrier(0); \
            n0_ = __builtin_amdgcn_mfma_f32_32x32x16_bf16(fa0_, qf[0], n0_, 0, 0, 0); n1_ = __builtin_amdgcn_mfma_f32_32x32x16_bf16(fa1_, qf[0], n1_, 0, 0, 0); \
            n0_ = __builtin_amdgcn_mfma_f32_32x32x16_bf16(fa2_, qf[1], n0_, 0, 0, 0); n1_ = __builtin_amdgcn_mfma_f32_32x32x16_bf16(fa3_, qf[1], n1_, 0, 0, 0); \
            __builtin_amdgcn_sched_barrier(0); \
            fa0_ = C3_KF(4); fa1_ = C3_KG(4); fa2_ = C3_KF(5); fa3_ = C3_KG(5); \
            __builtin_amdgcn_sched_barrier(0); \
            n0_ = __builtin_amdgcn_mfma_f32_32x32x16_bf16(fb0_, qf[2], n0_, 0, 0, 0); n1_ = __builtin_amdgcn_mfma_f32_32x32x16_bf16(fb1_, qf[2], n1_, 0, 0, 0); \
            n0_ = __builtin_amdgcn_mfma_f32_32x32x16_bf16(fb2_, qf[3], n0_, 0, 0, 0); n1_ = __builtin_amdgcn_mfma_f32_32x32x16_bf16(fb3_, qf[3], n1_, 0, 0, 0); \
            n0_ = __builtin_amdgcn_mfma_f32_32x32x16_bf16(fa0_, qf[4], n0_, 0, 0, 0); n1_ = __builtin_amdgcn_mfma_f32_32x32x16_bf16(fa1_, qf[4], n1_, 0, 0, 0); \
            n0_ = __builtin_amdgcn_mfma_f32_32x32x16_bf16(fa2_, qf[5], n0_, 0, 0, 0); n1_ = __builtin_amdgcn_mfma_f32_32x32x16_bf16(fa3_, qf[5], n1_, 0, 0, 0); } while (0)
#define C3_VA(ks_) (Vb_ + (16 * (ks_) + 4 * hh + (i16 >> 2)) * C3_VS + (16 * g16 + 4 * (i16 & 3)) * 2)
#define C3_V0(ks_) cat8(lds_tr(C3_VA(ks_)), lds_tr(C3_VA(ks_) + 8 * C3_VS))
#define C3_V1(ks_) cat8(lds_tr(C3_VA(ks_) + C3_VH), lds_tr(C3_VA(ks_) + 8 * C3_VS + C3_VH))
#define C3_SMPV(TT, SLOT) do { const ldsp Vb_ = lds + C3_V + (SLOT) * C3_VB; \
              \
            bf16x8 va0_ = C3_V0(0), va1_ = C3_V1(0), vb0_ = C3_V0(1), vb1_ = C3_V1(1); \
            __builtin_amdgcn_sched_barrier(0); \
            _Pragma("unroll") for (int r = 0; r < 16; ++r) { \
                const float e0_ = __builtin_amdgcn_exp2f(s0[r]), e1_ = __builtin_amdgcn_exp2f(s1[r]);        \
                s0[r] = e0_; s1[r] = e1_; { float t_ = e0_ + e1_; asm volatile("" : "+v"(t_)); lsum += t_; asm volatile("" : "+v"(lsum)); } }     \
            v4u pw_[4]; \
            pw_[0].x = cvtpk(s0[0], s0[1]); pw_[0].y = cvtpk(s0[2], s0[3]); pw_[0].z = cvtpk(s0[4], s0[5]); pw_[0].w = cvtpk(s0[6], s0[7]); \
            pw_[1].x = cvtpk(s0[8], s0[9]); pw_[1].y = cvtpk(s0[10], s0[11]); pw_[1].z = cvtpk(s0[12], s0[13]); pw_[1].w = cvtpk(s0[14], s0[15]); \
            pw_[2].x = cvtpk(s1[0], s1[1]); pw_[2].y = cvtpk(s1[2], s1[3]); pw_[2].z = cvtpk(s1[4], s1[5]); pw_[2].w = cvtpk(s1[6], s1[7]); \
            pw_[3].x = cvtpk(s1[8], s1[9]); pw_[3].y = cvtpk(s1[10], s1[11]); pw_[3].z = cvtpk(s1[12], s1[13]); pw_[3].w = cvtpk(s1[14], s1[15]); \
            __builtin_amdgcn_sched_barrier(0); \
            o0 = __builtin_amdgcn_mfma_f32_32x32x16_bf16(va0_, __builtin_bit_cast(bf16x8, pw_[0]), o0, 0, 0, 0); o1 = __builtin_amdgcn_mfma_f32_32x32x16_bf16(va1_, __builtin_bit_cast(bf16x8, pw_[0]), o1, 0, 0, 0); \
            __builtin_amdgcn_sched_barrier(0); \
            va0_ = C3_V0(2); va1_ = C3_V1(2); \
            __builtin_amdgcn_sched_barrier(0); \
            o0 = __builtin_amdgcn_mfma_f32_32x32x16_bf16(vb0_, __builtin_bit_cast(bf16x8, pw_[1]), o0, 0, 0, 0); o1 = __builtin_amdgcn_mfma_f32_32x32x16_bf16(vb1_, __builtin_bit_cast(bf16x8, pw_[1]), o1, 0, 0, 0); \
            __builtin_amdgcn_sched_barrier(0); \
            vb0_ = C3_V0(3); vb1_ = C3_V1(3); \
            __builtin_amdgcn_sched_barrier(0); \
            o0 = __builtin_amdgcn_mfma_f32_32x32x16_bf16(va0_, __builtin_bit_cast(bf16x8, pw_[2]), o0, 0, 0, 0); o1 = __builtin_amdgcn_mfma_f32_32x32x16_bf16(va1_, __builtin_bit_cast(bf16x8, pw_[2]), o1, 0, 0, 0); \
            o0 = __builtin_amdgcn_mfma_f32_32x32x16_bf16(vb0_, __builtin_bit_cast(bf16x8, pw_[3]), o0, 0, 0, 0); o1 = __builtin_amdgcn_mfma_f32_32x32x16_bf16(vb1_, __builtin_bit_cast(bf16x8, pw_[3]), o1, 0, 0, 0); } while (0)
        int slot = 0, pslot = 2;
#pragma unroll 1
        for (int t2 = 0; t2 < NT; t2 += 2) {
#pragma unroll
          for (int par = 0; par < 2; ++par) {
            const int t = t2 + par;
            __syncthreads();
            if (t + 1 < NT) C3_LOAD(t + 1, skA, svA, srA);
            f32x16 n0 = {}, n1 = {};
            const bool doqk = (t <= tw), dopv = (t >= 1) && (t - 1 <= tw);
            if (t == tw) {
                asm volatile("" ::: "memory");
                const int kq = qloc - 64 * (t - 4 * qb) - 4 * hh;
#pragma unroll
                for (int r = 0; r < 16; ++r) { const int kl = (r & 3) + 8 * (r >> 2); n0[r] = (kl > kq) ? -1e30f : 0.f; n1[r] = (kl + 32 > kq) ? -1e30f : 0.f; }
            }
            if (doqk) C3_QK(slot, n0, n1);
            if (dopv) C3_SMPV(t - 1, pslot);
            s0 = n0; s1 = n1;
            const int nslot = (slot == 2) ? 0 : slot + 1;
            if (t + 1 < NT) C3_STORE(nslot, skA, svA, srA);
            pslot = slot; slot = nslot;
          }
        }
        if (NT - 1 <= tw) C3_SMPV(NT - 1, pslot);
#undef C3_QK
#undef C3_KF
#undef C3_KG
#undef C3_SMPV
#undef C3_VA
#undef C3_V0
#undef C3_V1
#undef C3_LOAD
#undef C3_STORE
        lsum = xl::add32(lsum);
        const float il = 1.0f / lsum;
        char* op = (char*)(O + (rowbase + 256 * qb + 32 * w) * DM + 64 * h); const unsigned oo = (unsigned)(r32 * DM + 8 * hh) * 2u;
#define OUT16(acc, p_, il_, dst_) do { v4u w_; { const unsigned e0_ = cvtpk(acc[8 * (p_)] * il_, acc[8 * (p_) + 1] * il_), e1_ = cvtpk(acc[8 * (p_) + 2] * il_, acc[8 * (p_) + 3] * il_); \
            const unsigned d0_ = cvtpk(acc[8 * (p_) + 4] * il_, acc[8 * (p_) + 5] * il_), d1_ = cvtpk(acc[8 * (p_) + 6] * il_, acc[8 * (p_) + 7] * il_); \
              \
            const auto s0_ = __builtin_amdgcn_permlane32_swap(e0_, d0_, false, false); const auto s1_ = __builtin_amdgcn_permlane32_swap(e1_, d1_, false, false); \
            w_.x = s0_[0]; w_.y = s1_[0]; w_.z = s0_[1]; w_.w = s1_[1]; } dst_ = w_; } while (0)
        OUT16(o0, 0, il, po0); OUT16(o1, 0, il, po1); OUT16(o0, 1, il, po2); OUT16(o1, 1, il, po3);
        pop = op; poo = oo;
#undef OUT16
        __syncthreads();
      }
    }
    C3_FLUSH();
}
#undef C3_FLUSH

#ifndef MK_SINGLE
#define MK_SINGLE 1
#endif
#ifndef DUPMASK
#define DUPMASK 0
#endif
#define REP(bit) _Pragma("unroll 1") for (int rep_ = 0; rep_ < 1 + ((DUPMASK >> (bit)) & 1); ++rep_)
struct Args { const float* in[24]; float* out; unsigned char* ws; int ph_lo, ph_hi; };

typedef __attribute__((address_space(4))) const Args* karg_t;
#define PH_BEGIN karg_t A_ = ap; int bx = bx0, G = G0, vcu = vcu0, gw = gw0, NGW = NGW0, wave = wave0; asm volatile("" : "+s"(A_), "+s"(bx), "+s"(G), "+s"(vcu), "+s"(gw), "+s"(NGW), "+s"(wave)); (void)bx; (void)G; (void)vcu; (void)gw; (void)NGW; unsigned char* const ws = A_->ws; unsigned char* const R = ws + WS_R; (void)R; \
    bf16* const xb = (bf16*)(ws + WS_XB); float* const ssq = (float*)(ws + WS_SSQ); float* const ssq2 = (float*)(ws + WS_SSQ2); (void)xb; (void)ssq; (void)ssq2;
__global__ void __launch_bounds__(NTHR, 2) mk_fwd(Args args) {
    extern __shared__ __attribute__((aligned(16))) unsigned char lds_raw[];
    const ldsp lds = (ldsp)lds_raw;
    const int tid0 = threadIdx.x, wave0 = __builtin_amdgcn_readfirstlane(tid0 >> 6);
    const int G0 = gridDim.x, bx0 = blockIdx.x;
    const int vcu0 = (G0 % 8 == 0) ? (bx0 % 8) * (G0 / 8) + bx0 / 8 : bx0;
    const int gw0 = vcu0 * NWAVES + wave0, NGW0 = G0 * NWAVES;
    const karg_t ap = (karg_t)__builtin_amdgcn_kernarg_segment_ptr();
    for (int u = tid0; u < (LDS_BYTES - LDSCTL_OFF) / 4; u += NTHR) ((LAS unsigned*)(lds + LDSCTL_OFF))[u] = 0u;
    __syncthreads();
    XcdBarrier bar; bar.bar = (unsigned*)(args.ws + WS_CTL) + CW_BAR; bar.x = 0; bar.st = nullptr;
    if (MK_SINGLE) bar = xcd_barrier_post((unsigned*)(args.ws + WS_CTL) + CW_BAR, (volatile LAS unsigned*)(lds + MISC_OFF + 32));
    const int lo = args.ph_lo, hi = args.ph_hi; int ph = 0;
#define RUN (lo <= ph && ph < hi)
#define SEAM() do { if (MK_SINGLE && lo <= ph && ph + 1 < hi) xcd_barrier(bar); ++ph; } while (0)

    if (RUN) REP(9) { PH_BEGIN Ptrs P; for (int i = 0; i < 24; ++i) P.in[i] = A_->in[i]; P.out = A_->out; P.ws = ws; prologue(P, lds, gw, NGW, wave); }
    SEAM();

#pragma unroll
    for (int L = 0; L < 4; ++L) {
        const int kind = L % 3;
        if (kind == 0) {
            const int ia = (L == 0) ? 0 : 1;
            if (RUN) REP(1) {
                PH_BEGIN
                pg8::Gemm g{xb, (const bf16*)(ws + WS_WAIN + (size_t)ia * (A_N * DM * 2)), NTOK, A_N, DM, DM, DM}; pg8::StaticOrder S; S.init(NTOK, A_N, G, bx);
                pg8::EpiScale<0, false> E{(bf16*)(R + R_PA), A_N, ssq, 0, 16, 1.0f / 1024.0f, nullptr, 0};
                pg8::gemm_phase<pg8::EpiScale<0, false>, pg8::StaticOrder, true, true>(lds, g, S, E, wave);
            }
            SEAM();
            if (RUN) REP(2) { PH_BEGIN phase_a2(lds, (bf16*)(R + R_PA), (unsigned*)(R + R_MASK), (f32x4*)(R + R_O) + (size_t)bx * 32768, (bf16*)(R + R_KN), (bf16*)(R + R_VN), A_->in[9] + ia * 64, vcu, G, wave); }
            SEAM();
            if (RUN) REP(3) { PH_BEGIN phase_a3(lds, (const bf16*)(R + R_PA), (const bf16*)(R + R_KN), (const bf16*)(R + R_VN), (const unsigned*)(R + R_MASK), (bf16*)(R + R_O), A_->in[8] + ia * 64, A_->in[2], gw, NGW, wave); }
            SEAM();
            if (RUN) {
                PH_BEGIN
                pg8::Gemm g{(const bf16*)(R + R_O), (const bf16*)(ws + WS_WAOUT + (size_t)ia * 2 * MiB), NTOK, DM, DM, DM, DM}; pg8::StaticOrder S; S.init(NTOK, DM, G, bx);
                pg8::EpiRes E{xb, ssq2, nullptr, 0, nullptr};
                pg8::gemm_phase<pg8::EpiRes, pg8::StaticOrder, true, true>(lds, g, S, E, wave);
            }
            SEAM();
        } else if (kind == 1) {
            if (RUN) REP(4) {
                PH_BEGIN
                pg8::Gemm g{xb, (const bf16*)(ws + WS_WBIN), NTOK, B_N, DM, DM, DM}; pg8::StaticOrder S; S.init(NTOK, B_N, G, bx);
                pg8::EpiScale<0, false> E{(bf16*)(R + R_PB), B_N, ssq, 0, 16, 1.0f / 1024.0f, nullptr, 0};
                pg8::gemm_phase<pg8::EpiScale<0, false>, pg8::StaticOrder, true, true>(lds, g, S, E, wave);
            }
            SEAM();
            if (RUN) REP(5) { PH_BEGIN phase_b2(lds, (const bf16*)(R + R_PB), (bf16*)(R + R_O), A_->in[12], A_->in[13], A_->in[14], A_->in[2], vcu, G, wave); }
            SEAM();
            if (RUN) {
                PH_BEGIN
                pg8::Gemm g{(const bf16*)(R + R_O), (const bf16*)(ws + WS_WBOUT), NTOK, DM, DM, DM, DM}; pg8::StaticOrder S; S.init(NTOK, DM, G, bx);
                pg8::EpiRes E{xb, ssq2, nullptr, 0, nullptr};
                pg8::gemm_phase<pg8::EpiRes, pg8::StaticOrder, true, true>(lds, g, S, E, wave);
            }
            SEAM();
        } else {
            if (RUN) REP(6) {
                PH_BEGIN
                pg8::Gemm g{xb, (const bf16*)(ws + WS_WCIN), NTOK, C_N1, DM, DM, DM}; pg8::StaticOrder S; S.init(NTOK, C_N1, G, bx);
                pg8::EpiScale<0, true> E{(bf16*)(R + R_LAT), C_N1, ssq, 0, 16, 1.0f / 1024.0f, (float*)(ws + WS_CSTAT), 0};
                pg8::gemm_phase<pg8::EpiScale<0, true>, pg8::StaticOrder, true, true>(lds, g, S, E, wave);
            }
            SEAM();
            if (RUN) REP(7) {
                { PH_BEGIN
                  pg8::Gemm g{(const bf16*)(R + R_LAT), (const bf16*)(ws + WS_WQB), NTOK, C_NQ, 256, C_N1, 256}; pg8::StaticOrder S; S.init(NTOK, C_NQ, G, bx);
                  pg8::EpiScale<0, false> E{(bf16*)(R + R_Q), C_NQ, (const float*)(ws + WS_CSTAT), 0, 8, 1.0f / 256.0f, nullptr, 1};
                  pg8::gemm_phase<pg8::EpiScale<0, false>, pg8::StaticOrder, true, true>(lds, g, S, E, wave); }
                __syncthreads();
                { PH_BEGIN
                  pg8::Gemm g{(const bf16*)(R + R_LAT) + 256, (const bf16*)(ws + WS_WKVB), NTOK, C_NKV, 128, C_N1, 128}; pg8::StaticOrder S; S.init(NTOK, C_NKV, G, bx);
                  pg8::EpiScale<0, false> E{(bf16*)(R + R_KV), C_NKV, (const float*)(ws + WS_CSTAT), 8, 4, 1.0f / 128.0f, nullptr, 1};
                  pg8::gemm_phase<pg8::EpiScale<0, false>, pg8::StaticOrder, true, true>(lds, g, S, E, wave); }
            }
            SEAM();
            if (RUN) { PH_BEGIN phase_cfin((bf16*)(R + R_Q), (bf16*)(R + R_KV), (const bf16*)(R + R_LAT), (bf16*)(R + R_KR), (const float*)(ws + WS_CS), A_->in[21], A_->in[22], gw, NGW, wave); }
            SEAM();
            if (RUN) REP(8) { PH_BEGIN phase_c3(lds, (const bf16*)(R + R_Q), (const bf16*)(R + R_KV), (const bf16*)(R + R_KR), (bf16*)(R + R_OC), (const float*)(ws + WS_CS), A_->in[21], vcu, G, wave); }
            SEAM();
            if (RUN) {
                PH_BEGIN
                pg8::Gemm g{(const bf16*)(R + R_OC), (const bf16*)(ws + WS_WCOUT), NTOK, DM, DM, DM, DM}; pg8::StaticOrder S; S.init(NTOK, DM, G, bx);
                pg8::EpiRes E{xb, ssq2, nullptr, 0, nullptr};
                pg8::gemm_phase<pg8::EpiRes, pg8::StaticOrder, true, true>(lds, g, S, E, wave);
            }
            SEAM();
        }
        if (RUN) REP(0) {
            PH_BEGIN
            pg8::Gemm g{xb, (const bf16*)(ws + WS_WUP + (size_t)L * 8 * MiB), NTOK, DFF, DM, DM, DM}; pg8::StaticOrder S; S.init(NTOK, DFF, G, bx);
            pg8::EpiSq E{(bf16*)(R + R_U), DFF};
            pg8::gemm_phase<pg8::EpiSq, pg8::StaticOrder, true, true>(lds, g, S, E, wave);
        }
        SEAM();
        if (RUN) REP(10) {
            PH_BEGIN
            pg8::Gemm g{(const bf16*)(R + R_U), (const bf16*)(ws + WS_WDN + (size_t)L * 8 * MiB), NTOK, DM, DFF, DFF, DFF}; pg8::StaticOrder S; S.init(NTOK, DM, G, bx);
            pg8::EpiRes E{xb, ssq, (L == 3) ? A_->out : (float*)nullptr, (((DUPMASK >> 10) & 1) && rep_ == 0) ? 1 : 0, ssq2};
            pg8::gemm_phase<pg8::EpiRes, pg8::StaticOrder, true, true>(lds, g, S, E, wave);
        }
        SEAM();
    }
#undef RUN
#undef SEAM
}

constexpr int N_PHASES = 1 + (4 + 2) + (3 + 2) + (5 + 2) + (4 + 2);

extern "C" void kernel_launch(void* const* d_in, const int* in_sizes, int n_in, void* d_out, int out_size, void* d_ws, size_t ws_size, hipStream_t stream) {
    static int grid = 0;
    if (grid == 0) {
        if (n_in != 24 || in_sizes[0] != NTOK * DM || out_size != NTOK * DM || ws_size < WS_END) {
            fprintf(stderr, "kernel_launch: unexpected problem shape (n_in %d, in0 %d, out %d, ws %zu < %zu); nothing launched\n", n_in, n_in > 0 ? in_sizes[0] : -1, out_size, ws_size, (size_t)WS_END); grid = -1; return; }
        int dev = 0, cus = 0, per_cu = 0;
        if (hipGetDevice(&dev) != hipSuccess || hipDeviceGetAttribute(&cus, hipDeviceAttributeMultiprocessorCount, dev) != hipSuccess) { grid = -1; return; }
        if (hipFuncSetAttribute((const void*)mk_fwd, hipFuncAttributeMaxDynamicSharedMemorySize, LDS_BYTES) != hipSuccess) { fprintf(stderr, "kernel_launch: hipFuncSetAttribute failed\n"); grid = -1; return; }
        if (hipOccupancyMaxActiveBlocksPerMultiprocessor(&per_cu, (const void*)mk_fwd, NTHR, LDS_BYTES) != hipSuccess || per_cu < 1)
            fprintf(stderr, "kernel_launch: note: occupancy query reports %d workgroups per CU\n", per_cu);
        (void)hipGetLastError();
        grid = cus;
    }
    if (grid < 0) return;
    if (hipMemsetAsync((char*)d_ws + WS_CTL, 0, CTL_ZERO_BYTES, stream) != hipSuccess) return;
    Args a{};
    for (int i = 0; i < 24; ++i) a.in[i] = (const float*)d_in[i];
    a.out = (float*)d_out; a.ws = (unsigned char*)d_ws;
#if MK_SINGLE
    a.ph_lo = 0; a.ph_hi = N_PHASES;
    hipLaunchKernelGGL(mk_fwd, dim3(grid), dim3(NTHR), LDS_BYTES, stream, a);
#else
    for (int k = 0; k < N_PHASES; ++k) { a.ph_lo = k; a.ph_hi = k + 1; hipLaunchKernelGGL(mk_fwd, dim3(grid), dim3(NTHR), LDS_BYTES, stream, a); }
#endif
}
```

```cpp
#include <hip/hip_runtime.h>
#include <cstdio>
#include <cstdint>

namespace xl {
template <int CTRL> __device__ __forceinline__ unsigned dppu(unsigned v) { return (unsigned)__builtin_amdgcn_update_dpp(0, (int)v, CTRL, 0xf, 0xf, true); }
__device__ __forceinline__ void sw16(unsigned v, unsigned& a, unsigned& b) { auto r = __builtin_amdgcn_permlane16_swap(v, v, false, false); a = r[0]; b = r[1]; }
__device__ __forceinline__ void sw32(unsigned v, unsigned& a, unsigned& b) { auto r = __builtin_amdgcn_permlane32_swap(v, v, false, false); a = r[0]; b = r[1]; }
__device__ __forceinline__ float add1(float v) { return v + __uint_as_float(dppu<0xB1>(__float_as_uint(v))); }
__device__ __forceinline__ float add2(float v) { return v + __uint_as_float(dppu<0x4E>(__float_as_uint(v))); }
__device__ __forceinline__ float add4(float v) { return v + __uint_as_float(dppu<0x141>(__float_as_uint(v))); }
__device__ __forceinline__ float add8(float v) { return v + __uint_as_float(dppu<0x140>(__float_as_uint(v))); }
__device__ __forceinline__ float max1(float v) { return fmaxf(v, __uint_as_float(dppu<0xB1>(__float_as_uint(v)))); }
__device__ __forceinline__ float max2(float v) { return fmaxf(v, __uint_as_float(dppu<0x4E>(__float_as_uint(v)))); }
__device__ __forceinline__ float max4(float v) { return fmaxf(v, __uint_as_float(dppu<0x141>(__float_as_uint(v)))); }
__device__ __forceinline__ float max8(float v) { return fmaxf(v, __uint_as_float(dppu<0x140>(__float_as_uint(v)))); }
__device__ __forceinline__ float min1(float v) { return fminf(v, __uint_as_float(dppu<0xB1>(__float_as_uint(v)))); }
__device__ __forceinline__ float min2(float v) { return fminf(v, __uint_as_float(dppu<0x4E>(__float_as_uint(v)))); }
__device__ __forceinline__ float min4(float v) { return fminf(v, __uint_as_float(dppu<0x141>(__float_as_uint(v)))); }
__device__ __forceinline__ float min8(float v) { return fminf(v, __uint_as_float(dppu<0x140>(__float_as_uint(v)))); }
__device__ __forceinline__ int iadd1(int v) { return v + (int)dppu<0xB1>((unsigned)v); }
__device__ __forceinline__ int iadd2(int v) { return v + (int)dppu<0x4E>((unsigned)v); }
__device__ __forceinline__ int iadd4(int v) { return v + (int)dppu<0x141>((unsigned)v); }
__device__ __forceinline__ int iadd8(int v) { return v + (int)dppu<0x140>((unsigned)v); }
__device__ __forceinline__ unsigned or1(unsigned v) { return v | dppu<0xB1>(v); }
__device__ __forceinline__ unsigned or2(unsigned v) { return v | dppu<0x4E>(v); }
__device__ __forceinline__ unsigned or4(unsigned v) { return v | dppu<0x141>(v); }
__device__ __forceinline__ float add16(float v) { unsigned a, b; sw16(__float_as_uint(v), a, b); return __uint_as_float(a) + __uint_as_float(b); }
__device__ __forceinline__ float add32(float v) { unsigned a, b; sw32(__float_as_uint(v), a, b); return __uint_as_float(a) + __uint_as_float(b); }
__device__ __forceinline__ float max16(float v) { unsigned a, b; sw16(__float_as_uint(v), a, b); return fmaxf(__uint_as_float(a), __uint_as_float(b)); }
__device__ __forceinline__ float max32(float v) { unsigned a, b; sw32(__float_as_uint(v), a, b); return fmaxf(__uint_as_float(a), __uint_as_float(b)); }
__device__ __forceinline__ float min16(float v) { unsigned a, b; sw16(__float_as_uint(v), a, b); return fminf(__uint_as_float(a), __uint_as_float(b)); }
__device__ __forceinline__ float min32(float v) { unsigned a, b; sw32(__float_as_uint(v), a, b); return fminf(__uint_as_float(a), __uint_as_float(b)); }
__device__ __forceinline__ int iadd16(int v) { unsigned a, b; sw16((unsigned)v, a, b); return (int)(a + b); }
__device__ __forceinline__ int iadd32(int v) { unsigned a, b; sw32((unsigned)v, a, b); return (int)(a + b); }
__device__ __forceinline__ unsigned or16(unsigned v) { unsigned a, b; sw16(v, a, b); return a | b; }
__device__ __forceinline__ unsigned or32(unsigned v) { unsigned a, b; sw32(v, a, b); return a | b; }
}
namespace pg8 {
#define PG8_LAS __attribute__((address_space(3)))
typedef unsigned short bf16_t;
typedef short bf16x8 __attribute__((ext_vector_type(8)));
typedef float f32x4 __attribute__((ext_vector_type(4)));
typedef unsigned u32x4 __attribute__((ext_vector_type(4)));
constexpr int BM = 256, BK = 64, HALF = 128, HTB = HALF * BK * 2  , STAGE_BYTES = 8 * HTB, NXCD = 8, WGM = 8;

__host__ __device__ __forceinline__ int lds_byte(int r, int c) { const int st = (r >> 4) * 2 + (c >> 5), rr = r & 15, cc = c & 31, ob = rr * 64 + cc * 2; return st * 1024 + (ob ^ (((ob >> 9) & 1) << 5)); }
__host__ __device__ __forceinline__ void stage_rc(int b, int& R, int& C) { const int st = b / 1024, sb = b % 1024, swz = sb ^ (((sb >> 9) & 1) << 5); R = (st >> 1) * 16 + swz / 64; C = (st & 1) * 32 + (swz % 64) / 2; }
__host__ __device__ __forceinline__ int perm32(int rho) { const int n = rho >> 4, i = rho & 15; return 8 * (i >> 2) + 4 * n + (i & 3); }

struct Unit { int pm, pn; };
struct Gemm { const bf16_t* A; const bf16_t* Bt; int M, N, K, lda, ldb; };

struct StaticOrder {
    int nM, nN, nwg, G, c;
    __host__ __device__ void init(int M, int N, int G_, int c_) { nM = M / BM; nN = N / BM; nwg = nM * nN; G = G_; c = c_; }
    __host__ __device__ bool next(int i, Unit& u) const {
        const long L = (long)i * G + c; if (L >= nwg) return false;
        int wgid = (int)L; { const int q = nwg / NXCD, r = nwg % NXCD, xcd = wgid % NXCD, off = wgid / NXCD; wgid = (xcd < r ? xcd * (q + 1) : r * (q + 1) + (xcd - r) * q) + off; }
        const int nig = WGM * nN, gid = wgid / nig, fm = gid * WGM, gsz = (nM - fm) < WGM ? (nM - fm) : WGM;
        u.pm = fm + ((wgid % nig) % gsz); u.pn = (wgid % nig) / gsz; return true;
    }
    __device__ __forceinline__ void a_ready(const Unit&) const {}
    __device__ __forceinline__ void done(const Unit&) const {}
};

__device__ __forceinline__ unsigned cvt_pk_bf16(float lo, float hi) { unsigned r; asm volatile("v_cvt_pk_bf16_f32 %0, %1, %2" : "=v"(r) : "v"(lo), "v"(hi)); return r; }
typedef float f32x2 __attribute__((ext_vector_type(2)));

__device__ __forceinline__ void row_rs8(float (&rsv)[2][4], const float* st, int row0, int off, int cnt, float inv_n, int fq) {
    const bool in = 4 * fq < cnt;
    const float msk = in ? 1.0f : 0.0f;
    const float* p = st + (size_t)row0 * 16 + off + (in ? 4 * fq : 0);
    f32x4 v[2][4];
#pragma unroll
    for (int ai = 0; ai < 2; ++ai)
#pragma unroll
        for (int m = 0; m < 4; ++m) v[ai][m] = *(const f32x4*)(p + (size_t)(ai * HALF + m * 16) * 16);
    __builtin_amdgcn_sched_barrier(0);
#pragma unroll
    for (int ai = 0; ai < 2; ++ai)
#pragma unroll
        for (int m = 0; m < 4; ++m) {
            float s = ((v[ai][m][0] + v[ai][m][1]) + (v[ai][m][2] + v[ai][m][3])) * msk;
            s = xl::add32(xl::add16(s));
            rsv[ai][m] = __builtin_amdgcn_rsqf(s * inv_n + 1e-6f);
        }
}
template <int ACT, bool STAT> struct EpiScale {
    static constexpr bool PERM = true, AFTER_DRAIN = false;
    bf16_t* O; int ldc; const float* st; int st_off, st_cnt; float inv_n; float* stat_out; int nt;
    __device__ __forceinline__ bool stores16() const { return true; }
    __device__ __forceinline__ void operator()(const f32x4 (&acc)[2][2][4][2], const Unit& u, int wr, int wc, int fr, int fq) const {
        asm volatile("" : "+v"(fr), "+v"(fq));
        const int row0 = u.pm * BM + wr * 64 + fr, col0 = u.pn * BM + wc * 64 + 8 * fq;
        float rsv[2][4];
        row_rs8(rsv, st, row0, st_off, st_cnt, inv_n, fq);
        asm volatile("" ::: "memory");
#pragma unroll
        for (int ai = 0; ai < 2; ++ai)
#pragma unroll
            for (int m = 0; m < 4; ++m) {
                const int row = row0 + ai * HALF + m * 16;
                const float rs = rsv[ai][m];
                bf16_t* rowp = O + (size_t)row * ldc + col0;
#pragma unroll
                for (int bj = 0; bj < 2; ++bj) {
                    f32x4 v0 = acc[ai][bj][m][0] * rs, v1 = acc[ai][bj][m][1] * rs;
                    if (ACT == 1) {
#pragma unroll
                        for (int e = 0; e < 4; ++e) { const float a = fmaxf(v0[e], 0.f), b = fmaxf(v1[e], 0.f); v0[e] = a * a; v1[e] = b * b; }
                    }
                    if (STAT) {
                        float q = (v0[0] * v0[0] + v0[1] * v0[1]) + (v0[2] * v0[2] + v0[3] * v0[3]) + (v1[0] * v1[0] + v1[1] * v1[1]) + (v1[2] * v1[2] + v1[3] * v1[3]);
                        q = xl::add32(xl::add16(q));
                        if (fq == 0) stat_out[(size_t)row * 16 + u.pn * 8 + wc * 2 + bj] = q;
                    }
                    u32x4 w; w.x = cvt_pk_bf16(v0[0], v0[1]); w.y = cvt_pk_bf16(v0[2], v0[3]); w.z = cvt_pk_bf16(v1[0], v1[1]); w.w = cvt_pk_bf16(v1[2], v1[3]);
                    if (ACT == 1 || nt) __builtin_nontemporal_store(w, (u32x4*)(rowp + bj * 32));
                    else *(u32x4*)(rowp + bj * 32) = w;
                }
            }
    }
};
struct EpiSq {
    static constexpr bool PERM = true, AFTER_DRAIN = false;
    bf16_t* O; int ldc;
    __device__ __forceinline__ bool stores16() const { return true; }
    __device__ __forceinline__ void operator()(const f32x4 (&acc)[2][2][4][2], const Unit& u, int wr, int wc, int fr, int fq) const {
        asm volatile("" : "+v"(fr), "+v"(fq));
        const int row0 = u.pm * BM + wr * 64 + fr, col0 = u.pn * BM + wc * 64 + 8 * fq;
#pragma unroll
        for (int ai = 0; ai < 2; ++ai)
#pragma unroll
            for (int m = 0; m < 4; ++m) {
                bf16_t* rowp = O + (size_t)(row0 + ai * HALF + m * 16) * ldc + col0;
#pragma unroll
                for (int bj = 0; bj < 2; ++bj) {
                    f32x4 v0 = acc[ai][bj][m][0], v1 = acc[ai][bj][m][1];
#pragma unroll
                    for (int e = 0; e < 4; ++e) { const float a = fmaxf(v0[e], 0.f), b = fmaxf(v1[e], 0.f); v0[e] = a * a; v1[e] = b * b; }
                    u32x4 w; w.x = cvt_pk_bf16(v0[0], v0[1]); w.y = cvt_pk_bf16(v0[2], v0[3]); w.z = cvt_pk_bf16(v1[0], v1[1]); w.w = cvt_pk_bf16(v1[2], v1[3]);
                    __builtin_nontemporal_store(w, (u32x4*)(rowp + bj * 32));
                }
            }
    }
};
struct EpiRes {
    static constexpr bool PERM = true, AFTER_DRAIN = false;
    bf16_t* xb; float* ssq; float* outf; int dry;
    __device__ __forceinline__ bool stores16() const { return dry == 0; }
    const float* sin;
    __device__ __forceinline__ void operator()(const f32x4 (&acc)[2][2][4][2], const Unit& u, int wr, int wc, int fr, int fq) const {
        if (dry) return;
        asm volatile("" : "+v"(fr), "+v"(fq));
        const int row0 = u.pm * BM + wr * 64 + fr, col0 = u.pn * BM + wc * 64 + 8 * fq;
#pragma unroll
        for (int ai = 0; ai < 2; ++ai) {
            u32x4 pre[4][2];
            f32x4 sv[4]; float r2[4] = {1.f, 1.f, 1.f, 1.f};
            if (sin) {
#pragma unroll
                for (int m = 0; m < 4; ++m) sv[m] = *(const f32x4*)(sin + (size_t)(row0 + ai * HALF + m * 16) * 16 + 4 * fq);
            }
#pragma unroll
            for (int m = 0; m < 4; ++m)
#pragma unroll
                for (int bj = 0; bj < 2; ++bj) pre[m][bj] = *(const u32x4*)(xb + (size_t)(row0 + ai * HALF + m * 16) * 1024 + col0 + bj * 32);
            if (sin) {
#pragma unroll
                for (int m = 0; m < 4; ++m) { float s = (sv[m][0] + sv[m][1]) + (sv[m][2] + sv[m][3]); s = xl::add32(xl::add16(s)); r2[m] = __builtin_amdgcn_rcpf(s * (1.0f / 1024.0f) + 1e-6f); }
            }
#pragma unroll
            for (int m = 0; m < 4; ++m) {
                const int row = row0 + ai * HALF + m * 16; const size_t off = (size_t)row * 1024 + col0; float q = 0.f;
#pragma unroll
                for (int bj = 0; bj < 2; ++bj) {
                    const u32x4 p = pre[m][bj];
                    f32x4 o0 = acc[ai][bj][m][0] * r2[m], o1 = acc[ai][bj][m][1] * r2[m];
                    o0[0] += __uint_as_float(p.x << 16); o0[1] += __uint_as_float(p.x & 0xffff0000u); o0[2] += __uint_as_float(p.y << 16); o0[3] += __uint_as_float(p.y & 0xffff0000u);
                    o1[0] += __uint_as_float(p.z << 16); o1[1] += __uint_as_float(p.z & 0xffff0000u); o1[2] += __uint_as_float(p.w << 16); o1[3] += __uint_as_float(p.w & 0xffff0000u);
                    q += ((o0[0] * o0[0] + o0[1] * o0[1]) + (o0[2] * o0[2] + o0[3] * o0[3])) + ((o1[0] * o1[0] + o1[1] * o1[1]) + (o1[2] * o1[2] + o1[3] * o1[3]));
                    u32x4 w; w.x = cvt_pk_bf16(o0[0], o0[1]); w.y = cvt_pk_bf16(o0[2], o0[3]); w.z = cvt_pk_bf16(o1[0], o1[1]); w.w = cvt_pk_bf16(o1[2], o1[3]);
                    if (outf) { __builtin_nontemporal_store(o0, (f32x4*)(outf + off + bj * 32)); __builtin_nontemporal_store(o1, (f32x4*)(outf + off + bj * 32 + 4)); }
                    else *(u32x4*)(xb + off + bj * 32) = w;
                }
                q = xl::add32(xl::add16(q));
                if (fq == 0 && !outf) ssq[(size_t)row * 16 + u.pn * 4 + wc] = q;
            }
            asm volatile("" ::: "memory");
        }
    }
};
template <class Epi, class Sched, bool ALIGN_EPI = false, bool SP2 = false>
__device__ __forceinline__ void gemm_phase(PG8_LAS unsigned char* lds, const Gemm g, const Sched& S, const Epi& E, const int wave_id) {
    int lane_; asm volatile("v_mbcnt_lo_u32_b32 %0, -1, 0\n\tv_mbcnt_hi_u32_b32 %0, -1, %0" : "=v"(lane_));
    const int tid = wave_id * 64 + lane_;
    const int wid = wave_id, lane = tid & 63, wr = wid >> 2, wc = wid & 3, fr = lane & 15, fq = lane >> 4;
    const int K = g.K, nt = K / BK;
    unsigned voffA[2], voffB[2];
#pragma unroll
    for (int i = 0; i < 2; ++i) { int R, C; stage_rc(tid * 16 + i * 8192, R, C); const int Rb = Epi::PERM ? ((R & ~31) + perm32(R & 31)) : R;
        voffA[i] = (unsigned)(R * g.lda + C) * 2u; voffB[i] = (unsigned)(Rb * g.ldb + C) * 2u; }
    const size_t kstep = (size_t)(BK * 2);
    const size_t hstepA = (size_t)HALF * g.lda * 2, hstepB = (size_t)HALF * g.ldb * 2;
    const size_t tstepA = 2 * hstepA, tstepB = 2 * hstepB;
    const unsigned ldsw = (unsigned)wid * 1024u;
    const int aoff = lds_byte(wr * 64 + fr, fq * 8), boff = lds_byte(wc * 32 + fr, fq * 8);
#define PG8_SA(b, h) (((b) * 2 + (h)) * HTB)
#define PG8_SB(b, h) ((4 + (b) * 2 + (h)) * HTB)
#define PG8_STAGE(bufoff, gbase, voff) do { _Pragma("unroll") for (int _i = 0; _i < 2; ++_i) \
        __builtin_amdgcn_global_load_lds((const unsigned*)((const char*)(gbase) + (voff)[_i]), (PG8_LAS unsigned*)(lds + (bufoff) + ldsw + _i * 8192), 16, 0, 0); } while (0)
#define PG8_LDA(dst, b, h) do { _Pragma("unroll") for (int m = 0; m < 4; ++m) _Pragma("unroll") for (int k = 0; k < 2; ++k) dst[m][k] = *(const PG8_LAS bf16x8*)(lds + PG8_SA(b, h) + aoff + m * 2048 + k * 1024); } while (0)
#define PG8_LDB(dst, b, h) do { _Pragma("unroll") for (int n = 0; n < 2; ++n) _Pragma("unroll") for (int k = 0; k < 2; ++k) dst[n][k] = *(const PG8_LAS bf16x8*)(lds + PG8_SB(b, h) + boff + n * 2048 + k * 1024); } while (0)
#define PG8_MMA(ai, bj, At, Bt) do { __builtin_amdgcn_s_setprio(1); _Pragma("unroll") for (int m = 0; m < 4; ++m) _Pragma("unroll") for (int n = 0; n < 2; ++n) _Pragma("unroll") for (int k = 0; k < 2; ++k) \
        acc[ai][bj][m][n] = __builtin_amdgcn_mfma_f32_16x16x32_bf16(Bt[n][k], At[m][k], acc[ai][bj][m][n], 0, 0, 0); __builtin_amdgcn_s_setprio(0); } while (0)
#define PG8_WAIT_V(n) asm volatile("s_waitcnt vmcnt(" #n ")" ::: "memory")
#define PG8_WAIT_V_RLX(r) asm volatile("s_cmp_lg_u32 %0, 0\n\ts_cbranch_scc0 .Lpgw8_%=\n\ts_waitcnt vmcnt(24)\n\ts_branch .Lpgwe_%=\n.Lpgw8_%=:\n\ts_waitcnt vmcnt(8)\n.Lpgwe_%=:" :: "s"(r) : "memory", "scc")
#define PG8_WAIT_L(n) asm volatile("s_waitcnt lgkmcnt(" #n ")" ::: "memory")
#define PG8_BAR __builtin_amdgcn_s_barrier()
#define PG8_SCHED __builtin_amdgcn_sched_barrier(0)
    Unit cur, nxt; int ui = 0;
    if (!S.next(0, cur)) return;
    f32x4 acc[2][2][4][2];
#pragma unroll
    for (int a = 0; a < 2; ++a)
#pragma unroll
        for (int b = 0; b < 2; ++b)
#pragma unroll
            for (int m = 0; m < 4; ++m)
#pragma unroll
                for (int n = 0; n < 2; ++n) acc[a][b][m][n] = (f32x4){0.f, 0.f, 0.f, 0.f};
    bf16x8 At[4][2], B0[2][2], B1[2][2];
    const char* cA = (const char*)g.A + (size_t)cur.pm * tstepA; const char* cB = (const char*)g.Bt + (size_t)cur.pn * tstepB;
    S.a_ready(cur);
    if constexpr (SP2) {
        PG8_STAGE(PG8_SB(0, 0), cB, voffB); PG8_STAGE(PG8_SB(0, 1), cB + hstepB, voffB); PG8_STAGE(PG8_SA(0, 0), cA, voffA); PG8_STAGE(PG8_SA(0, 1), cA + hstepA, voffA);
        if (wr == 1) PG8_BAR;
        PG8_WAIT_V(2); PG8_BAR;
        PG8_STAGE(PG8_SB(1, 0), cB + kstep, voffB); PG8_STAGE(PG8_SA(1, 0), cA + kstep, voffA); PG8_STAGE(PG8_SB(1, 1), cB + hstepB + kstep, voffB);
        PG8_WAIT_V(6); PG8_BAR;
    } else {
        PG8_STAGE(PG8_SB(0, 0), cB, voffB); PG8_STAGE(PG8_SA(0, 0), cA, voffA); PG8_STAGE(PG8_SB(0, 1), cB + hstepB, voffB); PG8_STAGE(PG8_SA(0, 1), cA + hstepA, voffA);
        if (wr == 1) PG8_BAR;
        PG8_WAIT_V(4); PG8_BAR;
        PG8_STAGE(PG8_SB(1, 0), cB + kstep, voffB); PG8_STAGE(PG8_SA(1, 0), cA + kstep, voffA); PG8_STAGE(PG8_SB(1, 1), cB + hstepB + kstep, voffB);
        PG8_WAIT_V(6); PG8_BAR;
    }
    bool after_epi = false;
    for (;;) {
        const bool has_next = S.next(ui + 1, nxt);
        const char* nA = has_next ? (const char*)g.A + (size_t)nxt.pm * tstepA : cA; const char* nB = has_next ? (const char*)g.Bt + (size_t)nxt.pn * tstepB : cB;
        for (int t = 0; t < nt; t += 2) {
            const bool last = (t == nt - 2);
            const char* a1 = cA + (size_t)(t + 1) * kstep;
            const char* a2 = last ? nA : cA + (size_t)(t + 2) * kstep; const char* b2 = last ? nB : cB + (size_t)(t + 2) * kstep;
            const char* a3 = a2 + kstep; const char* b3 = b2 + kstep;
            if (last && has_next) S.a_ready(nxt);
            if constexpr (SP2) {
            const int rlx = __builtin_amdgcn_readfirstlane((after_epi && (t == 0)) ? 1 : 0);
            PG8_LDB(B0, 0, 0); PG8_LDB(B1, 0, 1); PG8_SCHED; PG8_LDA(At, 0, 0); PG8_STAGE(PG8_SA(1, 1), a1 + hstepA, voffA);
            PG8_WAIT_V_RLX(rlx);
            PG8_WAIT_L(0); PG8_BAR; PG8_MMA(0, 0, At, B0); PG8_MMA(0, 1, At, B1); PG8_BAR; PG8_SCHED;
            PG8_LDA(At, 0, 1); PG8_STAGE(PG8_SB(0, 0), b2, voffB); PG8_STAGE(PG8_SB(0, 1), b2 + hstepB, voffB); PG8_STAGE(PG8_SA(0, 0), a2, voffA);
            PG8_WAIT_V_RLX(rlx);
            PG8_WAIT_L(0); PG8_BAR; PG8_MMA(1, 0, At, B0); PG8_MMA(1, 1, At, B1); PG8_BAR; PG8_SCHED;
            PG8_LDB(B0, 1, 0); PG8_LDB(B1, 1, 1); PG8_SCHED; PG8_LDA(At, 1, 0); PG8_STAGE(PG8_SA(0, 1), a2 + hstepA, voffA);
            PG8_WAIT_V(8); PG8_WAIT_L(0); PG8_BAR; PG8_MMA(0, 0, At, B0); PG8_MMA(0, 1, At, B1); PG8_BAR; PG8_SCHED;
            PG8_LDA(At, 1, 1); PG8_STAGE(PG8_SB(1, 0), b3, voffB); PG8_STAGE(PG8_SB(1, 1), b3 + hstepB, voffB); PG8_STAGE(PG8_SA(1, 0), a3, voffA);
            PG8_WAIT_V(8); PG8_WAIT_L(0); PG8_BAR; PG8_MMA(1, 0, At, B0); PG8_MMA(1, 1, At, B1); PG8_BAR; PG8_SCHED;
            } else {
            PG8_LDB(B0, 0, 0); PG8_SCHED; PG8_LDA(At, 0, 0); PG8_STAGE(PG8_SA(1, 1), a1 + hstepA, voffA);
            PG8_WAIT_L(8); PG8_BAR; PG8_WAIT_L(0); PG8_MMA(0, 0, At, B0); PG8_BAR; PG8_SCHED;
            PG8_LDB(B1, 0, 1); PG8_STAGE(PG8_SB(0, 0), b2, voffB);
            PG8_BAR; PG8_WAIT_L(0); PG8_MMA(0, 1, At, B1); PG8_BAR;
            PG8_LDA(At, 0, 1); PG8_STAGE(PG8_SA(0, 0), a2, voffA);
            PG8_BAR; PG8_WAIT_L(0); PG8_MMA(1, 0, At, B0); PG8_BAR; PG8_SCHED;
            PG8_STAGE(PG8_SB(0, 1), b2 + hstepB, voffB);
            PG8_WAIT_V(6); PG8_BAR; PG8_MMA(1, 1, At, B1); PG8_BAR;
            PG8_LDB(B0, 1, 0); PG8_SCHED; PG8_LDA(At, 1, 0); PG8_STAGE(PG8_SA(0, 1), a2 + hstepA, voffA);
            PG8_WAIT_L(8); PG8_BAR; PG8_WAIT_L(0); PG8_MMA(0, 0, At, B0); PG8_BAR; PG8_SCHED;
            PG8_LDB(B1, 1, 1); PG8_STAGE(PG8_SB(1, 0), b3, voffB);
            PG8_BAR; PG8_WAIT_L(0); PG8_MMA(0, 1, At, B1); PG8_BAR;
            PG8_LDA(At, 1, 1); PG8_STAGE(PG8_SA(1, 0), a3, voffA);
            PG8_BAR; PG8_WAIT_L(0); PG8_MMA(1, 0, At, B0); PG8_BAR; PG8_SCHED;
            PG8_STAGE(PG8_SB(1, 1), b3 + hstepB, voffB);
            PG8_WAIT_V(6); PG8_BAR; PG8_MMA(1, 1, At, B1); PG8_BAR;
            }
        }
        if constexpr (ALIGN_EPI) { if (wr == 0) PG8_BAR; }
        if constexpr (!Epi::AFTER_DRAIN) { int le_; asm volatile("v_mbcnt_lo_u32_b32 %0, -1, 0\n\tv_mbcnt_hi_u32_b32 %0, -1, %0" : "=v"(le_)); E(acc, cur, wr, wc, le_ & 15, le_ >> 4); S.done(cur); }
        if (!has_next) break;
#pragma unroll
        for (int a = 0; a < 2; ++a)
#pragma unroll
            for (int b = 0; b < 2; ++b)
#pragma unroll
                for (int m = 0; m < 4; ++m)
#pragma unroll
                    for (int n = 0; n < 2; ++n) acc[a][b][m][n] = (f32x4){0.f, 0.f, 0.f, 0.f};
        cur = nxt; cA = nA; cB = nB; ++ui; after_epi = E.stores16();
        if constexpr (ALIGN_EPI) { if (wr == 1) PG8_BAR; }
    }
    PG8_WAIT_V(0);
    if constexpr (!ALIGN_EPI) { if (wr == 0) PG8_BAR; }
    PG8_BAR;
    if constexpr (Epi::AFTER_DRAIN) { E.fused(acc, cur, wr, wc, fr, fq, lds, wid, lane); S.done(cur); }
#undef PG8_SA
#undef PG8_SB
#undef PG8_STAGE
#undef PG8_LDA
#undef PG8_LDB
#undef PG8_MMA
#undef PG8_WAIT_V
#undef PG8_WAIT_V_RLX
#undef PG8_WAIT_L
#undef PG8_BAR
#undef PG8_SCHED
}
}
#define GAS __attribute__((address_space(1)))
#define LAS __attribute__((address_space(3)))
typedef unsigned short bf16;
typedef unsigned v4u __attribute__((ext_vector_type(4)));
typedef float f32x4 __attribute__((ext_vector_type(4)));
typedef short bf16x8 __attribute__((ext_vector_type(8)));
typedef GAS unsigned gu32;
typedef GAS unsigned long long gu64;
#define RLX_AGENT __ATOMIC_RELAXED, __HIP_MEMORY_SCOPE_AGENT
#define LDS_WAIT() asm volatile("s_waitcnt lgkmcnt(0)" ::: "memory")
#define VM_WAIT() asm volatile("s_waitcnt vmcnt(0)" ::: "memory")
__device__ __forceinline__ unsigned long long rt() { return __builtin_amdgcn_s_memrealtime(); }
__device__ __forceinline__ unsigned f2bf(float f) { unsigned u = __builtin_bit_cast(unsigned, f); return (u + 0x7fffu + ((u >> 16) & 1u)) >> 16; }
__device__ __forceinline__ unsigned pk2(float lo, float hi) { return f2bf(lo) | (f2bf(hi) << 16); }
#define XB_TMO      128
#define XB_XCNT(j)  (256  + 64 * (j))
#define XB_XSUB(j)  (1280 + 64 * (j))
#define XB_XGEN(j)  (2304 + 64 * (j))
#define XB_TOP      3328
#define XB_TOPGEN   3392
#define XCD_BAR_WORDS 3456
#define XB_SPIN_CAP (1u << 18)

__device__ __forceinline__ unsigned xb_ld(unsigned* p)              { return __hip_atomic_load(p, __ATOMIC_RELAXED, __HIP_MEMORY_SCOPE_AGENT); }
__device__ __forceinline__ unsigned xb_add(unsigned* p, unsigned v) { return __hip_atomic_fetch_add(p, v, __ATOMIC_RELAXED, __HIP_MEMORY_SCOPE_AGENT); }
__device__ __forceinline__ unsigned xb_xcc_id() { return (unsigned)__builtin_amdgcn_s_getreg((3 << 11) | 20) & 0xFu; }
#define XB_SPIN(cond, bar) do { unsigned _sp = 0; while (cond) { __builtin_amdgcn_s_sleep(1); \
    if ((++_sp & 255u) == 0u) { if (xb_ld(&(bar)[XB_TMO])) break; if (_sp > XB_SPIN_CAP) { atomicAdd(&(bar)[XB_TMO], 1u); break; } } } } while (0)

struct XcdBarrier {
    unsigned* bar; unsigned x;
    volatile LAS unsigned* st;
};

__device__ __forceinline__ XcdBarrier xcd_barrier_post(unsigned* bar, volatile LAS unsigned* st) {
    XcdBarrier b; b.bar = bar; b.x = xb_xcc_id(); b.st = st;
    if (threadIdx.x == 0) (void)xb_add(&bar[XB_XCNT(b.x)], 1u);
    return b;
}
__device__ __forceinline__ void xcd_barrier_complete(unsigned* bar, unsigned x, unsigned& nloc, unsigned& nx) {
    const unsigned G = gridDim.x * gridDim.y * gridDim.z;
    unsigned sum, cnt, mine, sp = 0u;
    for (;;) {
        sum = 0u; cnt = 0u; mine = 0u;
#pragma unroll
        for (unsigned j = 0; j < 16; ++j) { const unsigned c = xb_ld(&bar[XB_XCNT(j)]); sum += c; cnt += (c > 0u) ? 1u : 0u; mine = (j == x) ? c : mine; }
        if (sum == G) break;
        __builtin_amdgcn_s_sleep(1);
        if ((++sp & 255u) == 0u) { if (xb_ld(&bar[XB_TMO])) break; if (sp > XB_SPIN_CAP) { atomicAdd(&bar[XB_TMO], 1u); break; } }
    }
    nloc = mine > 0u ? mine : 1u; nx = cnt > 0u ? cnt : 1u;
}

__device__ __forceinline__ void xcd_barrier(const XcdBarrier& b) {
    asm volatile("s_waitcnt vmcnt(0)" ::: "memory");
    __syncthreads();
    if (threadIdx.x == 0) {
        unsigned* bar = b.bar;
        __builtin_amdgcn_s_waitcnt(0);
        unsigned nloc = b.st[0], nx = b.st[1];
        if (nloc == 0u) { xcd_barrier_complete(bar, b.x, nloc, nx); b.st[0] = nloc; b.st[1] = nx; }
        const unsigned old = xb_add(&bar[XB_XSUB(b.x)], 1u);
        const unsigned gen = old / nloc;
        if (old + 1u == (gen + 1u) * nloc) {
            __builtin_amdgcn_fence(__ATOMIC_RELEASE, "agent");
            asm volatile("s_waitcnt vmcnt(0)" ::: "memory");
            const unsigned og = xb_add(&bar[XB_TOP], 1u);
            const unsigned tg = og / nx;
            if (og + 1u == (tg + 1u) * nx) xb_add(&bar[XB_TOPGEN], 1u);
            else XB_SPIN(xb_ld(&bar[XB_TOPGEN]) == tg, bar);
            __builtin_amdgcn_fence(__ATOMIC_ACQUIRE, "agent");
            xb_add(&bar[XB_XGEN(b.x)], 1u);
            asm volatile("s_waitcnt vmcnt(0)" ::: "memory");
        } else {
            XB_SPIN(xb_ld(&bar[XB_XGEN(b.x)]) == gen, bar);
            __builtin_amdgcn_fence(__ATOMIC_ACQUIRE, "agent");
            asm volatile("s_waitcnt vmcnt(0)" ::: "memory");
        }
    }
    __syncthreads();
}

typedef short s16x4 __attribute__((ext_vector_type(4)));
typedef float f32x16 __attribute__((ext_vector_type(16)));
typedef unsigned u32x2 __attribute__((ext_vector_type(2)));
typedef LAS unsigned char* ldsp;

constexpr int NWAVES = 8, NTHR = 512;
constexpr int NTOK = 65536, SEQ = 4096, NBATCH = 16, DM = 1024, DFF = 4096;
constexpr int A_N = 1792, A_NREAL = 1736;
constexpr int A_K = 1024, A_V = 1088, A_QI = 1152, A_KI = 1664, A_WI = 1728;
constexpr int B_N = 1536;
constexpr int C_N1 = 512, C_N1REAL = 416;
constexpr int C_NQ = 1536, C_NKV = 2048;
constexpr float EPS = 1e-6f, LOG2E = 1.4426950408889634f;

constexpr size_t MiB = 1u << 20;
constexpr size_t WS_CTL = 0, CTL_ZERO_BYTES = 1 * MiB;
constexpr size_t WS_WUP = 1 * MiB, WS_WDN = 33 * MiB, WS_WAIN = 65 * MiB, WS_WAOUT = 72 * MiB, WS_WBIN = 76 * MiB, WS_WBOUT = 79 * MiB;
constexpr size_t WS_WCIN = 81 * MiB, WS_WQB = 82 * MiB, WS_WKVB = 83 * MiB, WS_WCOUT = 84 * MiB;
constexpr size_t WS_CS = 86 * MiB, WS_SSQ = 94 * MiB, WS_CSTAT = 98 * MiB, WS_XB = 102 * MiB, WS_R = 230 * MiB;
constexpr size_t R_U = 0, R_PA = 0, R_MASK = 224 * MiB, R_O = 256 * MiB, R_PB = 0, R_KN = 384 * MiB, R_VN = 392 * MiB;
constexpr size_t R_LAT = 0, R_Q = 64 * MiB, R_KV = 256 * MiB, R_KR = 512 * MiB, R_OC = 576 * MiB;
constexpr size_t WS_SSQ2 = WS_R + 704 * MiB;
constexpr size_t WS_END = WS_SSQ2 + 4 * MiB;
constexpr int CW_BAR = 4096;

constexpr int RING_BYTES = 131072, LDS_BYTES = 163840, LDSCTL_OFF = LDS_BYTES - 512, MISC_OFF = LDSCTL_OFF + 320;

__device__ __forceinline__ int phase_tid(int wave) { int l; asm volatile("v_mbcnt_lo_u32_b32 %0, -1, 0\n\tv_mbcnt_hi_u32_b32 %0, -1, %0" : "=v"(l)); return wave * 64 + l; }
__device__ __forceinline__ float bf2f(unsigned short v) { return __uint_as_float((unsigned)v << 16); }
__device__ __forceinline__ float bflo(unsigned w) { return __uint_as_float(w << 16); }
__device__ __forceinline__ float bfhi(unsigned w) { return __uint_as_float(w & 0xffff0000u); }
__device__ __forceinline__ unsigned cvtpk(float lo, float hi) { return pg8::cvt_pk_bf16(lo, hi); }
__device__ __forceinline__ float wave_sum(float v) {
    return xl::add32(xl::add16(xl::add8(xl::add4(xl::add2(xl::add1(v))))));
}
__device__ __forceinline__ s16x4 lds_tr(const LAS void* p) {
    typedef short v4i16_t __attribute__((ext_vector_type(4)));
    return __builtin_bit_cast(s16x4, __builtin_amdgcn_ds_read_tr16_b64_v4i16((LAS v4i16_t*)p));
}
__device__ __forceinline__ bf16x8 cat8(s16x4 a, s16x4 b) { return (bf16x8){a[0], a[1], a[2], a[3], b[0], b[1], b[2], b[3]}; }

__device__ __forceinline__ int t5_bucket(int n) {
    if (n < 16) return n;
    if (n >= 128) return 31;
    int b = 16 + (int)(logf((float)n * 0.0625f) * (16.0f / 2.0794415416798357f));
    return b > 31 ? 31 : b;
}

__device__ __forceinline__ void transpose_item(const float* __restrict__ W, int K, int Kreal, int Nreal, bf16* WT, const float* __restrict__ gain, LAS float* scr, int item, int nblk, int lane) {
    const int kb = item / nblk, nb = item % nblk, k0 = 64 * kb, n0 = 64 * nb;
    const int nq = n0 + 4 * (lane & 15);
    const bool vec = ((Nreal & 3) == 0) && (nq + 3 < Nreal);
    f32x4 vv[16]; float gg[16];
#pragma unroll
    for (int i = 0; i < 16; ++i) {
        const int kk = 4 * i + (lane >> 4); vv[i] = (f32x4){0.f, 0.f, 0.f, 0.f}; gg[i] = 1.0f;
        if (k0 + kk < Kreal) {
            const float* rp = W + (size_t)(k0 + kk) * Nreal + nq;
            if (vec) vv[i] = *(const f32x4*)rp;
            else { if (nq + 0 < Nreal) vv[i][0] = rp[0]; if (nq + 1 < Nreal) vv[i][1] = rp[1]; if (nq + 2 < Nreal) vv[i][2] = rp[2]; if (nq + 3 < Nreal) vv[i][3] = rp[3]; }
            if (gain) gg[i] = gain[k0 + kk];
        }
    }
#pragma unroll
    for (int i = 0; i < 16; ++i) {
        const int kk = 4 * i + (lane >> 4);
        *(LAS f32x4*)(scr + kk * 68 + ((4 * (lane & 15) + 4 * (kk >> 3)) & 63)) = vv[i] * gg[i];
    }
    LDS_WAIT(); asm volatile("" ::: "memory");
    const int c = lane & 7;
#pragma unroll
    for (int j = 0; j < 8; ++j) { const int nn = (lane >> 3) + 8 * j; const LAS float* s = scr + (8 * c) * 68 + ((nn + 4 * c) & 63);
        v4u o; o.x = pk2(s[0 * 68], s[1 * 68]); o.y = pk2(s[2 * 68], s[3 * 68]); o.z = pk2(s[4 * 68], s[5 * 68]); o.w = pk2(s[6 * 68], s[7 * 68]);
        const int ncol = n0 + nn, cl = ncol & 255;
        const int brow = (ncol & ~255) + 128 * ((cl & 63) >> 5) + 32 * (cl >> 6) + (cl & 31);
        *(v4u*)(WT + (size_t)brow * K + k0 + 8 * c) = o; }
    LDS_WAIT(); asm volatile("" ::: "memory");
}

struct Ptrs {
    const float* in[24]; float* out; unsigned char* ws;
};

__device__ __forceinline__ void prologue(const Ptrs& P, ldsp lds, int gw, int NGW, int wave) {
    const int lane = phase_tid(wave) & 63;
    LAS float* scr = (LAS float*)(lds + wave * 17408);
    unsigned char* ws = P.ws;
    {
        constexpr int I_UP = 16 * 64, I_DN = 64 * 16, I_AIN = 16 * (A_N / 64), I_SQ = 16 * 16, I_BIN = 16 * (B_N / 64), I_CIN = 16 * (C_N1 / 64), I_QB = 4 * (C_NQ / 64), I_KVB = 2 * (C_NKV / 64);
        constexpr int E0 = 4 * I_UP, E1 = E0 + 4 * I_DN, E2 = E1 + 2 * I_AIN, E3 = E2 + 2 * I_SQ, E4 = E3 + I_BIN, E5 = E4 + I_SQ, E6 = E5 + I_CIN, E7 = E6 + I_QB, E8 = E7 + I_KVB, E9 = E8 + I_SQ;
#pragma unroll 1
        for (int it = gw; it < E9; it += NGW) {
            const float* src; const float* gain = nullptr; bf16* dst; int KK = DM, NREAL = DM, NPAD = DM, li, KREAL = 0;
            if (it < E0)      { const int l = it / I_UP; li = it - l * I_UP; src = P.in[5] + (size_t)l * DM * DFF; NREAL = DFF; NPAD = DFF; dst = (bf16*)(ws + WS_WUP + (size_t)l * 8 * MiB); gain = P.in[4] + l * DM; }
            else if (it < E1) { const int l = (it - E0) / I_DN; li = it - E0 - l * I_DN; src = P.in[6] + (size_t)l * DM * DFF; KK = DFF; dst = (bf16*)(ws + WS_WDN + (size_t)l * 8 * MiB); }
            else if (it < E2) { const int i = (it - E1) / I_AIN; li = it - E1 - i * I_AIN; src = P.in[7] + (size_t)i * DM * A_NREAL; NREAL = A_NREAL; NPAD = A_N; dst = (bf16*)(ws + WS_WAIN + (size_t)i * (A_N * DM * 2)); gain = P.in[3] + (i == 0 ? 0 : 3) * DM; }
            else if (it < E3) { const int i = (it - E2) / I_SQ; li = it - E2 - i * I_SQ; src = P.in[10] + (size_t)i * DM * DM; dst = (bf16*)(ws + WS_WAOUT + (size_t)i * 2 * MiB); }
            else if (it < E4) { li = it - E3; src = P.in[11]; NREAL = B_N; NPAD = B_N; dst = (bf16*)(ws + WS_WBIN); gain = P.in[3] + 1 * DM; }
            else if (it < E5) { li = it - E4; src = P.in[15]; dst = (bf16*)(ws + WS_WBOUT); }
            else if (it < E6) { li = it - E5; src = P.in[16]; NREAL = C_N1REAL; NPAD = C_N1; dst = (bf16*)(ws + WS_WCIN); gain = P.in[3] + 2 * DM; }
            else if (it < E7) { li = it - E6; src = P.in[18]; KK = 256; NREAL = C_NQ; NPAD = C_NQ; dst = (bf16*)(ws + WS_WQB); gain = P.in[17]; }
            else if (it < E8) { li = it - E7; src = P.in[20]; KK = 128; NREAL = C_NKV; NPAD = C_NKV; dst = (bf16*)(ws + WS_WKVB); gain = P.in[19]; }
            else              { li = it - E8; src = P.in[23]; dst = (bf16*)(ws + WS_WCOUT); }
            transpose_item(src, KK, KREAL ? KREAL : KK, NREAL, dst, gain, scr, li, NPAD / 64, lane);
        }
    }
    {
        const float* x = P.in[0]; bf16* xb = (bf16*)(ws + WS_XB); float* ssq = (float*)(ws + WS_SSQ);
        for (int m0 = gw; m0 < NTOK; m0 += 2 * NGW) {
            f32x4 v[2][4];
#pragma unroll
            for (int rr = 0; rr < 2; ++rr) { const int m = m0 + rr * NGW; if (m < NTOK) { const f32x4* xr = (const f32x4*)(x + (size_t)m * DM) + lane;
#pragma unroll
                for (int j = 0; j < 4; ++j) v[rr][j] = xr[64 * j]; } }
#pragma unroll
            for (int rr = 0; rr < 2; ++rr) { const int m = m0 + rr * NGW; if (m < NTOK) {
                float s = 0.f;
#pragma unroll
                for (int j = 0; j < 4; ++j) s += (v[rr][j][0] * v[rr][j][0] + v[rr][j][1] * v[rr][j][1]) + (v[rr][j][2] * v[rr][j][2] + v[rr][j][3] * v[rr][j][3]);
                s = wave_sum(s);
                u32x2* o8 = (u32x2*)(xb + (size_t)m * DM) + lane;
#pragma unroll
                for (int j = 0; j < 4; ++j) { u32x2 w; w.x = pk2(v[rr][j][0], v[rr][j][1]); w.y = pk2(v[rr][j][2], v[rr][j][3]); o8[64 * j] = w; }
                if (lane < 16) ssq[(size_t)m * 16 + lane] = (lane == 0) ? s : 0.f; } }
        }
    }
    {
        const int* pos = (const int*)P.in[1]; float* cs = (float*)(ws + WS_CS);
        const int gt = gw * 64 + lane, NGT = NGW * 64;
        const int i = gt & 15;
        double inv_freq = 1.0; for (int k = 0; k < i; ++k) inv_freq *= 0.5623413251903491;
        for (int e0 = gt; e0 < NTOK * 16; e0 += 8 * NGT) {
            int pv[8];
#pragma unroll
            for (int u = 0; u < 8; ++u) { const int e = e0 + u * NGT; pv[u] = (e < NTOK * 16) ? pos[e >> 4] : 0; }
#pragma unroll
            for (int u = 0; u < 8; ++u) { const int e = e0 + u * NGT;
                if (e < NTOK * 16) {
                    const double rev = (double)pv[u] * inv_freq * 0.15915494309189535;
                    const float fr = (float)(rev - floor(rev));
                    pg8::f32x2 o; o[0] = __builtin_amdgcn_cosf(fr); o[1] = __builtin_amdgcn_sinf(fr);
                    *(pg8::f32x2*)(cs + 2 * (size_t)e) = o; } }
        }
    }
}

constexpr int A2_CAP = 64;
#ifndef A2DUP
#define A2DUP 0
#endif
constexpr int A2_QS = 8208;
constexpr int A2_T = 0, A2_MASK = 16 * A2_QS, A2_CAND = A2_MASK + 8192, A2_CCNT = A2_CAND + 8192;
__device__ __forceinline__ void phase_a2(ldsp lds, bf16* PA, unsigned* maskOut, f32x4* scr  , bf16* KN, bf16* VN  , const float* kgain, int vcu, int G, int wave) {
    const int w = wave;
    LAS unsigned* mask32 = (LAS unsigned*)(lds + A2_MASK);
    LAS unsigned long long* candk = (LAS unsigned long long*)(lds + A2_CAND);
    LAS unsigned* ccnt = (LAS unsigned*)(lds + A2_CCNT);
    { const int tid = phase_tid(wave); if (tid < 16) ccnt[tid] = 0u; }
    __syncthreads();
    int sbuf = 0;
    unsigned pm0 = 0u, pm1 = 0u, pm2 = 0u, pm3 = 0u; int prow = -1;
#define A2_FLUSH() do { if (prow >= 0) { const int m_ = phase_tid(wave) & 31; unsigned* mp_ = maskOut + (size_t)prow * 128 + m_; mp_[0] = pm0; mp_[32] = pm1; mp_[64] = pm2; mp_[96] = pm3; prow = -1; } } while (0)
    for (int p = vcu; p < 2048; p += G) {
#pragma unroll 1
      for (int half = 0; half < 2; ++half) {
        const int b = p >> 7, pr = p & 127, qt = half ? 255 - pr : pr, t0 = 16 * qt;
        const size_t rowbase = (size_t)b * SEQ;
        const int NT = qt + 1;
        const float NINF = -__builtin_inff();
        const f32x4* scrb = scr + (size_t)sbuf * 16384;
        _Pragma("unroll 1") for (int rp_ = 0; rp_ < 1 + (A2DUP & 1); ++rp_)
        {
            const int tid = phase_tid(wave); const int lane = tid & 63, j = lane & 15, g = lane >> 4; (void)lane; (void)j; (void)g;
            const int r16 = (tid >> 4) & 15, c4 = tid & 15;
            const u32x2 kvraw = *(const u32x2*)(PA + (rowbase + t0 + r16) * A_N + (tid < 256 ? A_K : A_V) + 4 * c4);
            const int nslots = (qt < 16) ? 0 : ((NT - w + 7) >> 3);
            const GAS bf16* kp = (const GAS bf16*)(PA + (rowbase + 16 * w + j) * A_N + A_KI + 8 * g);
            bf16x8 ring[4][2];
#pragma unroll
            for (int u = 0; u < 4; ++u) { ring[u][0] = *(const GAS bf16x8*)kp; ring[u][1] = *(const GAS bf16x8*)(kp + 32); kp += (size_t)128 * A_N; asm volatile("" : "+v"(kp)); }
            bf16x8 qb[8][2]; float wh[8]; v4u wr = (v4u){0u, 0u, 0u, 0u};
            if (qt >= 16) {
                const bf16* qrow = PA + (rowbase + t0 + j) * A_N;
#pragma unroll
                for (int h = 0; h < 8; ++h)
#pragma unroll
                    for (int ks = 0; ks < 2; ++ks) qb[h][ks] = *(const bf16x8*)(qrow + A_QI + 64 * h + 32 * ks + 8 * g);
                wr = *(const v4u*)(qrow + A_WI);
            }
            A2_FLUSH();
            if (tid < 256) {
                float k0 = bflo(kvraw.x), k1 = bfhi(kvraw.x), k2 = bflo(kvraw.y), k3 = bfhi(kvraw.y);
                float s = (k0 * k0 + k1 * k1) + (k2 * k2 + k3 * k3);
                s = xl::add8(xl::add4(xl::add2(xl::add1(s))));
                const float rs = 1.0f / sqrtf(s * (1.0f / 64.0f) + EPS);
                const f32x4 gk = *(const f32x4*)(kgain + 4 * c4);
                u32x2 o; o.x = cvtpk(k0 * rs * gk[0], k1 * rs * gk[1]); o.y = cvtpk(k2 * rs * gk[2], k3 * rs * gk[3]); *(u32x2*)(KN + (rowbase + t0 + r16) * 64 + 4 * c4) = o;
            } else {
                *(u32x2*)(VN + (rowbase + t0 + r16) * 64 + 4 * c4) = kvraw;
            }
            if (qt < 16) {
                for (int e = tid; e < 2048; e += NTHR) { const int q = e >> 7, wi = e & 127; const int nb = t0 + q + 1 - 32 * wi;
                    maskOut[(rowbase + t0 + q) * 128 + wi] = nb >= 32 ? 0xffffffffu : (nb <= 0 ? 0u : ((1u << nb) - 1u)); }
                break;
            }
            const float wsc = 0.5f * 0.35355339059327373f * 0.125f;
            wh[0] = bflo(wr.x) * wsc; wh[1] = bfhi(wr.x) * wsc; wh[2] = bflo(wr.y) * wsc; wh[3] = bfhi(wr.y) * wsc;
            wh[4] = bflo(wr.z) * wsc; wh[5] = bfhi(wr.z) * wsc; wh[6] = bflo(wr.w) * wsc; wh[7] = bfhi(wr.w) * wsc;
            bf16x8 ql[2];
#pragma unroll
            for (int ks = 0; ks < 2; ++ks) {
                float acc8[8] = {0.f, 0.f, 0.f, 0.f, 0.f, 0.f, 0.f, 0.f};
#pragma unroll
                for (int h = 0; h < 8; ++h) { const v4u qw = __builtin_bit_cast(v4u, qb[h][ks]);
                    acc8[0] += wh[h] * bflo(qw.x); acc8[1] += wh[h] * bfhi(qw.x); acc8[2] += wh[h] * bflo(qw.y); acc8[3] += wh[h] * bfhi(qw.y);
                    acc8[4] += wh[h] * bflo(qw.z); acc8[5] += wh[h] * bfhi(qw.z); acc8[6] += wh[h] * bflo(qw.w); acc8[7] += wh[h] * bfhi(qw.w); }
                v4u o; o.x = cvtpk(acc8[0], acc8[1]); o.y = cvtpk(acc8[2], acc8[3]); o.z = cvtpk(acc8[4], acc8[5]); o.w = cvtpk(acc8[6], acc8[7]);
                ql[ks] = __builtin_bit_cast(bf16x8, o);
            }
            GAS char* spw = (GAS char*)(scr + (size_t)sbuf * 16384) + (size_t)w * 64; asm volatile("" : "+s"(spw));
            const unsigned voff = (unsigned)j * 16384u + (unsigned)g * 16u;
            const unsigned toff = (unsigned)j * A2_QS + (unsigned)g * 16u + (unsigned)w * 64u;
            const int ngroups = (((NT + 7) >> 3) + 3) >> 2;
#define A2_TILE(i_, u_, STORE_) do { \
                    const int kt_ = w + 8 * (i_); \
                    const bf16x8 ka0 = ring[u_][0], ka1 = ring[u_][1]; \
                    f32x4 s = __builtin_amdgcn_mfma_f32_16x16x32_bf16(ka0, ql[0], (f32x4){0.f, 0.f, 0.f, 0.f}, 0, 0, 0); \
                    s = __builtin_amdgcn_mfma_f32_16x16x32_bf16(ka1, ql[1], s, 0, 0, 0); \
                    _Pragma("unroll") for (int h = 0; h < 8; ++h) { \
                        f32x4 a = __builtin_amdgcn_mfma_f32_16x16x32_bf16(ka0, qb[h][0], (f32x4){0.f, 0.f, 0.f, 0.f}, 0, 0, 0); \
                        a = __builtin_amdgcn_mfma_f32_16x16x32_bf16(ka1, qb[h][1], a, 0, 0, 0); \
                          \
                        _Pragma("unroll") for (int r = 0; r < 4; ++r) { float t_ = __builtin_fmaf(__builtin_fabsf(a[r]), wh[h], s[r]); asm volatile("" : "+v"(t_)); s[r] = t_; } } \
                    if (kt_ >= qt) { asm volatile("" ::: "memory");     \
                        _Pragma("unroll") for (int r = 0; r < 4; ++r) if (kt_ > qt || 4 * g + r > j) s[r] = NINF; } \
                    __builtin_amdgcn_sched_barrier(0);        \
                    ring[u_][0] = *(const GAS bf16x8*)kp; ring[u_][1] = *(const GAS bf16x8*)(kp + 32); \
                    __builtin_amdgcn_sched_barrier(0); \
                    STORE_; \
                    kp += (size_t)128 * A_N; asm volatile("" : "+v"(kp)); } while (0)
            const int ng_lds = ngroups < 4 ? ngroups : 4;
#pragma unroll 1
            for (int gi = 0; gi < ng_lds; ++gi) {
#pragma unroll
                for (int u = 0; u < 4; ++u) A2_TILE(4 * gi + u, u, *(LAS f32x4*)(lds + A2_T + toff + (unsigned)(4 * gi + u) * 512u) = s);
            }
#pragma unroll 1
            for (int gi = 4; gi < ngroups; ++gi) {
#pragma unroll
                for (int u = 0; u < 4; ++u) A2_TILE(4 * gi + u, u, *(GAS f32x4*)(spw + (size_t)(4 * gi + u) * 512 + voff) = s);
            }
#undef A2_TILE
        }
        if (qt < 16) continue;
        asm volatile("s_waitcnt vmcnt(0)" ::: "memory");
        __syncthreads();
        _Pragma("unroll 1") for (int rp_ = 0; rp_ < 1 + ((A2DUP >> 1) & 1); ++rp_)
        {
            const int tid = phase_tid(wave); const int lane = tid & 63, hq0 = lane >> 5, m0 = lane & 31, q0 = 2 * w + hq0;
#define A2_SQ ((const GAS f32x4*)scrb + (size_t)q0 * 1024 + m0)
            const int imax = (NT + 7) >> 3;
            f32x4 sc[32];
            {
                const LAS f32x4* tq = (const LAS f32x4*)(lds + A2_T + (unsigned)q0 * A2_QS) + m0;
#pragma unroll
                for (int gi = 0; gi < 8; ++gi) {
                    if (4 * gi < imax) {
#pragma unroll
                        for (int ii = 0; ii < 4; ++ii) { if (gi < 4) sc[4 * gi + ii] = tq[(4 * gi + ii) * 32]; else sc[4 * gi + ii] = A2_SQ[(4 * gi + ii) * 32]; }
                    } else {
#pragma unroll
                        for (int ii = 0; ii < 4; ++ii) sc[4 * gi + ii] = (f32x4){NINF, NINF, NINF, NINF};
                    }
                }
            }
            asm volatile("s_waitcnt lgkmcnt(0)" ::: "memory");
            __syncthreads();
            float mx = NINF, mn = __builtin_inff();
#pragma unroll
            for (int gi = 0; gi < 8; ++gi) {
                if (4 * gi < imax) {
#pragma unroll
                    for (int ii = 0; ii < 4; ++ii) { const int i = 4 * gi + ii; const f32x4 v = sc[i];
                        mx = fmaxf(fmaxf(mx, fmaxf(v[0], v[1])), fmaxf(v[2], v[3]));
                        if (i >= imax - 2) {
#pragma unroll
                            for (int r = 0; r < 4; ++r) mn = fminf(mn, v[r] == NINF ? __builtin_inff() : v[r]);
                        } else mn = fminf(fminf(mn, fminf(v[0], v[1])), fminf(v[2], v[3]));
                    }
                }
            }
            mx = xl::max16(xl::max8(xl::max4(xl::max2(xl::max1(mx))))); mn = xl::min16(xl::min8(xl::min4(xl::min2(xl::min1(mn)))));
            float lo = mn, hi = mx + (fabsf(mx) * 1e-6f + 1e-30f);
            int clo = t0 + q0 + 1, chi = 0; bool done = false, tie = false;
            for (int it = 0; it < 96; ++it) {
                if (!done && clo - chi <= A2_CAP) done = true;
                const float mid = 0.5f * (lo + hi);
                if (!done && !(mid > lo && mid < hi)) { tie = true; done = true; }
                if (__all(done)) break;
                int c0 = 0, c1 = 0, c2 = 0, c3 = 0;
#define A2_CNT16(A_) do { unsigned long long m0_, m1_, m2_; \
                    asm("v_cmp_ge_f32_e64 %[m0], %[a0], %[mid]\n\tv_cmp_ge_f32_e64 %[m1], %[a1], %[mid]\n\tv_cmp_ge_f32_e64 %[m2], %[a2], %[mid]\n\tv_addc_co_u32_e64 %[c0], %[m0], 0, %[c0], %[m0]\n\tv_cmp_ge_f32_e64 %[m0], %[a3], %[mid]\n\tv_addc_co_u32_e64 %[c1], %[m1], 0, %[c1], %[m1]\n\tv_cmp_ge_f32_e64 %[m1], %[a4], %[mid]\n\tv_addc_co_u32_e64 %[c2], %[m2], 0, %[c2], %[m2]\n\tv_cmp_ge_f32_e64 %[m2], %[a5], %[mid]\n\tv_addc_co_u32_e64 %[c3], %[m0], 0, %[c3], %[m0]\n\tv_cmp_ge_f32_e64 %[m0], %[a6], %[mid]\n\tv_addc_co_u32_e64 %[c0], %[m1], 0, %[c0], %[m1]\n\tv_cmp_ge_f32_e64 %[m1], %[a7], %[mid]\n\tv_addc_co_u32_e64 %[c1], %[m2], 0, %[c1], %[m2]\n\tv_cmp_ge_f32_e64 %[m2], %[a8], %[mid]\n\tv_addc_co_u32_e64 %[c2], %[m0], 0, %[c2], %[m0]\n\tv_cmp_ge_f32_e64 %[m0], %[a9], %[mid]\n\tv_addc_co_u32_e64 %[c3], %[m1], 0, %[c3], %[m1]\n\tv_cmp_ge_f32_e64 %[m1], %[a10], %[mid]\n\tv_addc_co_u32_e64 %[c0], %[m2], 0, %[c0], %[m2]\n\tv_cmp_ge_f32_e64 %[m2], %[a11], %[mid]\n\tv_addc_co_u32_e64 %[c1], %[m0], 0, %[c1], %[m0]\n\tv_cmp_ge_f32_e64 %[m0], %[a12], %[mid]\n\tv_addc_co_u32_e64 %[c2], %[m1], 0, %[c2], %[m1]\n\tv_cmp_ge_f32_e64 %[m1], %[a13], %[mid]\n\tv_addc_co_u32_e64 %[c3], %[m2], 0, %[c3], %[m2]\n\tv_cmp_ge_f32_e64 %[m2], %[a14], %[mid]\n\tv_addc_co_u32_e64 %[c0], %[m0], 0, %[c0], %[m0]\n\tv_cmp_ge_f32_e64 %[m0], %[a15], %[mid]\n\tv_addc_co_u32_e64 %[c1], %[m1], 0, %[c1], %[m1]\n\tv_addc_co_u32_e64 %[c2], %[m2], 0, %[c2], %[m2]\n\tv_addc_co_u32_e64 %[c3], %[m0], 0, %[c3], %[m0]" \
                        : [c0] "+v"(c0), [c1] "+v"(c1), [c2] "+v"(c2), [c3] "+v"(c3), [m0] "=&s"(m0_), [m1] "=&s"(m1_), [m2] "=&s"(m2_) \
                        : [a0] "v"(A_[0][0]), [a1] "v"(A_[0][1]), [a2] "v"(A_[0][2]), [a3] "v"(A_[0][3]), [a4] "v"(A_[1][0]), [a5] "v"(A_[1][1]), [a6] "v"(A_[1][2]), [a7] "v"(A_[1][3]), [a8] "v"(A_[2][0]), [a9] "v"(A_[2][1]), [a10] "v"(A_[2][2]), [a11] "v"(A_[2][3]), [a12] "v"(A_[3][0]), [a13] "v"(A_[3][1]), [a14] "v"(A_[3][2]), [a15] "v"(A_[3][3]), [mid] "v"(mid)); } while (0)
#pragma unroll
                for (int gi = 0; gi < 8; ++gi) {
                    if (4 * gi < imax) { const f32x4 (&G_)[4] = *(const f32x4 (*)[4])&sc[4 * gi]; A2_CNT16(G_); }
                }
#undef A2_CNT16
                int c = (c0 + c1) + (c2 + c3);
                c = xl::iadd16(xl::iadd8(xl::iadd4(xl::iadd2(xl::iadd1(c)))));
                if (!done) { if (c >= 256) { lo = mid; clo = c; } else { hi = mid; chi = c; } }
            }
            const int need = 256 - chi;
            const int lane2 = phase_tid(wave) & 63, m = lane2 & 31, q = 2 * w + (lane2 >> 5);
            const bool bigtie = tie && (clo - chi > A2_CAP);
            int J = -1;
            if (__any(bigtie)) {
                { GAS f32x4* sqw = (GAS f32x4*)A2_SQ;
#pragma unroll
                for (int i = 0; i < 16; ++i) sqw[i * 32] = sc[i]; }
                asm volatile("s_waitcnt vmcnt(0)" ::: "memory");
                int jlo = -1, jhi = SEQ - 1;
                for (int it = 0; it < 13; ++it) {
                    const int jm = (jlo + jhi) >> 1;
                    int c = 0;
#pragma unroll 1
                    for (int i = 0; i < 32; ++i) {
                        const f32x4 s4 = A2_SQ[i * 32];
#pragma unroll
                        for (int r = 0; r < 4; ++r) c += (s4[r] == lo && (4 * (i * 32 + m) + r) <= jm) ? 1 : 0;
                    }
                    c = xl::iadd16(xl::iadd8(xl::iadd4(xl::iadd2(xl::iadd1(c)))));
                    if (jhi - jlo > 1) { if (c >= need) jhi = jm; else jlo = jm; }
                }
                J = jhi;
            }
            int ctot = 0;
            {
                const float loc = bigtie ? hi : lo;
                unsigned bcw[4] = {0u, 0u, 0u, 0u}; int ccn = 0;
#pragma unroll
                for (int gi = 0; gi < 8; ++gi) {
                    if (4 * gi < imax) {
#pragma unroll
                        for (int ii = 0; ii < 4; ++ii) {
                            const int i = 4 * gi + ii;
                            unsigned bs = 0u, bc = 0u;
#pragma unroll
                            for (int r = 0; r < 4; ++r) { const float s = sc[i][r]; const unsigned a = (s >= hi) ? 1u : 0u, c = (s >= loc) ? 1u : 0u; bs |= a << r; bc |= (c & ~a) << r; }
                            unsigned v = bs << (4 * (m & 7));
                            v = xl::or4(xl::or2(xl::or1(v)));
                            if ((m & 7) == 0) mask32[q * 128 + 4 * i + (m >> 3)] = v;
                            bcw[gi >> 1] |= bc << (16 * (gi & 1) + 4 * ii); ccn += __popc(bc);
                        }
                    } else {
#pragma unroll
                        for (int ii = 0; ii < 4; ++ii) if ((m & 7) == 0) mask32[q * 128 + 4 * (4 * gi + ii) + (m >> 3)] = 0u;
                    }
                }
                {
                    int ln_ = lane2; asm volatile("" : "+v"(ln_));
                    const int mm_ = ln_ & 31; int pre_ = ccn;
#pragma unroll
                    for (int o_ = 1; o_ < 32; o_ <<= 1) { const int v_ = __builtin_amdgcn_ds_bpermute((mm_ >= o_ ? ln_ - o_ : ln_) << 2, pre_); if (mm_ >= o_) pre_ += v_; }
                    ctot = __builtin_amdgcn_ds_bpermute((ln_ | 31) << 2, pre_);
                    unsigned pos = (unsigned)(pre_ - ccn);
#pragma unroll
                    for (int gi = 0; gi < 8; ++gi) {
                        if (4 * gi < imax) {
#pragma unroll
                            for (int ii = 0; ii < 4; ++ii) {
                                const int i = 4 * gi + ii; const unsigned bc = (bcw[gi >> 1] >> (16 * (gi & 1) + 4 * ii)) & 15u;
                                if (bc) {
#pragma unroll
                                    for (int r = 0; r < 4; ++r) if ((bc >> r) & 1u) {
                                        if (pos < (unsigned)A2_CAP) {
                                            const unsigned sb_ = __float_as_uint(sc[i][r] + 0.0f), sk_ = sb_ ^ ((unsigned)((int)sb_ >> 31) | 0x80000000u);
                                            candk[q * A2_CAP + pos] = ((unsigned long long)sk_ << 32) | (unsigned long long)(~(unsigned)(4 * (i * 32 + m) + r)); }
                                        ++pos;
                                    }
                                }
                            }
                        }
                    }
                }
            }
            LDS_WAIT(); asm volatile("" ::: "memory");
            if (__any(bigtie)) {
#pragma unroll 1
                for (int i = 0; i < 32; ++i) {
                    const f32x4 s4 = A2_SQ[i * 32];
#pragma unroll
                    for (int r = 0; r < 4; ++r) { const int idx = 4 * (i * 32 + m) + r;
                        if (bigtie && s4[r] == lo && idx <= J) atomicOr((unsigned*)(mask32 + q * 128 + (idx >> 5)), 1u << (idx & 31)); }
                }
            }
            {
                const int C = min(ctot, A2_CAP), nd = bigtie ? 0 : need;
                LAS unsigned long long* cl = candk + q * A2_CAP;
                unsigned long long z_ = 0ull; asm volatile("" : "+v"(z_));
                if (m >= C) cl[m] = z_;
                if (m + 32 >= C) cl[m + 32] = z_;
                LDS_WAIT(); asm volatile("" ::: "memory");
                const unsigned long long me0 = cl[m], me1 = cl[m + 32];
                int rank0 = 0, rank1 = 0;
                for (int o0 = 0; o0 < C; o0 += 8) {
                    unsigned long long e_[8];
#pragma unroll
                    for (int k = 0; k < 8; ++k) e_[k] = cl[o0 + k];
                    unsigned long long m0_, m1_, m2_;
                    asm("v_cmp_gt_u64_e64 %[m0], %[o0], %[me0]\n\tv_cmp_gt_u64_e64 %[m1], %[o0], %[me1]\n\tv_cmp_gt_u64_e64 %[m2], %[o1], %[me0]\n\tv_addc_co_u32_e64 %[r0], %[m0], 0, %[r0], %[m0]\n\tv_cmp_gt_u64_e64 %[m0], %[o1], %[me1]\n\tv_addc_co_u32_e64 %[r1], %[m1], 0, %[r1], %[m1]\n\tv_cmp_gt_u64_e64 %[m1], %[o2], %[me0]\n\tv_addc_co_u32_e64 %[r0], %[m2], 0, %[r0], %[m2]\n\tv_cmp_gt_u64_e64 %[m2], %[o2], %[me1]\n\tv_addc_co_u32_e64 %[r1], %[m0], 0, %[r1], %[m0]\n\tv_cmp_gt_u64_e64 %[m0], %[o3], %[me0]\n\tv_addc_co_u32_e64 %[r0], %[m1], 0, %[r0], %[m1]\n\tv_cmp_gt_u64_e64 %[m1], %[o3], %[me1]\n\tv_addc_co_u32_e64 %[r1], %[m2], 0, %[r1], %[m2]\n\tv_cmp_gt_u64_e64 %[m2], %[o4], %[me0]\n\tv_addc_co_u32_e64 %[r0], %[m0], 0, %[r0], %[m0]\n\tv_cmp_gt_u64_e64 %[m0], %[o4], %[me1]\n\tv_addc_co_u32_e64 %[r1], %[m1], 0, %[r1], %[m1]\n\tv_cmp_gt_u64_e64 %[m1], %[o5], %[me0]\n\tv_addc_co_u32_e64 %[r0], %[m2], 0, %[r0], %[m2]\n\tv_cmp_gt_u64_e64 %[m2], %[o5], %[me1]\n\tv_addc_co_u32_e64 %[r1], %[m0], 0, %[r1], %[m0]\n\tv_cmp_gt_u64_e64 %[m0], %[o6], %[me0]\n\tv_addc_co_u32_e64 %[r0], %[m1], 0, %[r0], %[m1]\n\tv_cmp_gt_u64_e64 %[m1], %[o6], %[me1]\n\tv_addc_co_u32_e64 %[r1], %[m2], 0, %[r1], %[m2]\n\tv_cmp_gt_u64_e64 %[m2], %[o7], %[me0]\n\tv_addc_co_u32_e64 %[r0], %[m0], 0, %[r0], %[m0]\n\tv_cmp_gt_u64_e64 %[m0], %[o7], %[me1]\n\tv_addc_co_u32_e64 %[r1], %[m1], 0, %[r1], %[m1]\n\tv_addc_co_u32_e64 %[r0], %[m2], 0, %[r0], %[m2]\n\tv_addc_co_u32_e64 %[r1], %[m0], 0, %[r1], %[m0]"
                        : [r0] "+v"(rank0), [r1] "+v"(rank1), [m0] "=&s"(m0_), [m1] "=&s"(m1_), [m2] "=&s"(m2_)
                        : [o0] "v"(e_[0]), [o1] "v"(e_[1]), [o2] "v"(e_[2]), [o3] "v"(e_[3]), [o4] "v"(e_[4]), [o5] "v"(e_[5]), [o6] "v"(e_[6]), [o7] "v"(e_[7]), [me0] "v"(me0), [me1] "v"(me1));
                }
                if (m < C && rank0 < nd) { const int idx = (int)~(unsigned)me0; atomicOr((unsigned*)(mask32 + q * 128 + (idx >> 5)), 1u << (idx & 31)); }
                if (m + 32 < C && rank1 < nd) { const int idx = (int)~(unsigned)me1; atomicOr((unsigned*)(mask32 + q * 128 + (idx >> 5)), 1u << (idx & 31)); }
            }
            LDS_WAIT(); asm volatile("" ::: "memory");
            pm0 = mask32[q * 128 + m]; pm1 = mask32[q * 128 + m + 32]; pm2 = mask32[q * 128 + m + 64]; pm3 = mask32[q * 128 + m + 96]; prow = (int)(rowbase + t0 + q);
            if (m == 0) ccnt[q] = 0u;
            LDS_WAIT(); asm volatile("" ::: "memory");
        }
        sbuf ^= 1;
      }
    }
    A2_FLUSH();
    __syncthreads();
}
#undef A2_FLUSH
#undef A2_SQ

constexpr int A3_BIAS = 0, A3_GAIN = 8448, A3_WAVE0 = 8704, A3_WSTRIDE = 10240, A3_VS = 144;
__device__ __forceinline__ void phase_a3(ldsp lds, const bf16* PA, const bf16* KN, const bf16* VN, const unsigned* maskIn, bf16* O, const float* qgain, const float* rel_bias, int gw, int NGW, int wave) {
    const int tid = phase_tid(wave);
    const int lane = tid & 63, w = wave, j = lane & 15, g = lane >> 4;
    LAS float* biasT = (LAS float*)(lds + A3_BIAS);
    for (int e = tid; e < 129 * 16; e += NTHR) { const int n = e >> 4, h = e & 15; biasT[e] = rel_bias[t5_bucket(n) * 16 + h] * LOG2E; }
    LAS float* gainT = (LAS float*)(lds + A3_GAIN);
    if (tid < 64) gainT[tid] = qgain[tid];
    __syncthreads();
    const ldsp selb = lds + A3_WAVE0 + w * A3_WSTRIDE;
    const ldsp Vl = lds + A3_WAVE0 + w * A3_WSTRIDE + 1024;
    const ldsp Kl = Vl + 32 * A3_VS;
    const float QS = 0.125f * LOG2E;
    unsigned long long mw_n = 0ull; v4u r0_n = (v4u){0u, 0u, 0u, 0u}, r1_n = (v4u){0u, 0u, 0u, 0u};
    const unsigned moff = (unsigned)lane * 8u, qoff = (unsigned)(64 * j + 8 * g) * 2u, koff = (unsigned)g * 16u, voff = (unsigned)(lane & 7) * 16u;
#define A3_REQM(qq) do { unsigned mo_ = moff; asm volatile("" : "+v"(mo_));     \
        mw_n = *(const unsigned long long*)((const char*)(maskIn + (size_t)(qq) * 128) + mo_); } while (0)
#define A3_REQQ(qq) do { unsigned qo_ = qoff; asm volatile("" : "+v"(qo_)); const char* qp_ = (const char*)(PA + (size_t)(qq) * A_N); r0_n = *(const v4u*)(qp_ + qo_); r1_n = *(const v4u*)(qp_ + qo_ + 64); } while (0)
#define A3_BUILD(mw_, sel_, nk_) do { const int cnt_ = __popcll(mw_); int pre_ = cnt_; int ln_ = lane; asm volatile("" : "+v"(ln_));     \
        _Pragma("unroll") for (int o_ = 1; o_ < 64; o_ <<= 1) { const int v_ = __builtin_amdgcn_ds_bpermute((ln_ >= o_ ? ln_ - o_ : ln_) << 2, pre_); if (ln_ >= o_) pre_ += v_; } \
        nk_ = __builtin_amdgcn_readlane(pre_, 63); \
        { int off_ = pre_ - cnt_; unsigned long long m_ = (mw_); while (m_) { const int bpos_ = __ffsll((long long)m_) - 1; (sel_)[off_++] = (unsigned short)(64 * ln_ + bpos_); m_ &= m_ - 1; } } \
        for (int e_ = nk_ + ln_; e_ < 256; e_ += 64) (sel_)[e_] = 0; } while (0)
    v4u kb[4][4]; v4u vb[4][4];
#define A3_LOADKV(sel_, Kb_, Vb_, c, bf) do { \
        _Pragma("unroll") for (int m = 0; m < 4; ++m) { const unsigned vo = (unsigned)(sel_)[32 * (c) + 8 * m + (lane >> 3)] * 128u + voff; kb[bf][m] = *(const v4u*)((Kb_) + vo); vb[bf][m] = *(const v4u*)((Vb_) + vo); } } while (0)
    int nkeys_n = 0;
    if (gw < NTOK) {
        A3_REQM(gw); A3_REQQ(gw);
        LAS unsigned short* s0_ = (LAS unsigned short*)selb;
        A3_BUILD(mw_n, s0_, nkeys_n);
        LDS_WAIT(); asm volatile("" ::: "memory");
        const int b0_ = gw >> 12; const char* Kb0 = (const char*)(KN + (size_t)b0_ * SEQ * 64); const char* Vb0 = (const char*)(VN + (size_t)b0_ * SEQ * 64);
        A3_LOADKV(s0_, Kb0, Vb0, 0, 0); A3_LOADKV(s0_, Kb0, Vb0, 1, 1); A3_LOADKV(s0_, Kb0, Vb0, 2, 2);
    }
    int par = 0;
#pragma unroll 1
    for (int qi = gw; qi < NTOK; qi += NGW) {
        const int b = qi >> 12, t = qi & (SEQ - 1);
        const char* Kb = (const char*)(KN + (size_t)b * SEQ * 64); const char* Vb = (const char*)(VN + (size_t)b * SEQ * 64);
        const v4u r0 = r0_n, r1 = r1_n; const int nkeys = nkeys_n;
        LAS unsigned short* sel = (LAS unsigned short*)(selb + 512 * par); LAS unsigned short* seln = (LAS unsigned short*)(selb + 512 * (par ^ 1));
        const int qn = (qi + NGW < NTOK) ? qi + NGW : qi;
        const int bn = qn >> 12; const char* Kbn = (const char*)(KN + (size_t)bn * SEQ * 64); const char* Vbn = (const char*)(VN + (size_t)bn * SEQ * 64);
        A3_REQM(qn);
        bf16x8 qf0, qf1;
        {
            const f32x4 gq0 = *(const LAS f32x4*)(gainT + 8 * g), gq1 = *(const LAS f32x4*)(gainT + 8 * g + 4), gq2 = *(const LAS f32x4*)(gainT + 32 + 8 * g), gq3 = *(const LAS f32x4*)(gainT + 32 + 8 * g + 4);
            float x[16] = {bflo(r0.x), bfhi(r0.x), bflo(r0.y), bfhi(r0.y), bflo(r0.z), bfhi(r0.z), bflo(r0.w), bfhi(r0.w),
                           bflo(r1.x), bfhi(r1.x), bflo(r1.y), bfhi(r1.y), bflo(r1.z), bfhi(r1.z), bflo(r1.w), bfhi(r1.w)};
            float s = 0.f;
#pragma unroll
            for (int e = 0; e < 16; ++e) s += x[e] * x[e];
            s = xl::add32(xl::add16(s));
            const float rs = QS / sqrtf(s * (1.0f / 64.0f) + EPS);
            v4u a, c;
            a.x = cvtpk(x[0] * rs * gq0[0], x[1] * rs * gq0[1]); a.y = cvtpk(x[2] * rs * gq0[2], x[3] * rs * gq0[3]); a.z = cvtpk(x[4] * rs * gq1[0], x[5] * rs * gq1[1]); a.w = cvtpk(x[6] * rs * gq1[2], x[7] * rs * gq1[3]);
            c.x = cvtpk(x[8] * rs * gq2[0], x[9] * rs * gq2[1]); c.y = cvtpk(x[10] * rs * gq2[2], x[11] * rs * gq2[3]); c.z = cvtpk(x[12] * rs * gq3[0], x[13] * rs * gq3[1]); c.w = cvtpk(x[14] * rs * gq3[2], x[15] * rs * gq3[3]);
            qf0 = __builtin_bit_cast(bf16x8, a); qf1 = __builtin_bit_cast(bf16x8, c);
        }
        f32x4 o[4]; float lsum = 0.f;
#pragma unroll
        for (int nd = 0; nd < 4; ++nd) o[nd] = (f32x4){0.f, 0.f, 0.f, 0.f};
#pragma unroll
        for (int c = 0; c < 8; ++c) {
            if (c == 4) { A3_BUILD(mw_n, seln, nkeys_n); LDS_WAIT(); asm volatile("" ::: "memory"); }
            if (c == 6) A3_REQQ(qn);
            if (c < 5) A3_LOADKV(sel, Kb, Vb, c + 3, (c + 3) & 3);
            else A3_LOADKV(seln, Kbn, Vbn, c - 5, (c + 3) & 3);
#pragma unroll
            for (int m = 0; m < 4; ++m) { *(LAS v4u*)(Kl + (8 * m + (lane >> 3)) * A3_VS + 16 * (lane & 7)) = kb[c & 3][m]; *(LAS v4u*)(Vl + (8 * m + (lane >> 3)) * A3_VS + 16 * (lane & 7)) = vb[c & 3][m]; }
            LDS_WAIT(); asm volatile("" ::: "memory");
            f32x4 pr[2];
#pragma unroll
            for (int tt = 0; tt < 2; ++tt) {
                const bf16x8 kf0 = *(const LAS bf16x8*)(Kl + (16 * tt + j) * A3_VS + 16 * g), kf1 = *(const LAS bf16x8*)(Kl + (16 * tt + j) * A3_VS + 64 + 16 * g);
                f32x4 s = __builtin_amdgcn_mfma_f32_16x16x32_bf16(kf0, qf0, (f32x4){0.f, 0.f, 0.f, 0.f}, 0, 0, 0);
                s = __builtin_amdgcn_mfma_f32_16x16x32_bf16(kf1, qf1, s, 0, 0, 0);
                const int kbase = 32 * c + 16 * tt + 4 * g;
                const u32x2 iw = *(const LAS u32x2*)(sel + kbase);
                const int i0 = iw.x & 0xffff, i1 = iw.x >> 16, i2 = iw.y & 0xffff, i3 = iw.y >> 16;
                float p0 = __builtin_amdgcn_exp2f(s[0] + biasT[min(t - i0, 128) * 16 + j]);
                float p1 = __builtin_amdgcn_exp2f(s[1] + biasT[min(t - i1, 128) * 16 + j]);
                float p2 = __builtin_amdgcn_exp2f(s[2] + biasT[min(t - i2, 128) * 16 + j]);
                float p3 = __builtin_amdgcn_exp2f(s[3] + biasT[min(t - i3, 128) * 16 + j]);
                if (kbase + 0 >= nkeys) p0 = 0.f; if (kbase + 1 >= nkeys) p1 = 0.f; if (kbase + 2 >= nkeys) p2 = 0.f; if (kbase + 3 >= nkeys) p3 = 0.f;
                lsum += (p0 + p1) + (p2 + p3);
                pr[tt] = (f32x4){p0, p1, p2, p3};
            }
            {
                v4u pw; pw.x = cvtpk(pr[0][0], pr[0][1]); pw.y = cvtpk(pr[0][2], pr[0][3]); pw.z = cvtpk(pr[1][0], pr[1][1]); pw.w = cvtpk(pr[1][2], pr[1][3]);
                const bf16x8 pfrag = __builtin_bit_cast(bf16x8, pw);
#pragma unroll
                for (int nd = 0; nd < 4; ++nd) {
                    const ldsp a0 = Vl + (4 * g + (j >> 2)) * A3_VS + (16 * nd + 4 * (j & 3)) * 2;
                    const bf16x8 vf = cat8(lds_tr(a0), lds_tr(a0 + 16 * A3_VS));
                    o[nd] = __builtin_amdgcn_mfma_f32_16x16x32_bf16(vf, pfrag, o[nd], 0, 0, 0);
                }
            }
            LDS_WAIT(); asm volatile("" ::: "memory");
        }
        lsum = xl::add32(xl::add16(lsum));
        const float il = 1.0f / lsum;
        char* op = (char*)(O + (size_t)qi * DM); unsigned ooff = (unsigned)(64 * j + 4 * g) * 2u; asm volatile("" : "+v"(ooff));
#pragma unroll
        for (int nd = 0; nd < 4; ++nd) { u32x2 wv; wv.x = cvtpk(o[nd][0] * il, o[nd][1] * il); wv.y = cvtpk(o[nd][2] * il, o[nd][3] * il); *(u32x2*)(op + ooff + 32 * nd) = wv; }
        par ^= 1;
    }
#undef A3_LOADKV
#undef A3_BUILD
#undef A3_REQM
#undef A3_REQQ
    __syncthreads();
}

constexpr int B2_BIAS = 0, B2_K = 8192, B2_V = 8192 + 36864, B2_KS = 144, B2_GAIN = 8192 + 2 * 36864;
__device__ __forceinline__ void phase_b2(ldsp lds, const bf16* PB, bf16* O, const float* qgain, const float* kgain, const float* sinks, const float* rel_bias, int vcu, int G, int wave) {
    const int tid = phase_tid(wave);
    const int lane = tid & 63, w = wave, r32 = lane & 31, hh = lane >> 5, g16 = (lane >> 4) & 1, i16 = lane & 15;
    LAS float* biasT = (LAS float*)(lds + B2_BIAS);
    for (int e = tid; e < 128 * 16; e += NTHR) { const int n = e & 127, h = e >> 7; biasT[e] = rel_bias[t5_bucket(n) * 16 + h] * LOG2E; }
    LAS float* gT = (LAS float*)(lds + B2_GAIN);
    if (tid < 64) { gT[tid] = qgain[tid]; gT[64 + tid] = kgain[tid]; } if (tid < 16) gT[128 + tid] = sinks[tid];
    const ldsp Kl = lds + B2_K, Vl = lds + B2_V;
    const float QS = 0.125f * LOG2E;
    v4u kreg[4], vreg[4];
#define B2_LOADKV(uu) do { const int nb_ = (uu) & 31, kvh_ = ((uu) >> 5) & 3, b_ = (uu) >> 7; \
        _Pragma("unroll") for (int m = 0; m < 4; ++m) { const int kj = 64 * m + (tid >> 3), pc = tid & 7; const int tok = 128 * (nb_ - 1) + kj; \
              \
            const bf16* rp = PB + ((size_t)b_ * SEQ + (tok < 0 ? tok + 128 : tok)) * B_N; kreg[m] = *(const v4u*)(rp + 1024 + 64 * kvh_ + 8 * pc); vreg[m] = *(const v4u*)(rp + 1280 + 64 * kvh_ + 8 * pc); } } while (0)
    if (vcu < 2048) B2_LOADKV(vcu);
    v4u rq[4] = {(v4u){0u, 0u, 0u, 0u}, (v4u){0u, 0u, 0u, 0u}, (v4u){0u, 0u, 0u, 0u}, (v4u){0u, 0u, 0u, 0u}};
#define B2_LOADQ(uu, qb_) do { const int nb_ = (uu) & 31, kvh_ = ((uu) >> 5) & 3, b_ = (uu) >> 7; \
        const bf16* qp_ = PB + ((size_t)b_ * SEQ + 128 * nb_ + 64 * (w & 1) + 32 * (qb_) + r32) * B_N + 64 * (4 * kvh_ + (w >> 1)) + 8 * hh; \
        _Pragma("unroll") for (int ks = 0; ks < 4; ++ks) rq[ks] = *(const v4u*)(qp_ + 16 * ks); } while (0)
    if (vcu < 2048) B2_LOADQ(vcu, 0);
    for (int u = vcu; u < 2048; u += G) {
        const int nb = u & 31, kvh = (u >> 5) & 3, b = u >> 7;
        const size_t rowbase = (size_t)b * SEQ;
        __syncthreads();
        {
            const f32x4 gk0 = *(const LAS f32x4*)(gT + 64 + 8 * (tid & 7)), gk1 = *(const LAS f32x4*)(gT + 64 + 8 * (tid & 7) + 4);
#pragma unroll
            for (int m = 0; m < 4; ++m) {
                const int kj = 64 * m + (tid >> 3), pc = tid & 7;
                const v4u kk = kreg[m], vv = vreg[m];
                float x[8] = {bflo(kk.x), bfhi(kk.x), bflo(kk.y), bfhi(kk.y), bflo(kk.z), bfhi(kk.z), bflo(kk.w), bfhi(kk.w)};
                float s = 0.f;
#pragma unroll
                for (int e = 0; e < 8; ++e) s += x[e] * x[e];
                s = xl::add4(xl::add2(xl::add1(s)));
                const float rs = 1.0f / sqrtf(s * (1.0f / 64.0f) + EPS);
                v4u ko; ko.x = cvtpk(x[0] * rs * gk0[0], x[1] * rs * gk0[1]); ko.y = cvtpk(x[2] * rs * gk0[2], x[3] * rs * gk0[3]); ko.z = cvtpk(x[4] * rs * gk1[0], x[5] * rs * gk1[1]); ko.w = cvtpk(x[6] * rs * gk1[2], x[7] * rs * gk1[3]);
                *(LAS v4u*)(Kl + kj * B2_KS + 16 * pc) = ko; *(LAS v4u*)(Vl + kj * B2_KS + 16 * pc) = vv;
            }
        }
        const int un = (u + G < 2048) ? u + G : u;
        B2_LOADKV(un);
        __syncthreads();
        const int hq = 4 * kvh + (w >> 1);
        const float sinkp = __builtin_amdgcn_exp2f(gT[128 + hq] * LOG2E);
#pragma unroll 1
        for (int qblk = 0; qblk < 2; ++qblk) {
            const int qs = 64 * (w & 1) + 32 * qblk;
            const int ql = qs + r32;
            bf16x8 qf[4];
            {
                float s = 0.f;
#pragma unroll
                for (int ks = 0; ks < 4; ++ks) {
                    const float a0 = bflo(rq[ks].x), a1 = bfhi(rq[ks].x), a2 = bflo(rq[ks].y), a3 = bfhi(rq[ks].y), a4 = bflo(rq[ks].z), a5 = bfhi(rq[ks].z), a6 = bflo(rq[ks].w), a7 = bfhi(rq[ks].w);
                    s += (a0 * a0 + a1 * a1) + (a2 * a2 + a3 * a3) + (a4 * a4 + a5 * a5) + (a6 * a6 + a7 * a7); }
                s = xl::add32(s);
                const float rs = QS / sqrtf(s * (1.0f / 64.0f) + EPS);
#pragma unroll
                for (int ks = 0; ks < 4; ++ks) {
                    const f32x4 g0 = *(const LAS f32x4*)(gT + 16 * ks + 8 * hh), g1 = *(const LAS f32x4*)(gT + 16 * ks + 8 * hh + 4);
                    v4u o; o.x = cvtpk(bflo(rq[ks].x) * rs * g0[0], bfhi(rq[ks].x) * rs * g0[1]); o.y = cvtpk(bflo(rq[ks].y) * rs * g0[2], bfhi(rq[ks].y) * rs * g0[3]);
                    o.z = cvtpk(bflo(rq[ks].z) * rs * g1[0], bfhi(rq[ks].z) * rs * g1[1]); o.w = cvtpk(bflo(rq[ks].w) * rs * g1[2], bfhi(rq[ks].w) * rs * g1[3]);
                    qf[ks] = __builtin_bit_cast(bf16x8, o);
                }
                asm volatile("" ::: "memory");
                if (qblk == 0) B2_LOADQ(u, 1); else B2_LOADQ(un, 0);
            }
            f32x16 o0 = {}, o1 = {}; float lsum = 0.f;
#pragma unroll 1
            for (int kt5 = 0; kt5 < 5; ++kt5) {
                const int kt = (qs >> 5) + kt5;
                if (nb == 0 && kt < 4) continue;
                f32x16 p = {};
#pragma unroll
                for (int ks = 0; ks < 4; ++ks) {
                    const bf16x8 ka = *(const LAS bf16x8*)(Kl + (32 * kt + r32) * B2_KS + (16 * ks + 8 * hh) * 2);
                    p = __builtin_amdgcn_mfma_f32_32x32x16_bf16(ka, qf[ks], p, 0, 0, 0);
                }
#pragma unroll
                for (int r = 0; r < 16; ++r) {
                    const int kj = 32 * kt + (r & 3) + 8 * (r >> 2) + 4 * hh; const int rel = ql + 128 - kj;
                    const float bv = biasT[hq * 128 + (rel & 127)];
                    p[r] = __builtin_amdgcn_exp2f(p[r] + bv);
                }
                if (kt5 == 0 || kt5 == 4) {
                    asm volatile("" ::: "memory");
#pragma unroll
                    for (int r = 0; r < 16; ++r) {
                        const int kj = 32 * kt + (r & 3) + 8 * (r >> 2) + 4 * hh; const int rel = ql + 128 - kj;
                        p[r] = ((rel >= 0) && (rel < 128)) ? p[r] : 0.f;
                    }
                }
#pragma unroll
                for (int r = 0; r < 16; ++r) lsum += p[r];
                v4u pw0, pw1;
                pw0.x = cvtpk(p[0], p[1]); pw0.y = cvtpk(p[2], p[3]); pw0.z = cvtpk(p[4], p[5]); pw0.w = cvtpk(p[6], p[7]);
                pw1.x = cvtpk(p[8], p[9]); pw1.y = cvtpk(p[10], p[11]); pw1.z = cvtpk(p[12], p[13]); pw1.w = cvtpk(p[14], p[15]);
                const bf16x8 pf0 = __builtin_bit_cast(bf16x8, pw0), pf1 = __builtin_bit_cast(bf16x8, pw1);
#pragma unroll
                for (int s = 0; s < 2; ++s) {
                    const ldsp va = Vl + (32 * kt + 16 * s + 4 * hh + (i16 >> 2)) * B2_KS + (16 * g16 + 4 * (i16 & 3)) * 2;
                    const bf16x8 v0 = cat8(lds_tr(va), lds_tr(va + 8 * B2_KS));
                    const bf16x8 v1 = cat8(lds_tr(va + 64), lds_tr(va + 8 * B2_KS + 64));
                    o0 = __builtin_amdgcn_mfma_f32_32x32x16_bf16(v0, s == 0 ? pf0 : pf1, o0, 0, 0, 0);
                    o1 = __builtin_amdgcn_mfma_f32_32x32x16_bf16(v1, s == 0 ? pf0 : pf1, o1, 0, 0, 0);
                }
            }
            lsum = xl::add32(lsum);
            const float il = 1.0f / (lsum + sinkp);
            bf16* op = O + (rowbase + 128 * nb + ql) * DM + 64 * hq + 8 * hh;
#define OUT16(acc, p_, il_, dst_) do { v4u w_; { const unsigned e0_ = cvtpk(acc[8 * (p_)] * il_, acc[8 * (p_) + 1] * il_), e1_ = cvtpk(acc[8 * (p_) + 2] * il_, acc[8 * (p_) + 3] * il_); \
            const unsigned d0_ = cvtpk(acc[8 * (p_) + 4] * il_, acc[8 * (p_) + 5] * il_), d1_ = cvtpk(acc[8 * (p_) + 6] * il_, acc[8 * (p_) + 7] * il_); \
              \
            const auto s0_ = __builtin_amdgcn_permlane32_swap(e0_, d0_, false, false); const auto s1_ = __builtin_amdgcn_permlane32_swap(e1_, d1_, false, false); \
            w_.x = s0_[0]; w_.y = s1_[0]; w_.z = s0_[1]; w_.w = s1_[1]; } *(v4u*)(dst_) = w_; } while (0)
#pragma unroll
            for (int p2 = 0; p2 < 2; ++p2) { OUT16(o0, p2, il, op + 16 * p2); OUT16(o1, p2, il, op + 32 + 16 * p2); }
#undef OUT16
        }
    }
    __syncthreads();
}
#undef B2_LOADKV
#undef B2_LOADQ

__device__ __forceinline__ void phase_cfin(bf16* Q, bf16* KV, const bf16* LAT, bf16* KR, const float* cs, const float* qgain, const float* kgain, int gw, int NGW, int wave) {
    const int lane = phase_tid(wave) & 63;
    const int hd = lane >> 2, sub = lane & 3;
    const float QS = 0.10206207261596575f * LOG2E;
    f32x4 gqn[4], gkn[4]; f32x4 gq1, gq2, gk1, gk2;
#pragma unroll
    for (int e = 0; e < 4; ++e) { gqn[e] = *(const f32x4*)(qgain + 16 * sub + 4 * e); gkn[e] = *(const f32x4*)(kgain + 16 * sub + 4 * e); }
    gq1 = *(const f32x4*)(qgain + 64 + 4 * sub); gq2 = *(const f32x4*)(qgain + 80 + 4 * sub); gk1 = *(const f32x4*)(kgain + 64 + 4 * sub); gk2 = *(const f32x4*)(kgain + 80 + 4 * sub);
    f32x4 csa_n = {}, csb_n = {}; v4u n0_n = (v4u){0u, 0u, 0u, 0u}, n1_n = (v4u){0u, 0u, 0u, 0u}; u32x2 t1_n = {0u, 0u}, t2_n = {0u, 0u};
#define CF_LOAD(tk) do { csa_n = *(const f32x4*)(cs + (size_t)(tk) * 32 + 8 * sub); csb_n = *(const f32x4*)(cs + (size_t)(tk) * 32 + 8 * sub + 4); \
        const bf16* np_ = KV + (size_t)(tk) * C_NKV + 128 * hd + 16 * sub; const bf16* r1p_ = LAT + (size_t)(tk) * C_N1 + 384 + 4 * sub; \
        n0_n = *(const v4u*)np_; n1_n = *(const v4u*)(np_ + 8); t1_n = *(const u32x2*)r1p_; t2_n = *(const u32x2*)(r1p_ + 16); } while (0)
    if (gw < NTOK) CF_LOAD(gw);
    for (int tok = gw; tok < NTOK; tok += NGW) {
        const f32x4 csa = csa_n, csb = csb_n;
        const float cv[4] = {csa[0], csa[2], csb[0], csb[2]}, sv[4] = {csa[1], csa[3], csb[1], csb[3]};
        v4u n0s[2], n1s[2]; u32x2 t1s[2], t2s[2];
        n0s[1] = n0_n; n1s[1] = n1_n; t1s[1] = t1_n; t2s[1] = t2_n;
        if (tok + NGW < NTOK) CF_LOAD(tok + NGW);
#pragma unroll
        for (int isk = 1; isk < 2; ++isk) {
            bf16* np = isk ? (KV + (size_t)tok * C_NKV + 128 * hd + 16 * sub) : (Q + (size_t)tok * C_NQ + 96 * hd + 16 * sub);
            const v4u n0 = n0s[isk], n1 = n1s[isk]; const u32x2 t1 = t1s[isk], t2 = t2s[isk];
            float x[16] = {bflo(n0.x), bfhi(n0.x), bflo(n0.y), bfhi(n0.y), bflo(n0.z), bfhi(n0.z), bflo(n0.w), bfhi(n0.w), bflo(n1.x), bfhi(n1.x), bflo(n1.y), bfhi(n1.y), bflo(n1.z), bfhi(n1.z), bflo(n1.w), bfhi(n1.w)};
            float a[4] = {bflo(t1.x), bfhi(t1.x), bflo(t1.y), bfhi(t1.y)}, c[4] = {bflo(t2.x), bfhi(t2.x), bflo(t2.y), bfhi(t2.y)};
            float s = 0.f;
#pragma unroll
            for (int e = 0; e < 16; ++e) s += x[e] * x[e];
#pragma unroll
            for (int e = 0; e < 4; ++e) s += a[e] * a[e] + c[e] * c[e];
            s = xl::add2(xl::add1(s));
            const float rs = (isk ? 1.0f : QS) / sqrtf(s * (1.0f / 96.0f) + EPS);
            v4u o0, o1;
            const f32x4* gn = isk ? gkn : gqn;
            o0.x = cvtpk(x[0] * rs * gn[0][0], x[1] * rs * gn[0][1]); o0.y = cvtpk(x[2] * rs * gn[0][2], x[3] * rs * gn[0][3]); o0.z = cvtpk(x[4] * rs * gn[1][0], x[5] * rs * gn[1][1]); o0.w = cvtpk(x[6] * rs * gn[1][2], x[7] * rs * gn[1][3]);
            o1.x = cvtpk(x[8] * rs * gn[2][0], x[9] * rs * gn[2][1]); o1.y = cvtpk(x[10] * rs * gn[2][2], x[11] * rs * gn[2][3]); o1.z = cvtpk(x[12] * rs * gn[3][0], x[13] * rs * gn[3][1]); o1.w = cvtpk(x[14] * rs * gn[3][2], x[15] * rs * gn[3][3]);
            const f32x4 g1 = isk ? gk1 : gq1, g2 = isk ? gk2 : gq2;
            float r1[4], r2[4];
#pragma unroll
            for (int e = 0; e < 4; ++e) { const float u1 = a[e] * rs * g1[e], u2 = c[e] * rs * g2[e]; r1[e] = u1 * cv[e] - u2 * sv[e]; r2[e] = u2 * cv[e] + u1 * sv[e]; }
            u32x2 w1, w2; w1.x = cvtpk(r1[0], r1[1]); w1.y = cvtpk(r1[2], r1[3]); w2.x = cvtpk(r2[0], r2[1]); w2.y = cvtpk(r2[2], r2[3]);
            *(v4u*)np = o0; *(v4u*)(np + 8) = o1;
            bf16* rop = isk ? (KR + (size_t)tok * 512 + 32 * hd + 4 * sub) : (Q + (size_t)tok * C_NQ + 96 * hd + 64 + 4 * sub);
            *(u32x2*)rop = w1; *(u32x2*)(rop + 16) = w2;
        }
    }
}

#undef CF_LOAD
constexpr int C3_KS = 208, C3_VS = 64, C3_VH = 4096 + 64, C3_KB = 64 * C3_KS, C3_VB = 2 * 4096 + 128, C3_K = 0, C3_V = 3 * C3_KB;
__device__ __forceinline__ void phase_c3(ldsp lds, const bf16* Q, const bf16* KV, const bf16* KR, bf16* O, const float* cs, const float* qgain, int vcu, int G, int wave) {
    const int tid = phase_tid(wave);
    const int lane = tid & 63, w = wave, r32 = lane & 31, hh = lane >> 5, g16 = (lane >> 4) & 1, i16 = lane & 15;
    const int srow = tid >> 3, spc = tid & 7, rrow = (tid >> 2) & 63, rpc = tid & 3;
    v4u po0 = (v4u){0u, 0u, 0u, 0u}, po1 = po0, po2 = po0, po3 = po0; char* pop = nullptr; unsigned poo = 0u;
#define C3_FLUSH() do { if (pop) { *(v4u*)(pop + poo) = po0; *(v4u*)(pop + poo + 64) = po1; *(v4u*)(pop + poo + 32) = po2; *(v4u*)(pop + poo + 96) = po3; pop = nullptr; } } while (0)
    for (int p = vcu; p < 2048; p += G) {
#pragma unroll 1
      for (int half = 0; half < 2; ++half) {
        const int bh = p >> 3, b = bh >> 4, h = bh & 15, qb = half ? 15 - (p & 7) : (p & 7);
        const size_t rowbase = (size_t)b * SEQ;
        const int NT = 4 * (qb + 1), tw = 4 * qb + (w >> 1);
        const bf16* kvb = KV + rowbase * C_NKV + 128 * h; const bf16* krb = KR + rowbase * 512 + 32 * h;
        v4u skA, svA, srA = (v4u){0u, 0u, 0u, 0u};
        const unsigned kvo = (unsigned)(srow * C_NKV + 8 * spc) * 2u, kro = (unsigned)(rrow * 512 + 8 * rpc) * 2u;
#define C3_LOAD(T, sk_, sv_, sr_) do { const char* kb_ = (const char*)(kvb + (size_t)(64 * (T)) * C_NKV); sk_ = *(const v4u*)(kb_ + kvo); sv_ = *(const v4u*)(kb_ + kvo + 128); \
            if (tid < 256) sr_ = *(const v4u*)((const char*)(krb + (size_t)(64 * (T)) * 512) + kro); } while (0)
#define C3_STORE(SLOT, sk_, sv_, sr_) do { *(LAS v4u*)(lds + C3_K + (SLOT) * C3_KB + srow * C3_KS + 16 * spc) = sk_; *(LAS v4u*)(lds + C3_V + (SLOT) * C3_VB + (spc >> 2) * C3_VH + srow * C3_VS + 16 * (spc & 3)) = sv_; \
            if (tid < 256) *(LAS v4u*)(lds + C3_K + (SLOT) * C3_KB + rrow * C3_KS + 128 + 16 * rpc) = sr_; } while (0)
        C3_LOAD(0, skA, svA, srA);
        bf16x8 qf[6];
        {
            const char* qp = (const char*)(Q + (rowbase + 256 * qb + 32 * w) * C_NQ + 96 * h); const unsigned qo = (unsigned)(r32 * C_NQ + 8 * hh) * 2u;
            v4u qr[6];
#pragma unroll
            for (int ks = 0; ks < 6; ++ks) qr[ks] = *(const v4u*)(qp + qo + 32 * ks);
            const float* csp = cs + (rowbase + 256 * qb + 32 * w + r32) * 32 + 16 * hh;
            f32x4 csv[4];
#pragma unroll
            for (int e = 0; e < 4; ++e) csv[e] = *(const f32x4*)(csp + 4 * e);
            C3_FLUSH();
            float x[6][8]; float ss = 0.f;
#pragma unroll
            for (int ks = 0; ks < 6; ++ks) {
                x[ks][0] = bflo(qr[ks].x); x[ks][1] = bfhi(qr[ks].x); x[ks][2] = bflo(qr[ks].y); x[ks][3] = bfhi(qr[ks].y);
                x[ks][4] = bflo(qr[ks].z); x[ks][5] = bfhi(qr[ks].z); x[ks][6] = bflo(qr[ks].w); x[ks][7] = bfhi(qr[ks].w);
#pragma unroll
                for (int e = 0; e < 8; ++e) ss += x[ks][e] * x[ks][e];
            }
            ss = xl::add32(ss);
            const float rs = (0.10206207261596575f * LOG2E) / sqrtf(ss * (1.0f / 96.0f) + EPS);
#pragma unroll
            for (int ks = 0; ks < 6; ++ks) {
                const f32x4 g0 = *(const f32x4*)(qgain + 16 * ks + 8 * hh), g1 = *(const f32x4*)(qgain + 16 * ks + 8 * hh + 4);
#pragma unroll
                for (int e = 0; e < 4; ++e) { x[ks][e] *= rs * g0[e]; x[ks][4 + e] *= rs * g1[e]; }
            }
#pragma unroll
            for (int e = 0; e < 8; ++e) { const float cc = csv[e >> 1][2 * (e & 1)], sn = csv[e >> 1][2 * (e & 1) + 1]; const float a = x[4][e], b2 = x[5][e]; x[4][e] = a * cc - b2 * sn; x[5][e] = b2 * cc + a * sn; }
#pragma unroll
            for (int ks = 0; ks < 6; ++ks) { v4u o; o.x = cvtpk(x[ks][0], x[ks][1]); o.y = cvtpk(x[ks][2], x[ks][3]); o.z = cvtpk(x[ks][4], x[ks][5]); o.w = cvtpk(x[ks][6], x[ks][7]); qf[ks] = __builtin_bit_cast(bf16x8, o); }
        }
        C3_STORE(0, skA, svA, srA);
        f32x16 o0 = {}, o1 = {}; float lsum = 0.f;
        const int qloc = 32 * w + r32;
        f32x16 s0 = {}, s1 = {};
#define C3_KF(ks_) *(const LAS bf16x8*)(Kb_ + r32 * C3_KS + (16 * (ks_) + 8 * hh) * 2)
#define C3_KG(ks_) *(const LAS bf16x8*)(Kb_ + (32 + r32) * C3_KS + (16 * (ks_) + 8 * hh) * 2)
#define C3_QK(SLOT, n0_, n1_) do { const ldsp Kb_ = lds + C3_K + (SLOT) * C3_KB; \
              \
            bf16x8 fa0_ = C3_KF(0), fa1_ = C3_KG(0), fa2_ = C3_KF(1), fa3_ = C3_KG(1); \
            bf16x8 fb0_ = C3_KF(2), fb1_ = C3_KG(2), fb2_ = C3_KF(3), fb3_ = C3_KG(3); \
            __builtin_amdgcn_sched_barrier(0); \
            n0_ = __builtin_amdgcn_mfma_f32_32x32x16_bf16(fa0_, qf[0], n0_, 0, 0, 0); n1_ = __builtin_amdgcn_mfma_f32_32x32x16_bf16(fa1_, qf[0], n1_, 0, 0, 0); \
            n0_ = __builtin_amdgcn_mfma_f32_32x32x16_bf16(fa2_, qf[1], n0_, 0, 0, 0); n1_ = __builtin_amdgcn_mfma_f32_32x32x16_bf16(fa3_, qf[1], n1_, 0, 0, 0); \
            __builtin_amdgcn_sched_barrier(0); \
            fa0_ = C3_KF(4); fa1_ = C3_KG(4); fa2_ = C3_KF(5); fa3_ = C3_KG(5); \
            __builtin_amdgcn_sched_barrier(0); \
            n0_ = __builtin_amdgcn_mfma_f32_32x32x16_bf16(fb0_, qf[2], n0_, 0, 0, 0); n1_ = __builtin_amdgcn_mfma_f32_32x32x16_bf16(fb1_, qf[2], n1_, 0, 0, 0); \
            n0_ = __builtin_amdgcn_mfma_f32_32x32x16_bf16(fb2_, qf[3], n0_, 0, 0, 0); n1_ = __builtin_amdgcn_mfma_f32_32x32x16_bf16(fb3_, qf[3], n1_, 0, 0, 0); \
            n0_ = __builtin_amdgcn_mfma_f32_32x32x16_bf16(fa0_, qf[4], n0_, 0, 0, 0); n1_ = __builtin_amdgcn_mfma_f32_32x32x16_bf16(fa1_, qf[4], n1_, 0, 0, 0); \
            n0_ = __builtin_amdgcn_mfma_f32_32x32x16_bf16(fa2_, qf[5], n0_, 0, 0, 0); n1_ = __builtin_amdgcn_mfma_f32_32x32x16_bf16(fa3_, qf[5], n1_, 0, 0, 0); } while (0)
#define C3_VA(ks_) (Vb_ + (16 * (ks_) + 4 * hh + (i16 >> 2)) * C3_VS + (16 * g16 + 4 * (i16 & 3)) * 2)
#define C3_V0(ks_) cat8(lds_tr(C3_VA(ks_)), lds_tr(C3_VA(ks_) + 8 * C3_VS))
#define C3_V1(ks_) cat8(lds_tr(C3_VA(ks_) + C3_VH), lds_tr(C3_VA(ks_) + 8 * C3_VS + C3_VH))
#define C3_SMPV(TT, SLOT) do { const ldsp Vb_ = lds + C3_V + (SLOT) * C3_VB; \
              \
            bf16x8 va0_ = C3_V0(0), va1_ = C3_V1(0), vb0_ = C3_V0(1), vb1_ = C3_V1(1); \
            __builtin_amdgcn_sched_barrier(0); \
            _Pragma("unroll") for (int r = 0; r < 16; ++r) { \
                const float e0_ = __builtin_amdgcn_exp2f(s0[r]), e1_ = __builtin_amdgcn_exp2f(s1[r]);        \
                s0[r] = e0_; s1[r] = e1_; { float t_ = e0_ + e1_; asm volatile("" : "+v"(t_)); lsum += t_; asm volatile("" : "+v"(lsum)); } }     \
            v4u pw_[4]; \
            pw_[0].x = cvtpk(s0[0], s0[1]); pw_[0].y = cvtpk(s0[2], s0[3]); pw_[0].z = cvtpk(s0[4], s0[5]); pw_[0].w = cvtpk(s0[6], s0[7]); \
            pw_[1].x = cvtpk(s0[8], s0[9]); pw_[1].y = cvtpk(s0[10], s0[11]); pw_[1].z = cvtpk(s0[12], s0[13]); pw_[1].w = cvtpk(s0[14], s0[15]); \
            pw_[2].x = cvtpk(s1[0], s1[1]); pw_[2].y = cvtpk(s1[2], s1[3]); pw_[2].z = cvtpk(s1[4], s1[5]); pw_[2].w = cvtpk(s1[6], s1[7]); \
            pw_[3].x = cvtpk(s1[8], s1[9]); pw_[3].y = cvtpk(s1[10], s1[11]); pw_[3].z = cvtpk(s1[12], s1[13]); pw_[3].w = cvtpk(s1[14], s1[15]); \
            __builtin_amdgcn_sched_barrier(0); \
            o0 = __builtin_amdgcn_mfma_f32_32x32x16_bf16(va0_, __builtin_bit_cast(bf16x8, pw_[0]), o0, 0, 0, 0); o1 = __builtin_amdgcn_mfma_f32_32x32x16_bf16(va1_, __builtin_bit_cast(bf16x8, pw_[0]), o1, 0, 0, 0); \
            __builtin_amdgcn_sched_barrier(0); \
            va0_ = C3_V0(2); va1_ = C3_V1(2); \
            __builtin_amdgcn_sched_barrier(0); \
            o0 = __builtin_amdgcn_mfma_f32_32x32x16_bf16(vb0_, __builtin_bit_cast(bf16x8, pw_[1]), o0, 0, 0, 0); o1 = __builtin_amdgcn_mfma_f32_32x32x16_bf16(vb1_, __builtin_bit_cast(bf16x8, pw_[1]), o1, 0, 0, 0); \
            __builtin_amdgcn_sched_barrier(0); \
            vb0_ = C3_V0(3); vb1_ = C3_V1(3); \
            __builtin_amdgcn_sched_barrier(0); \
            o0 = __builtin_amdgcn_mfma_f32_32x32x16_bf16(va0_, __builtin_bit_cast(bf16x8, pw_[2]), o0, 0, 0, 0); o1 = __builtin_amdgcn_mfma_f32_32x32x16_bf16(va1_, __builtin_bit_cast(bf16x8, pw_[2]), o1, 0, 0, 0); \
            o0 = __builtin_amdgcn_mfma_f32_32x32x16_bf16(vb0_, __builtin_bit_cast(bf16x8, pw_[3]), o0, 0, 0, 0); o1 = __builtin_amdgcn_mfma_f32_32x32x16_bf16(vb1_, __builtin_bit_cast(bf16x8, pw_[3]), o1, 0, 0, 0); } while (0)
        int slot = 0, pslot = 2;
#pragma unroll 1
        for (int t2 = 0; t2 < NT; t2 += 2) {
#pragma unroll
          for (int par = 0; par < 2; ++par) {
            const int t = t2 + par;
            __syncthreads();
            if (t + 1 < NT) C3_LOAD(t + 1, skA, svA, srA);
            f32x16 n0 = {}, n1 = {};
            const bool doqk = (t <= tw), dopv = (t >= 1) && (t - 1 <= tw);
            if (t == tw) {
                asm volatile("" ::: "memory");
                const int kq = qloc - 64 * (t - 4 * qb) - 4 * hh;
#pragma unroll
                for (int r = 0; r < 16; ++r) { const int kl = (r & 3) + 8 * (r >> 2); n0[r] = (kl > kq) ? -1e30f : 0.f; n1[r] = (kl + 32 > kq) ? -1e30f : 0.f; }
            }
            if (doqk) C3_QK(slot, n0, n1);
            if (dopv) C3_SMPV(t - 1, pslot);
            s0 = n0; s1 = n1;
            const int nslot = (slot == 2) ? 0 : slot + 1;
            if (t + 1 < NT) C3_STORE(nslot, skA, svA, srA);
            pslot = slot; slot = nslot;
          }
        }
        if (NT - 1 <= tw) C3_SMPV(NT - 1, pslot);
#undef C3_QK
#undef C3_KF
#undef C3_KG
#undef C3_SMPV
#undef C3_VA
#undef C3_V0
#undef C3_V1
#undef C3_LOAD
#undef C3_STORE
        lsum = xl::add32(lsum);
        const float il = 1.0f / lsum;
        char* op = (char*)(O + (rowbase + 256 * qb + 32 * w) * DM + 64 * h); const unsigned oo = (unsigned)(r32 * DM + 8 * hh) * 2u;
#define OUT16(acc, p_, il_, dst_) do { v4u w_; { const unsigned e0_ = cvtpk(acc[8 * (p_)] * il_, acc[8 * (p_) + 1] * il_), e1_ = cvtpk(acc[8 * (p_) + 2] * il_, acc[8 * (p_) + 3] * il_); \
            const unsigned d0_ = cvtpk(acc[8 * (p_) + 4] * il_, acc[8 * (p_) + 5] * il_), d1_ = cvtpk(acc[8 * (p_) + 6] * il_, acc[8 * (p_) + 7] * il_); \
              \
            const auto s0_ = __builtin_amdgcn_permlane32_swap(e0_, d0_, false, false); const auto s1_ = __builtin_amdgcn_permlane32_swap(e1_, d1_, false, false); \
            w_.x = s0_[0]; w_.y = s1_[0]; w_.z = s0_[1]; w_.w = s1_[1]; } dst_ = w_; } while (0)
        OUT16(o0, 0, il, po0); OUT16(o1, 0, il, po1); OUT16(o0, 1, il, po2); OUT16(o1, 1, il, po3);
        pop = op; poo = oo;
#undef OUT16
        __syncthreads();
      }
    }
    C3_FLUSH();
}
#undef C3_FLUSH

#ifndef MK_SINGLE
#define MK_SINGLE 1
#endif
#ifndef DUPMASK
#define DUPMASK 0
#endif
#define REP(bit) _Pragma("unroll 1") for (int rep_ = 0; rep_ < 1 + ((DUPMASK >> (bit)) & 1); ++rep_)
struct Args { const float* in[24]; float* out; unsigned char* ws; int ph_lo, ph_hi; };

typedef __attribute__((address_space(4))) const Args* karg_t;
#define PH_BEGIN karg_t A_ = ap; int bx = bx0, G = G0, vcu = vcu0, gw = gw0, NGW = NGW0, wave = wave0; asm volatile("" : "+s"(A_), "+s"(bx), "+s"(G), "+s"(vcu), "+s"(gw), "+s"(NGW), "+s"(wave)); (void)bx; (void)G; (void)vcu; (void)gw; (void)NGW; unsigned char* const ws = A_->ws; unsigned char* const R = ws + WS_R; (void)R; \
    bf16* const xb = (bf16*)(ws + WS_XB); float* const ssq = (float*)(ws + WS_SSQ); float* const ssq2 = (float*)(ws + WS_SSQ2); (void)xb; (void)ssq; (void)ssq2;
__global__ void __launch_bounds__(NTHR, 2) mk_fwd(Args args) {
    extern __shared__ __attribute__((aligned(16))) unsigned char lds_raw[];
    const ldsp lds = (ldsp)lds_raw;
    const int tid0 = threadIdx.x, wave0 = __builtin_amdgcn_readfirstlane(tid0 >> 6);
    const int G0 = gridDim.x, bx0 = blockIdx.x;
    const int vcu0 = (G0 % 8 == 0) ? (bx0 % 8) * (G0 / 8) + bx0 / 8 : bx0;
    const int gw0 = vcu0 * NWAVES + wave0, NGW0 = G0 * NWAVES;
    const karg_t ap = (karg_t)__builtin_amdgcn_kernarg_segment_ptr();
    for (int u = tid0; u < (LDS_BYTES - LDSCTL_OFF) / 4; u += NTHR) ((LAS unsigned*)(lds + LDSCTL_OFF))[u] = 0u;
    __syncthreads();
    XcdBarrier bar; bar.bar = (unsigned*)(args.ws + WS_CTL) + CW_BAR; bar.x = 0; bar.st = nullptr;
    if (MK_SINGLE) bar = xcd_barrier_post((unsigned*)(args.ws + WS_CTL) + CW_BAR, (volatile LAS unsigned*)(lds + MISC_OFF + 32));
    const int lo = args.ph_lo, hi = args.ph_hi; int ph = 0;
#define RUN (lo <= ph && ph < hi)
#define SEAM() do { if (MK_SINGLE && lo <= ph && ph + 1 < hi) xcd_barrier(bar); ++ph; } while (0)

    if (RUN) REP(9) { PH_BEGIN Ptrs P; for (int i = 0; i < 24; ++i) P.in[i] = A_->in[i]; P.out = A_->out; P.ws = ws; prologue(P, lds, gw, NGW, wave); }
    SEAM();

#pragma unroll
    for (int L = 0; L < 4; ++L) {
        const int kind = L % 3;
        if (kind == 0) {
            const int ia = (L == 0) ? 0 : 1;
            if (RUN) REP(1) {
                PH_BEGIN
                pg8::Gemm g{xb, (const bf16*)(ws + WS_WAIN + (size_t)ia * (A_N * DM * 2)), NTOK, A_N, DM, DM, DM}; pg8::StaticOrder S; S.init(NTOK, A_N, G, bx);
                pg8::EpiScale<0, false> E{(bf16*)(R + R_PA), A_N, ssq, 0, 16, 1.0f / 1024.0f, nullptr, 0};
                pg8::gemm_phase<pg8::EpiScale<0, false>, pg8::StaticOrder, true, true>(lds, g, S, E, wave);
            }
            SEAM();
            if (RUN) REP(2) { PH_BEGIN phase_a2(lds, (bf16*)(R + R_PA), (unsigned*)(R + R_MASK), (f32x4*)(R + R_O) + (size_t)bx * 32768, (bf16*)(R + R_KN), (bf16*)(R + R_VN), A_->in[9] + ia * 64, vcu, G, wave); }
            SEAM();
            if (RUN) REP(3) { PH_BEGIN phase_a3(lds, (const bf16*)(R + R_PA), (const bf16*)(R + R_KN), (const bf16*)(R + R_VN), (const unsigned*)(R + R_MASK), (bf16*)(R + R_O), A_->in[8] + ia * 64, A_->in[2], gw, NGW, wave); }
            SEAM();
            if (RUN) {
                PH_BEGIN
                pg8::Gemm g{(const bf16*)(R + R_O), (const bf16*)(ws + WS_WAOUT + (size_t)ia * 2 * MiB), NTOK, DM, DM, DM, DM}; pg8::StaticOrder S; S.init(NTOK, DM, G, bx);
                pg8::EpiRes E{xb, ssq2, nullptr, 0, nullptr};
                pg8::gemm_phase<pg8::EpiRes, pg8::StaticOrder, true, true>(lds, g, S, E, wave);
            }
            SEAM();
        } else if (kind == 1) {
            if (RUN) REP(4) {
                PH_BEGIN
                pg8::Gemm g{xb, (const bf16*)(ws + WS_WBIN), NTOK, B_N, DM, DM, DM}; pg8::StaticOrder S; S.init(NTOK, B_N, G, bx);
                pg8::EpiScale<0, false> E{(bf16*)(R + R_PB), B_N, ssq, 0, 16, 1.0f / 1024.0f, nullptr, 0};
                pg8::gemm_phase<pg8::EpiScale<0, false>, pg8::StaticOrder, true, true>(lds, g, S, E, wave);
            }
            SEAM();
            if (RUN) REP(5) { PH_BEGIN phase_b2(lds, (const bf16*)(R + R_PB), (bf16*)(R + R_O), A_->in[12], A_->in[13], A_->in[14], A_->in[2], vcu, G, wave); }
            SEAM();
            if (RUN) {
                PH_BEGIN
                pg8::Gemm g{(const bf16*)(R + R_O), (const bf16*)(ws + WS_WBOUT), NTOK, DM, DM, DM, DM}; pg8::StaticOrder S; S.init(NTOK, DM, G, bx);
                pg8::EpiRes E{xb, ssq2, nullptr, 0, nullptr};
                pg8::gemm_phase<pg8::EpiRes, pg8::StaticOrder, true, true>(lds, g, S, E, wave);
            }
            SEAM();
        } else {
            if (RUN) REP(6) {
                PH_BEGIN
                pg8::Gemm g{xb, (const bf16*)(ws + WS_WCIN), NTOK, C_N1, DM, DM, DM}; pg8::StaticOrder S; S.init(NTOK, C_N1, G, bx);
                pg8::EpiScale<0, true> E{(bf16*)(R + R_LAT), C_N1, ssq, 0, 16, 1.0f / 1024.0f, (float*)(ws + WS_CSTAT), 0};
                pg8::gemm_phase<pg8::EpiScale<0, true>, pg8::StaticOrder, true, true>(lds, g, S, E, wave);
            }
            SEAM();
            if (RUN) REP(7) {
                { PH_BEGIN
                  pg8::Gemm g{(const bf16*)(R + R_LAT), (const bf16*)(ws + WS_WQB), NTOK, C_NQ, 256, C_N1, 256}; pg8::StaticOrder S; S.init(NTOK, C_NQ, G, bx);
                  pg8::EpiScale<0, false> E{(bf16*)(R + R_Q), C_NQ, (const float*)(ws + WS_CSTAT), 0, 8, 1.0f / 256.0f, nullptr, 0};
                  pg8::gemm_phase<pg8::EpiScale<0, false>, pg8::StaticOrder, true, true>(lds, g, S, E, wave); }
                __syncthreads();
                { PH_BEGIN
                  pg8::Gemm g{(const bf16*)(R + R_LAT) + 256, (const bf16*)(ws + WS_WKVB), NTOK, C_NKV, 128, C_N1, 128}; pg8::StaticOrder S; S.init(NTOK, C_NKV, G, bx);
                  pg8::EpiScale<0, false> E{(bf16*)(R + R_KV), C_NKV, (const float*)(ws + WS_CSTAT), 8, 4, 1.0f / 128.0f, nullptr, 0};
                  pg8::gemm_phase<pg8::EpiScale<0, false>, pg8::StaticOrder, true, true>(lds, g, S, E, wave); }
            }
            SEAM();
            if (RUN) { PH_BEGIN phase_cfin((bf16*)(R + R_Q), (bf16*)(R + R_KV), (const bf16*)(R + R_LAT), (bf16*)(R + R_KR), (const float*)(ws + WS_CS), A_->in[21], A_->in[22], gw, NGW, wave); }
            SEAM();
            if (RUN) REP(8) { PH_BEGIN phase_c3(lds, (const bf16*)(R + R_Q), (const bf16*)(R + R_KV), (const bf16*)(R + R_KR), (bf16*)(R + R_OC), (const float*)(ws + WS_CS), A_->in[21], vcu, G, wave); }
            SEAM();
            if (RUN) {
                PH_BEGIN
                pg8::Gemm g{(const bf16*)(R + R_OC), (const bf16*)(ws + WS_WCOUT), NTOK, DM, DM, DM, DM}; pg8::StaticOrder S; S.init(NTOK, DM, G, bx);
                pg8::EpiRes E{xb, ssq2, nullptr, 0, nullptr};
                pg8::gemm_phase<pg8::EpiRes, pg8::StaticOrder, true, true>(lds, g, S, E, wave);
            }
            SEAM();
        }
        if (RUN) REP(0) {
            PH_BEGIN
            pg8::Gemm g{xb, (const bf16*)(ws + WS_WUP + (size_t)L * 8 * MiB), NTOK, DFF, DM, DM, DM}; pg8::StaticOrder S; S.init(NTOK, DFF, G, bx);
            pg8::EpiSq E{(bf16*)(R + R_U), DFF};
            pg8::gemm_phase<pg8::EpiSq, pg8::StaticOrder, true, true>(lds, g, S, E, wave);
        }
        SEAM();
        if (RUN) REP(10) {
            PH_BEGIN
            pg8::Gemm g{(const bf16*)(R + R_U), (const bf16*)(ws + WS_WDN + (size_t)L * 8 * MiB), NTOK, DM, DFF, DFF, DFF}; pg8::StaticOrder S; S.init(NTOK, DM, G, bx);
            pg8::EpiRes E{xb, ssq, (L == 3) ? A_->out : (float*)nullptr, (((DUPMASK >> 10) & 1) && rep_ == 0) ? 1 : 0, ssq2};
            pg8::gemm_phase<pg8::EpiRes, pg8::StaticOrder, true, true>(lds, g, S, E, wave);
        }
        SEAM();
    }
#undef RUN
#undef SEAM
}

constexpr int N_PHASES = 1 + (4 + 2) + (3 + 2) + (5 + 2) + (4 + 2);

extern "C" void kernel_launch(void* const* d_in, const int* in_sizes, int n_in, void* d_out, int out_size, void* d_ws, size_t ws_size, hipStream_t stream) {
    static int grid = 0;
    if (grid == 0) {
        if (n_in != 24 || in_sizes[0] != NTOK * DM || out_size != NTOK * DM || ws_size < WS_END) {
            fprintf(stderr, "kernel_launch: unexpected problem shape (n_in %d, in0 %d, out %d, ws %zu < %zu); nothing launched\n", n_in, n_in > 0 ? in_sizes[0] : -1, out_size, ws_size, (size_t)WS_END); grid = -1; return; }
        int dev = 0, cus = 0, per_cu = 0;
        if (hipGetDevice(&dev) != hipSuccess || hipDeviceGetAttribute(&cus, hipDeviceAttributeMultiprocessorCount, dev) != hipSuccess) { grid = -1; return; }
        if (hipFuncSetAttribute((const void*)mk_fwd, hipFuncAttributeMaxDynamicSharedMemorySize, LDS_BYTES) != hipSuccess) { fprintf(stderr, "kernel_launch: hipFuncSetAttribute failed\n"); grid = -1; return; }
        if (hipOccupancyMaxActiveBlocksPerMultiprocessor(&per_cu, (const void*)mk_fwd, NTHR, LDS_BYTES) != hipSuccess || per_cu < 1)
            fprintf(stderr, "kernel_launch: note: occupancy query reports %d workgroups per CU\n", per_cu);
        (void)hipGetLastError();
        grid = cus;
    }
    if (grid < 0) return;
    if (hipMemsetAsync((char*)d_ws + WS_CTL, 0, CTL_ZERO_BYTES, stream) != hipSuccess) return;
    Args a{};
    for (int i = 0; i < 24; ++i) a.in[i] = (const float*)d_in[i];
    a.out = (float*)d_out; a.ws = (unsigned char*)d_ws;
#if MK_SINGLE
    a.ph_lo = 0; a.ph_hi = N_PHASES;
    hipLaunchKernelGGL(mk_fwd, dim3(grid), dim3(NTHR), LDS_BYTES, stream, a);
#else
    for (int k = 0; k < N_PHASES; ++k) { a.ph_lo = k; a.ph_hi = k + 1; hipLaunchKernelGGL(mk_fwd, dim3(grid), dim3(NTHR), LDS_BYTES, stream, a); }
#endif
}
```

```cpp
#include <hip/hip_runtime.h>
#include <cstdio>
#include <cstdint>

namespace xl {
template <int CTRL> __device__ __forceinline__ unsigned dppu(unsigned v) { return (unsigned)__builtin_amdgcn_update_dpp(0, (int)v, CTRL, 0xf, 0xf, true); }
__device__ __forceinline__ void sw16(unsigned v, unsigned& a, unsigned& b) { auto r = __builtin_amdgcn_permlane16_swap(v, v, false, false); a = r[0]; b = r[1]; }
__device__ __forceinline__ void sw32(unsigned v, unsigned& a, unsigned& b) { auto r = __builtin_amdgcn_permlane32_swap(v, v, false, false); a = r[0]; b = r[1]; }
__device__ __forceinline__ float add1(float v) { return v + __uint_as_float(dppu<0xB1>(__float_as_uint(v))); }
__device__ __forceinline__ float add2(float v) { return v + __uint_as_float(dppu<0x4E>(__float_as_uint(v))); }
__device__ __forceinline__ float add4(float v) { return v + __uint_as_float(dppu<0x141>(__float_as_uint(v))); }
__device__ __forceinline__ float add8(float v) { return v + __uint_as_float(dppu<0x140>(__float_as_uint(v))); }
__device__ __forceinline__ float max1(float v) { return fmaxf(v, __uint_as_float(dppu<0xB1>(__float_as_uint(v)))); }
__device__ __forceinline__ float max2(float v) { return fmaxf(v, __uint_as_float(dppu<0x4E>(__float_as_uint(v)))); }
__device__ __forceinline__ float max4(float v) { return fmaxf(v, __uint_as_float(dppu<0x141>(__float_as_uint(v)))); }
__device__ __forceinline__ float max8(float v) { return fmaxf(v, __uint_as_float(dppu<0x140>(__float_as_uint(v)))); }
__device__ __forceinline__ float min1(float v) { return fminf(v, __uint_as_float(dppu<0xB1>(__float_as_uint(v)))); }
__device__ __forceinline__ float min2(float v) { return fminf(v, __uint_as_float(dppu<0x4E>(__float_as_uint(v)))); }
__device__ __forceinline__ float min4(float v) { return fminf(v, __uint_as_float(dppu<0x141>(__float_as_uint(v)))); }
__device__ __forceinline__ float min8(float v) { return fminf(v, __uint_as_float(dppu<0x140>(__float_as_uint(v)))); }
__device__ __forceinline__ int iadd1(int v) { return v + (int)dppu<0xB1>((unsigned)v); }
__device__ __forceinline__ int iadd2(int v) { return v + (int)dppu<0x4E>((unsigned)v); }
__device__ __forceinline__ int iadd4(int v) { return v + (int)dppu<0x141>((unsigned)v); }
__device__ __forceinline__ int iadd8(int v) { return v + (int)dppu<0x140>((unsigned)v); }
__device__ __forceinline__ unsigned or1(unsigned v) { return v | dppu<0xB1>(v); }
__device__ __forceinline__ unsigned or2(unsigned v) { return v | dppu<0x4E>(v); }
__device__ __forceinline__ unsigned or4(unsigned v) { return v | dppu<0x141>(v); }
__device__ __forceinline__ float add16(float v) { unsigned a, b; sw16(__float_as_uint(v), a, b); return __uint_as_float(a) + __uint_as_float(b); }
__device__ __forceinline__ float add32(float v) { unsigned a, b; sw32(__float_as_uint(v), a, b); return __uint_as_float(a) + __uint_as_float(b); }
__device__ __forceinline__ float max16(float v) { unsigned a, b; sw16(__float_as_uint(v), a, b); return fmaxf(__uint_as_float(a), __uint_as_float(b)); }
__device__ __forceinline__ float max32(float v) { unsigned a, b; sw32(__float_as_uint(v), a, b); return fmaxf(__uint_as_float(a), __uint_as_float(b)); }
__device__ __forceinline__ float min16(float v) { unsigned a, b; sw16(__float_as_uint(v), a, b); return fminf(__uint_as_float(a), __uint_as_float(b)); }
__device__ __forceinline__ float min32(float v) { unsigned a, b; sw32(__float_as_uint(v), a, b); return fminf(__uint_as_float(a), __uint_as_float(b)); }
__device__ __forceinline__ int iadd16(int v) { unsigned a, b; sw16((unsigned)v, a, b); return (int)(a + b); }
__device__ __forceinline__ int iadd32(int v) { unsigned a, b; sw32((unsigned)v, a, b); return (int)(a + b); }
__device__ __forceinline__ int scan_row(int v) {
    v += (int)__builtin_amdgcn_update_dpp(0, v, 0x111, 0xf, 0xf, false); v += (int)__builtin_amdgcn_update_dpp(0, v, 0x112, 0xf, 0xf, false);
    v += (int)__builtin_amdgcn_update_dpp(0, v, 0x114, 0xf, 0xf, false); v += (int)__builtin_amdgcn_update_dpp(0, v, 0x118, 0xf, 0xf, false); return v; }
__device__ __forceinline__ int scan32(int v) { v = scan_row(v); v += (int)__builtin_amdgcn_update_dpp(0, v, 0x142, 0xa, 0xf, false); return v; }
__device__ __forceinline__ int scan64(int v) { v = scan32(v); v += (int)__builtin_amdgcn_update_dpp(0, v, 0x143, 0xc, 0xf, false); return v; }
__device__ __forceinline__ unsigned or16(unsigned v) { unsigned a, b; sw16(v, a, b); return a | b; }
__device__ __forceinline__ unsigned or32(unsigned v) { unsigned a, b; sw32(v, a, b); return a | b; }
}
namespace pg8 {
#define PG8_LAS __attribute__((address_space(3)))
typedef unsigned short bf16_t;
typedef short bf16x8 __attribute__((ext_vector_type(8)));
typedef float f32x4 __attribute__((ext_vector_type(4)));
typedef unsigned u32x4 __attribute__((ext_vector_type(4)));
constexpr int BM = 256, BK = 64, HALF = 128, HTB = HALF * BK * 2  , STAGE_BYTES = 8 * HTB, NXCD = 8, WGM = 8;

__host__ __device__ __forceinline__ int lds_byte(int r, int c) { const int st = (r >> 4) * 2 + (c >> 5), rr = r & 15, cc = c & 31, ob = rr * 64 + cc * 2; return st * 1024 + (ob ^ (((ob >> 9) & 1) << 5)); }
__host__ __device__ __forceinline__ void stage_rc(int b, int& R, int& C) { const int st = b / 1024, sb = b % 1024, swz = sb ^ (((sb >> 9) & 1) << 5); R = (st >> 1) * 16 + swz / 64; C = (st & 1) * 32 + (swz % 64) / 2; }
__host__ __device__ __forceinline__ int perm32(int rho) { const int n = rho >> 4, i = rho & 15; return 8 * (i >> 2) + 4 * n + (i & 3); }

struct Unit { int pm, pn; };
struct Gemm { const bf16_t* A; const bf16_t* Bt; int M, N, K, lda, ldb; };

struct StaticOrder {
    int nM, nN, nwg, G, c, rev;
    __host__ __device__ void init(int M, int N, int G_, int c_) { nM = M / BM; nN = N / BM; nwg = nM * nN; G = G_; c = c_; rev = 0; }
    __host__ __device__ bool next(int i, Unit& u) const {
        if ((long)i * G + c >= nwg) return false;
        const long L = (long)(rev ? (nwg / G - 1 - i) : i) * G + c;
        int wgid = (int)L; { const int q = nwg / NXCD, r = nwg % NXCD, xcd = wgid % NXCD, off = wgid / NXCD; wgid = (xcd < r ? xcd * (q + 1) : r * (q + 1) + (xcd - r) * q) + off; }
        const int nig = WGM * nN, gid = wgid / nig, fm = gid * WGM, gsz = (nM - fm) < WGM ? (nM - fm) : WGM;
        u.pm = fm + ((wgid % nig) % gsz); u.pn = (wgid % nig) / gsz; return true;
    }
    __device__ __forceinline__ void a_ready(const Unit&) const {}
    __device__ __forceinline__ void done(const Unit&) const {}
};

__device__ __forceinline__ unsigned cvt_pk_bf16(float lo, float hi) { unsigned r; asm volatile("v_cvt_pk_bf16_f32 %0, %1, %2" : "=v"(r) : "v"(lo), "v"(hi)); return r; }
typedef float f32x2 __attribute__((ext_vector_type(2)));

__device__ __forceinline__ void row_rs8(float (&rsv)[2][4], const float* st, int row0, int off, int cnt, float inv_n, int fq) {
    const bool in = 4 * fq < cnt;
    const float msk = in ? 1.0f : 0.0f;
    const float* p = st + (size_t)row0 * 16 + off + (in ? 4 * fq : 0);
    f32x4 v[2][4];
#pragma unroll
    for (int ai = 0; ai < 2; ++ai)
#pragma unroll
        for (int m = 0; m < 4; ++m) v[ai][m] = *(const f32x4*)(p + (size_t)(ai * HALF + m * 16) * 16);
    __builtin_amdgcn_sched_barrier(0);
#pragma unroll
    for (int ai = 0; ai < 2; ++ai)
#pragma unroll
        for (int m = 0; m < 4; ++m) {
            float s = ((v[ai][m][0] + v[ai][m][1]) + (v[ai][m][2] + v[ai][m][3])) * msk;
            s = xl::add32(xl::add16(s));
            rsv[ai][m] = __builtin_amdgcn_rsqf(s * inv_n + 1e-6f);
        }
}
template <int ACT, bool STAT> struct EpiScale {
    static constexpr bool PERM = true, AFTER_DRAIN = false;
    bf16_t* O; int ldc; const float* st; int st_off, st_cnt; float inv_n; float* stat_out; int nt;
    __device__ __forceinline__ bool stores16() const { return true; }
    __device__ __forceinline__ void operator()(const f32x4 (&acc)[2][2][4][2], const Unit& u, int wr, int wc, int fr, int fq) const {
        asm volatile("" : "+v"(fr), "+v"(fq));
        const int row0 = u.pm * BM + wr * 64 + fr, col0 = u.pn * BM + wc * 64 + 8 * fq;
        float rsv[2][4];
        row_rs8(rsv, st, row0, st_off, st_cnt, inv_n, fq);
        asm volatile("" ::: "memory");
#pragma unroll
        for (int ai = 0; ai < 2; ++ai)
#pragma unroll
            for (int m = 0; m < 4; ++m) {
                const int row = row0 + ai * HALF + m * 16;
                const float rs = rsv[ai][m];
                bf16_t* rowp = O + (size_t)row * ldc + col0;
#pragma unroll
                for (int bj = 0; bj < 2; ++bj) {
                    f32x4 v0 = acc[ai][bj][m][0] * rs, v1 = acc[ai][bj][m][1] * rs;
                    if (ACT == 1) {
#pragma unroll
                        for (int e = 0; e < 4; ++e) { const float a = fmaxf(v0[e], 0.f), b = fmaxf(v1[e], 0.f); v0[e] = a * a; v1[e] = b * b; }
                    }
                    if (STAT) {
                        float q = (v0[0] * v0[0] + v0[1] * v0[1]) + (v0[2] * v0[2] + v0[3] * v0[3]) + (v1[0] * v1[0] + v1[1] * v1[1]) + (v1[2] * v1[2] + v1[3] * v1[3]);
                        q = xl::add32(xl::add16(q));
                        if (fq == 0) stat_out[(size_t)row * 16 + u.pn * 8 + wc * 2 + bj] = q;
                    }
                    u32x4 w; w.x = cvt_pk_bf16(v0[0], v0[1]); w.y = cvt_pk_bf16(v0[2], v0[3]); w.z = cvt_pk_bf16(v1[0], v1[1]); w.w = cvt_pk_bf16(v1[2], v1[3]);
                    if (ACT == 1 || nt) __builtin_nontemporal_store(w, (u32x4*)(rowp + bj * 32));
                    else *(u32x4*)(rowp + bj * 32) = w;
                }
            }
    }
};
struct EpiSq {
    static constexpr bool PERM = true, AFTER_DRAIN = false;
    bf16_t* O; int ldc;
    __device__ __forceinline__ bool stores16() const { return true; }
    __device__ __forceinline__ void operator()(const f32x4 (&acc)[2][2][4][2], const Unit& u, int wr, int wc, int fr, int fq) const {
        asm volatile("" : "+v"(fr), "+v"(fq));
        const int row0 = u.pm * BM + wr * 64 + fr, col0 = u.pn * BM + wc * 64 + 8 * fq;
#pragma unroll
        for (int ai = 0; ai < 2; ++ai)
#pragma unroll
            for (int m = 0; m < 4; ++m) {
                bf16_t* rowp = O + (size_t)(row0 + ai * HALF + m * 16) * ldc + col0;
#pragma unroll
                for (int bj = 0; bj < 2; ++bj) {
                    f32x4 v0 = acc[ai][bj][m][0], v1 = acc[ai][bj][m][1];
#pragma unroll
                    for (int e = 0; e < 4; ++e) { const float a = fmaxf(v0[e], 0.f), b = fmaxf(v1[e], 0.f); v0[e] = a * a; v1[e] = b * b; }
                    u32x4 w; w.x = cvt_pk_bf16(v0[0], v0[1]); w.y = cvt_pk_bf16(v0[2], v0[3]); w.z = cvt_pk_bf16(v1[0], v1[1]); w.w = cvt_pk_bf16(v1[2], v1[3]);
                    __builtin_nontemporal_store(w, (u32x4*)(rowp + bj * 32));
                }
            }
    }
};
struct EpiRes {
    static constexpr bool PERM = true, AFTER_DRAIN = false;
    bf16_t* xb; float* ssq; float* outf; int dry;
    __device__ __forceinline__ bool stores16() const { return dry == 0; }
    const float* sin;
    __device__ __forceinline__ void operator()(const f32x4 (&acc)[2][2][4][2], const Unit& u, int wr, int wc, int fr, int fq) const {
        if (dry) return;
        asm volatile("" : "+v"(fr), "+v"(fq));
        const int row0 = u.pm * BM + wr * 64 + fr, col0 = u.pn * BM + wc * 64 + 8 * fq;
#pragma unroll
        for (int ai = 0; ai < 2; ++ai) {
            u32x4 pre[4][2];
            f32x4 sv[4]; float r2[4] = {1.f, 1.f, 1.f, 1.f};
            if (sin) {
#pragma unroll
                for (int m = 0; m < 4; ++m) sv[m] = *(const f32x4*)(sin + (size_t)(row0 + ai * HALF + m * 16) * 16 + 4 * fq);
            }
#pragma unroll
            for (int m = 0; m < 4; ++m)
#pragma unroll
                for (int bj = 0; bj < 2; ++bj) pre[m][bj] = *(const u32x4*)(xb + (size_t)(row0 + ai * HALF + m * 16) * 1024 + col0 + bj * 32);
            if (sin) {
#pragma unroll
                for (int m = 0; m < 4; ++m) { float s = (sv[m][0] + sv[m][1]) + (sv[m][2] + sv[m][3]); s = xl::add32(xl::add16(s)); r2[m] = __builtin_amdgcn_rcpf(s * (1.0f / 1024.0f) + 1e-6f); }
            }
#pragma unroll
            for (int m = 0; m < 4; ++m) {
                const int row = row0 + ai * HALF + m * 16; const size_t off = (size_t)row * 1024 + col0; float q = 0.f;
#pragma unroll
                for (int bj = 0; bj < 2; ++bj) {
                    const u32x4 p = pre[m][bj];
                    f32x4 o0 = acc[ai][bj][m][0] * r2[m], o1 = acc[ai][bj][m][1] * r2[m];
                    o0[0] += __uint_as_float(p.x << 16); o0[1] += __uint_as_float(p.x & 0xffff0000u); o0[2] += __uint_as_float(p.y << 16); o0[3] += __uint_as_float(p.y & 0xffff0000u);
                    o1[0] += __uint_as_float(p.z << 16); o1[1] += __uint_as_float(p.z & 0xffff0000u); o1[2] += __uint_as_float(p.w << 16); o1[3] += __uint_as_float(p.w & 0xffff0000u);
                    q += ((o0[0] * o0[0] + o0[1] * o0[1]) + (o0[2] * o0[2] + o0[3] * o0[3])) + ((o1[0] * o1[0] + o1[1] * o1[1]) + (o1[2] * o1[2] + o1[3] * o1[3]));
                    u32x4 w; w.x = cvt_pk_bf16(o0[0], o0[1]); w.y = cvt_pk_bf16(o0[2], o0[3]); w.z = cvt_pk_bf16(o1[0], o1[1]); w.w = cvt_pk_bf16(o1[2], o1[3]);
                    if (outf) { __builtin_nontemporal_store(o0, (f32x4*)(outf + off + bj * 32)); __builtin_nontemporal_store(o1, (f32x4*)(outf + off + bj * 32 + 4)); }
                    else *(u32x4*)(xb + off + bj * 32) = w;
                }
                q = xl::add32(xl::add16(q));
                if (fq == 0 && !outf) ssq[(size_t)row * 16 + u.pn * 4 + wc] = q;
            }
            asm volatile("" ::: "memory");
        }
    }
};
template <class Epi, class Sched, bool ALIGN_EPI = false, bool SP2 = false>
__device__ __forceinline__ void gemm_phase(PG8_LAS unsigned char* lds, const Gemm g, const Sched& S, const Epi& E, const int wave_id) {
    int lane_; asm volatile("v_mbcnt_lo_u32_b32 %0, -1, 0\n\tv_mbcnt_hi_u32_b32 %0, -1, %0" : "=v"(lane_));
    const int tid = wave_id * 64 + lane_;
    const int wid = wave_id, lane = tid & 63, wr = wid >> 2, wc = wid & 3, fr = lane & 15, fq = lane >> 4;
    const int K = g.K, nt = K / BK;
    unsigned voffA[2], voffB[2];
#pragma unroll
    for (int i = 0; i < 2; ++i) { int R, C; stage_rc(tid * 16 + i * 8192, R, C); const int Rb = Epi::PERM ? ((R & ~31) + perm32(R & 31)) : R;
        voffA[i] = (unsigned)(R * g.lda + C) * 2u; voffB[i] = (unsigned)(Rb * g.ldb + C) * 2u; }
    const size_t kstep = (size_t)(BK * 2);
    const size_t hstepA = (size_t)HALF * g.lda * 2, hstepB = (size_t)HALF * g.ldb * 2;
    const size_t tstepA = 2 * hstepA, tstepB = 2 * hstepB;
    const unsigned ldsw = (unsigned)wid * 1024u;
    const int aoff = lds_byte(wr * 64 + fr, fq * 8), boff = lds_byte(wc * 32 + fr, fq * 8);
#define PG8_SA(b, h) (((b) * 2 + (h)) * HTB)
#define PG8_SB(b, h) ((4 + (b) * 2 + (h)) * HTB)
#define PG8_STAGE(bufoff, gbase, voff) do { _Pragma("unroll") for (int _i = 0; _i < 2; ++_i) \
        __builtin_amdgcn_global_load_lds((const unsigned*)((const char*)(gbase) + (voff)[_i]), (PG8_LAS unsigned*)(lds + (bufoff) + ldsw + _i * 8192), 16, 0, 0); } while (0)
#define PG8_LDA(dst, b, h) do { _Pragma("unroll") for (int m = 0; m < 4; ++m) _Pragma("unroll") for (int k = 0; k < 2; ++k) dst[m][k] = *(const PG8_LAS bf16x8*)(lds + PG8_SA(b, h) + aoff + m * 2048 + k * 1024); } while (0)
#define PG8_LDB(dst, b, h) do { _Pragma("unroll") for (int n = 0; n < 2; ++n) _Pragma("unroll") for (int k = 0; k < 2; ++k) dst[n][k] = *(const PG8_LAS bf16x8*)(lds + PG8_SB(b, h) + boff + n * 2048 + k * 1024); } while (0)
#define PG8_MMA(ai, bj, At, Bt) do { __builtin_amdgcn_s_setprio(1); _Pragma("unroll") for (int m = 0; m < 4; ++m) _Pragma("unroll") for (int n = 0; n < 2; ++n) _Pragma("unroll") for (int k = 0; k < 2; ++k) \
        acc[ai][bj][m][n] = __builtin_amdgcn_mfma_f32_16x16x32_bf16(Bt[n][k], At[m][k], acc[ai][bj][m][n], 0, 0, 0); __builtin_amdgcn_s_setprio(0); } while (0)
#define PG8_WAIT_V(n) asm volatile("s_waitcnt vmcnt(" #n ")" ::: "memory")
#define PG8_WAIT_V_RLX(r) asm volatile("s_cmp_lg_u32 %0, 0\n\ts_cbranch_scc0 .Lpgw8_%=\n\ts_waitcnt vmcnt(24)\n\ts_branch .Lpgwe_%=\n.Lpgw8_%=:\n\ts_waitcnt vmcnt(8)\n.Lpgwe_%=:" :: "s"(r) : "memory", "scc")
#define PG8_WAIT_L(n) asm volatile("s_waitcnt lgkmcnt(" #n ")" ::: "memory")
#define PG8_BAR __builtin_amdgcn_s_barrier()
#define PG8_SCHED __builtin_amdgcn_sched_barrier(0)
    Unit cur, nxt; int ui = 0;
    if (!S.next(0, cur)) return;
    f32x4 acc[2][2][4][2];
#pragma unroll
    for (int a = 0; a < 2; ++a)
#pragma unroll
        for (int b = 0; b < 2; ++b)
#pragma unroll
            for (int m = 0; m < 4; ++m)
#pragma unroll
                for (int n = 0; n < 2; ++n) acc[a][b][m][n] = (f32x4){0.f, 0.f, 0.f, 0.f};
    bf16x8 At[4][2], B0[2][2], B1[2][2];
    const char* cA = (const char*)g.A + (size_t)cur.pm * tstepA; const char* cB = (const char*)g.Bt + (size_t)cur.pn * tstepB;
    S.a_ready(cur);
    if constexpr (SP2) {
        PG8_STAGE(PG8_SB(0, 0), cB, voffB); PG8_STAGE(PG8_SB(0, 1), cB + hstepB, voffB); PG8_STAGE(PG8_SA(0, 0), cA, voffA); PG8_STAGE(PG8_SA(0, 1), cA + hstepA, voffA);
        if (wr == 1) PG8_BAR;
        PG8_WAIT_V(2); PG8_BAR;
        PG8_STAGE(PG8_SB(1, 0), cB + kstep, voffB); PG8_STAGE(PG8_SA(1, 0), cA + kstep, voffA); PG8_STAGE(PG8_SB(1, 1), cB + hstepB + kstep, voffB);
        PG8_WAIT_V(6); PG8_BAR;
    } else {
        PG8_STAGE(PG8_SB(0, 0), cB, voffB); PG8_STAGE(PG8_SA(0, 0), cA, voffA); PG8_STAGE(PG8_SB(0, 1), cB + hstepB, voffB); PG8_STAGE(PG8_SA(0, 1), cA + hstepA, voffA);
        if (wr == 1) PG8_BAR;
        PG8_WAIT_V(4); PG8_BAR;
        PG8_STAGE(PG8_SB(1, 0), cB + kstep, voffB); PG8_STAGE(PG8_SA(1, 0), cA + kstep, voffA); PG8_STAGE(PG8_SB(1, 1), cB + hstepB + kstep, voffB);
        PG8_WAIT_V(6); PG8_BAR;
    }
    bool after_epi = false;
    for (;;) {
        const bool has_next = S.next(ui + 1, nxt);
        const char* nA = has_next ? (const char*)g.A + (size_t)nxt.pm * tstepA : cA; const char* nB = has_next ? (const char*)g.Bt + (size_t)nxt.pn * tstepB : cB;
        for (int t = 0; t < nt; t += 2) {
            const bool last = (t == nt - 2);
            const char* a1 = cA + (size_t)(t + 1) * kstep;
            const char* a2 = last ? nA : cA + (size_t)(t + 2) * kstep; const char* b2 = last ? nB : cB + (size_t)(t + 2) * kstep;
            const char* a3 = a2 + kstep; const char* b3 = b2 + kstep;
            if (last && has_next) S.a_ready(nxt);
            if constexpr (SP2) {
            const int rlx = __builtin_amdgcn_readfirstlane((after_epi && (t == 0)) ? 1 : 0);
            PG8_LDB(B0, 0, 0); PG8_LDB(B1, 0, 1); PG8_SCHED; PG8_LDA(At, 0, 0); PG8_STAGE(PG8_SA(1, 1), a1 + hstepA, voffA);
            PG8_WAIT_V_RLX(rlx);
            PG8_WAIT_L(0); PG8_BAR; PG8_MMA(0, 0, At, B0); PG8_MMA(0, 1, At, B1); PG8_BAR; PG8_SCHED;
            PG8_LDA(At, 0, 1); PG8_STAGE(PG8_SB(0, 0), b2, voffB); PG8_STAGE(PG8_SB(0, 1), b2 + hstepB, voffB); PG8_STAGE(PG8_SA(0, 0), a2, voffA);
            PG8_WAIT_V_RLX(rlx);
            PG8_WAIT_L(0); PG8_BAR; PG8_MMA(1, 0, At, B0); PG8_MMA(1, 1, At, B1); PG8_BAR; PG8_SCHED;
            PG8_LDB(B0, 1, 0); PG8_LDB(B1, 1, 1); PG8_SCHED; PG8_LDA(At, 1, 0); PG8_STAGE(PG8_SA(0, 1), a2 + hstepA, voffA);
            PG8_WAIT_V(8); PG8_WAIT_L(0); PG8_BAR; PG8_MMA(0, 0, At, B0); PG8_MMA(0, 1, At, B1); PG8_BAR; PG8_SCHED;
            PG8_LDA(At, 1, 1); PG8_STAGE(PG8_SB(1, 0), b3, voffB); PG8_STAGE(PG8_SB(1, 1), b3 + hstepB, voffB); PG8_STAGE(PG8_SA(1, 0), a3, voffA);
            PG8_WAIT_V(8); PG8_WAIT_L(0); PG8_BAR; PG8_MMA(1, 0, At, B0); PG8_MMA(1, 1, At, B1); PG8_BAR; PG8_SCHED;
            } else {
            PG8_LDB(B0, 0, 0); PG8_SCHED; PG8_LDA(At, 0, 0); PG8_STAGE(PG8_SA(1, 1), a1 + hstepA, voffA);
            PG8_WAIT_L(8); PG8_BAR; PG8_WAIT_L(0); PG8_MMA(0, 0, At, B0); PG8_BAR; PG8_SCHED;
            PG8_LDB(B1, 0, 1); PG8_STAGE(PG8_SB(0, 0), b2, voffB);
            PG8_BAR; PG8_WAIT_L(0); PG8_MMA(0, 1, At, B1); PG8_BAR;
            PG8_LDA(At, 0, 1); PG8_STAGE(PG8_SA(0, 0), a2, voffA);
            PG8_BAR; PG8_WAIT_L(0); PG8_MMA(1, 0, At, B0); PG8_BAR; PG8_SCHED;
            PG8_STAGE(PG8_SB(0, 1), b2 + hstepB, voffB);
            PG8_WAIT_V(6); PG8_BAR; PG8_MMA(1, 1, At, B1); PG8_BAR;
            PG8_LDB(B0, 1, 0); PG8_SCHED; PG8_LDA(At, 1, 0); PG8_STAGE(PG8_SA(0, 1), a2 + hstepA, voffA);
            PG8_WAIT_L(8); PG8_BAR; PG8_WAIT_L(0); PG8_MMA(0, 0, At, B0); PG8_BAR; PG8_SCHED;
            PG8_LDB(B1, 1, 1); PG8_STAGE(PG8_SB(1, 0), b3, voffB);
            PG8_BAR; PG8_WAIT_L(0); PG8_MMA(0, 1, At, B1); PG8_BAR;
            PG8_LDA(At, 1, 1); PG8_STAGE(PG8_SA(1, 0), a3, voffA);
            PG8_BAR; PG8_WAIT_L(0); PG8_MMA(1, 0, At, B0); PG8_BAR; PG8_SCHED;
            PG8_STAGE(PG8_SB(1, 1), b3 + hstepB, voffB);
            PG8_WAIT_V(6); PG8_BAR; PG8_MMA(1, 1, At, B1); PG8_BAR;
            }
        }
        if constexpr (ALIGN_EPI) { if (wr == 0) PG8_BAR; }
        if constexpr (!Epi::AFTER_DRAIN) { int le_; asm volatile("v_mbcnt_lo_u32_b32 %0, -1, 0\n\tv_mbcnt_hi_u32_b32 %0, -1, %0" : "=v"(le_)); E(acc, cur, wr, wc, le_ & 15, le_ >> 4); S.done(cur); }
        if (!has_next) break;
#pragma unroll
        for (int a = 0; a < 2; ++a)
#pragma unroll
            for (int b = 0; b < 2; ++b)
#pragma unroll
                for (int m = 0; m < 4; ++m)
#pragma unroll
                    for (int n = 0; n < 2; ++n) acc[a][b][m][n] = (f32x4){0.f, 0.f, 0.f, 0.f};
        cur = nxt; cA = nA; cB = nB; ++ui; after_epi = E.stores16();
        if constexpr (ALIGN_EPI) { if (wr == 1) PG8_BAR; }
    }
    PG8_WAIT_V(0);
    if constexpr (!ALIGN_EPI) { if (wr == 0) PG8_BAR; }
    PG8_BAR;
    if constexpr (Epi::AFTER_DRAIN) { E.fused(acc, cur, wr, wc, fr, fq, lds, wid, lane); S.done(cur); }
#undef PG8_SA
#undef PG8_SB
#undef PG8_STAGE
#undef PG8_LDA
#undef PG8_LDB
#undef PG8_MMA
#undef PG8_WAIT_V
#undef PG8_WAIT_V_RLX
#undef PG8_WAIT_L
#undef PG8_BAR
#undef PG8_SCHED
}
}
#define GAS __attribute__((address_space(1)))
#define LAS __attribute__((address_space(3)))
typedef unsigned short bf16;
typedef unsigned v4u __attribute__((ext_vector_type(4)));
typedef float f32x4 __attribute__((ext_vector_type(4)));
typedef short bf16x8 __attribute__((ext_vector_type(8)));
typedef GAS unsigned gu32;
typedef GAS unsigned long long gu64;
#define RLX_AGENT __ATOMIC_RELAXED, __HIP_MEMORY_SCOPE_AGENT
#define LDS_WAIT() asm volatile("s_waitcnt lgkmcnt(0)" ::: "memory")
#define VM_WAIT() asm volatile("s_waitcnt vmcnt(0)" ::: "memory")
__device__ __forceinline__ unsigned long long rt() { return __builtin_amdgcn_s_memrealtime(); }
__device__ __forceinline__ unsigned f2bf(float f) { unsigned u = __builtin_bit_cast(unsigned, f); return (u + 0x7fffu + ((u >> 16) & 1u)) >> 16; }
__device__ __forceinline__ unsigned pk2(float lo, float hi) { return f2bf(lo) | (f2bf(hi) << 16); }
#define XB_TMO      128
#define XB_XCNT(j)  (256  + 64 * (j))
#define XB_XSUB(j)  (1280 + 64 * (j))
#define XB_XGEN(j)  (2304 + 64 * (j))
#define XB_TOP      3328
#define XB_TOPGEN   3392
#define XCD_BAR_WORDS 3456
#define XB_SPIN_CAP (1u << 18)

__device__ __forceinline__ unsigned xb_ld(unsigned* p)              { return __hip_atomic_load(p, __ATOMIC_RELAXED, __HIP_MEMORY_SCOPE_AGENT); }
__device__ __forceinline__ unsigned xb_add(unsigned* p, unsigned v) { return __hip_atomic_fetch_add(p, v, __ATOMIC_RELAXED, __HIP_MEMORY_SCOPE_AGENT); }
__device__ __forceinline__ unsigned xb_xcc_id() { return (unsigned)__builtin_amdgcn_s_getreg((3 << 11) | 20) & 0xFu; }
#define XB_SPIN(cond, bar) do { unsigned _sp = 0; while (cond) { __builtin_amdgcn_s_sleep(1); \
    if ((++_sp & 255u) == 0u) { if (xb_ld(&(bar)[XB_TMO])) break; if (_sp > XB_SPIN_CAP) { atomicAdd(&(bar)[XB_TMO], 1u); break; } } } } while (0)

struct XcdBarrier {
    unsigned* bar; unsigned x;
    volatile LAS unsigned* st;
};

__device__ __forceinline__ XcdBarrier xcd_barrier_post(unsigned* bar, volatile LAS unsigned* st) {
    XcdBarrier b; b.bar = bar; b.x = xb_xcc_id(); b.st = st;
    if (threadIdx.x == 0) (void)xb_add(&bar[XB_XCNT(b.x)], 1u);
    return b;
}
__device__ __forceinline__ void xcd_barrier_complete(unsigned* bar, unsigned x, unsigned& nloc, unsigned& nx) {
    const unsigned G = gridDim.x * gridDim.y * gridDim.z;
    unsigned sum, cnt, mine, sp = 0u;
    for (;;) {
        sum = 0u; cnt = 0u; mine = 0u;
#pragma unroll
        for (unsigned j = 0; j < 16; ++j) { const unsigned c = xb_ld(&bar[XB_XCNT(j)]); sum += c; cnt += (c > 0u) ? 1u : 0u; mine = (j == x) ? c : mine; }
        if (sum == G) break;
        __builtin_amdgcn_s_sleep(1);
        if ((++sp & 255u) == 0u) { if (xb_ld(&bar[XB_TMO])) break; if (sp > XB_SPIN_CAP) { atomicAdd(&bar[XB_TMO], 1u); break; } }
    }
    nloc = mine > 0u ? mine : 1u; nx = cnt > 0u ? cnt : 1u;
}

__device__ __forceinline__ void xcd_barrier(const XcdBarrier& b) {
    asm volatile("s_waitcnt vmcnt(0)" ::: "memory");
    __syncthreads();
    if (threadIdx.x == 0) {
        unsigned* bar = b.bar;
        __builtin_amdgcn_s_waitcnt(0);
        unsigned nloc = b.st[0], nx = b.st[1];
        if (nloc == 0u) { xcd_barrier_complete(bar, b.x, nloc, nx); b.st[0] = nloc; b.st[1] = nx; }
        const unsigned old = xb_add(&bar[XB_XSUB(b.x)], 1u);
        const unsigned gen = old / nloc;
        if (old + 1u == (gen + 1u) * nloc) {
            __builtin_amdgcn_fence(__ATOMIC_RELEASE, "agent");
            asm volatile("s_waitcnt vmcnt(0)" ::: "memory");
            const unsigned og = xb_add(&bar[XB_TOP], 1u);
            const unsigned tg = og / nx;
            if (og + 1u == (tg + 1u) * nx) xb_add(&bar[XB_TOPGEN], 1u);
            else XB_SPIN(xb_ld(&bar[XB_TOPGEN]) == tg, bar);
            __builtin_amdgcn_fence(__ATOMIC_ACQUIRE, "agent");
            xb_add(&bar[XB_XGEN(b.x)], 1u);
            asm volatile("s_waitcnt vmcnt(0)" ::: "memory");
        } else {
            XB_SPIN(xb_ld(&bar[XB_XGEN(b.x)]) == gen, bar);
            __builtin_amdgcn_fence(__ATOMIC_ACQUIRE, "agent");
            asm volatile("s_waitcnt vmcnt(0)" ::: "memory");
        }
    }
    __syncthreads();
}

typedef short s16x4 __attribute__((ext_vector_type(4)));
typedef float f32x16 __attribute__((ext_vector_type(16)));
typedef unsigned u32x2 __attribute__((ext_vector_type(2)));
typedef LAS unsigned char* ldsp;

constexpr int NWAVES = 8, NTHR = 512;
constexpr int NTOK = 65536, SEQ = 4096, NBATCH = 16, DM = 1024, DFF = 4096;
constexpr int A_N = 1792, A_NREAL = 1736;
constexpr int A_K = 1024, A_V = 1088, A_QI = 1152, A_KI = 1664, A_WI = 1728;
constexpr int B_N = 1536;
constexpr int C_N1 = 512, C_N1REAL = 416;
constexpr int C_NQ = 1536, C_NKV = 2048;
constexpr float EPS = 1e-6f, LOG2E = 1.4426950408889634f;

constexpr size_t MiB = 1u << 20;
constexpr size_t WS_CTL = 0, CTL_ZERO_BYTES = 1 * MiB;
constexpr size_t WS_WUP = 1 * MiB, WS_WDN = 33 * MiB, WS_WAIN = 65 * MiB, WS_WAOUT = 72 * MiB, WS_WBIN = 76 * MiB, WS_WBOUT = 79 * MiB;
constexpr size_t WS_WCIN = 81 * MiB, WS_WQB = 82 * MiB, WS_WKVB = 83 * MiB, WS_WCOUT = 84 * MiB;
constexpr size_t WS_CS = 86 * MiB, WS_SSQ = 94 * MiB, WS_CSTAT = 98 * MiB, WS_XB = 102 * MiB, WS_R = 230 * MiB;
constexpr size_t R_U = 0, R_PA = 0, R_MASK = 224 * MiB, R_O = 256 * MiB, R_PB = 0, R_KN = 384 * MiB, R_VN = 392 * MiB;
constexpr size_t R_LAT = 0, R_Q = 64 * MiB, R_KV = 256 * MiB, R_KR = 512 * MiB, R_OC = 576 * MiB;
constexpr size_t WS_SSQ2 = WS_R + 704 * MiB;
constexpr size_t WS_END = WS_SSQ2 + 4 * MiB;
constexpr int CW_BAR = 4096;

constexpr int RING_BYTES = 131072, LDS_BYTES = 163840, LDSCTL_OFF = LDS_BYTES - 512, MISC_OFF = LDSCTL_OFF + 320;

__device__ __forceinline__ int phase_tid(int wave) { int l; asm volatile("v_mbcnt_lo_u32_b32 %0, -1, 0\n\tv_mbcnt_hi_u32_b32 %0, -1, %0" : "=v"(l)); return wave * 64 + l; }
__device__ __forceinline__ float bf2f(unsigned short v) { return __uint_as_float((unsigned)v << 16); }
__device__ __forceinline__ float bflo(unsigned w) { return __uint_as_float(w << 16); }
__device__ __forceinline__ float bfhi(unsigned w) { return __uint_as_float(w & 0xffff0000u); }
__device__ __forceinline__ unsigned cvtpk(float lo, float hi) { return pg8::cvt_pk_bf16(lo, hi); }
__device__ __forceinline__ float wave_sum(float v) {
    return xl::add32(xl::add16(xl::add8(xl::add4(xl::add2(xl::add1(v))))));
}
__device__ __forceinline__ s16x4 lds_tr(const LAS void* p) {
    typedef short v4i16_t __attribute__((ext_vector_type(4)));
    return __builtin_bit_cast(s16x4, __builtin_amdgcn_ds_read_tr16_b64_v4i16((LAS v4i16_t*)p));
}
__device__ __forceinline__ bf16x8 cat8(s16x4 a, s16x4 b) { return (bf16x8){a[0], a[1], a[2], a[3], b[0], b[1], b[2], b[3]}; }

__device__ __forceinline__ int t5_bucket(int n) {
    if (n < 16) return n;
    if (n >= 128) return 31;
    int b = 16 + (int)(logf((float)n * 0.0625f) * (16.0f / 2.0794415416798357f));
    return b > 31 ? 31 : b;
}

__device__ __forceinline__ void transpose_item(const float* __restrict__ W, int K, int Kreal, int Nreal, bf16* WT, const float* __restrict__ gain, LAS float* scr, int item, int nblk, int lane) {
    const int kb = item / nblk, nb = item % nblk, k0 = 64 * kb, n0 = 64 * nb;
    const int nq = n0 + 4 * (lane & 15);
    const bool vec = ((Nreal & 3) == 0) && (nq + 3 < Nreal);
    f32x4 vv[16]; float gg[16];
#pragma unroll
    for (int i = 0; i < 16; ++i) {
        const int kk = 4 * i + (lane >> 4); vv[i] = (f32x4){0.f, 0.f, 0.f, 0.f}; gg[i] = 1.0f;
        if (k0 + kk < Kreal) {
            const float* rp = W + (size_t)(k0 + kk) * Nreal + nq;
            if (vec) vv[i] = *(const f32x4*)rp;
            else { if (nq + 0 < Nreal) vv[i][0] = rp[0]; if (nq + 1 < Nreal) vv[i][1] = rp[1]; if (nq + 2 < Nreal) vv[i][2] = rp[2]; if (nq + 3 < Nreal) vv[i][3] = rp[3]; }
            if (gain) gg[i] = gain[k0 + kk];
        }
    }
#pragma unroll
    for (int i = 0; i < 16; ++i) {
        const int kk = 4 * i + (lane >> 4);
        *(LAS f32x4*)(scr + kk * 68 + ((4 * (lane & 15) + 4 * (kk >> 3)) & 63)) = vv[i] * gg[i];
    }
    LDS_WAIT(); asm volatile("" ::: "memory");
    const int c = lane & 7;
#pragma unroll
    for (int j = 0; j < 8; ++j) { const int nn = (lane >> 3) + 8 * j; const LAS float* s = scr + (8 * c) * 68 + ((nn + 4 * c) & 63);
        v4u o; o.x = pk2(s[0 * 68], s[1 * 68]); o.y = pk2(s[2 * 68], s[3 * 68]); o.z = pk2(s[4 * 68], s[5 * 68]); o.w = pk2(s[6 * 68], s[7 * 68]);
        const int ncol = n0 + nn, cl = ncol & 255;
        const int brow = (ncol & ~255) + 128 * ((cl & 63) >> 5) + 32 * (cl >> 6) + (cl & 31);
        *(v4u*)(WT + (size_t)brow * K + k0 + 8 * c) = o; }
    LDS_WAIT(); asm volatile("" ::: "memory");
}

struct Ptrs {
    const float* in[24]; float* out; unsigned char* ws;
};

__device__ __forceinline__ void prologue(const Ptrs& P, ldsp lds, int gw, int NGW, int wave) {
    const int lane = phase_tid(wave) & 63;
    LAS float* scr = (LAS float*)(lds + wave * 17408);
    unsigned char* ws = P.ws;
    {
        constexpr int I_UP = 16 * 64, I_DN = 64 * 16, I_AIN = 16 * (A_N / 64), I_SQ = 16 * 16, I_BIN = 16 * (B_N / 64), I_CIN = 16 * (C_N1 / 64), I_QB = 4 * (C_NQ / 64), I_KVB = 2 * (C_NKV / 64);
        constexpr int E0 = 4 * I_UP, E1 = E0 + 4 * I_DN, E2 = E1 + 2 * I_AIN, E3 = E2 + 2 * I_SQ, E4 = E3 + I_BIN, E5 = E4 + I_SQ, E6 = E5 + I_CIN, E7 = E6 + I_QB, E8 = E7 + I_KVB, E9 = E8 + I_SQ;
#pragma unroll 1
        for (int it = gw; it < E9; it += NGW) {
            const float* src; const float* gain = nullptr; bf16* dst; int KK = DM, NREAL = DM, NPAD = DM, li, KREAL = 0;
            if (it < E0)      { const int l = it / I_UP; li = it - l * I_UP; src = P.in[5] + (size_t)l * DM * DFF; NREAL = DFF; NPAD = DFF; dst = (bf16*)(ws + WS_WUP + (size_t)l * 8 * MiB); gain = P.in[4] + l * DM; }
            else if (it < E1) { const int l = (it - E0) / I_DN; li = it - E0 - l * I_DN; src = P.in[6] + (size_t)l * DM * DFF; KK = DFF; dst = (bf16*)(ws + WS_WDN + (size_t)l * 8 * MiB); }
            else if (it < E2) { const int i = (it - E1) / I_AIN; li = it - E1 - i * I_AIN; src = P.in[7] + (size_t)i * DM * A_NREAL; NREAL = A_NREAL; NPAD = A_N; dst = (bf16*)(ws + WS_WAIN + (size_t)i * (A_N * DM * 2)); gain = P.in[3] + (i == 0 ? 0 : 3) * DM; }
            else if (it < E3) { const int i = (it - E2) / I_SQ; li = it - E2 - i * I_SQ; src = P.in[10] + (size_t)i * DM * DM; dst = (bf16*)(ws + WS_WAOUT + (size_t)i * 2 * MiB); }
            else if (it < E4) { li = it - E3; src = P.in[11]; NREAL = B_N; NPAD = B_N; dst = (bf16*)(ws + WS_WBIN); gain = P.in[3] + 1 * DM; }
            else if (it < E5) { li = it - E4; src = P.in[15]; dst = (bf16*)(ws + WS_WBOUT); }
            else if (it < E6) { li = it - E5; src = P.in[16]; NREAL = C_N1REAL; NPAD = C_N1; dst = (bf16*)(ws + WS_WCIN); gain = P.in[3] + 2 * DM; }
            else if (it < E7) { li = it - E6; src = P.in[18]; KK = 256; NREAL = C_NQ; NPAD = C_NQ; dst = (bf16*)(ws + WS_WQB); gain = P.in[17]; }
            else if (it < E8) { li = it - E7; src = P.in[20]; KK = 128; NREAL = C_NKV; NPAD = C_NKV; dst = (bf16*)(ws + WS_WKVB); gain = P.in[19]; }
            else              { li = it - E8; src = P.in[23]; dst = (bf16*)(ws + WS_WCOUT); }
            transpose_item(src, KK, KREAL ? KREAL : KK, NREAL, dst, gain, scr, li, NPAD / 64, lane);
        }
    }
    {
        const float* x = P.in[0]; bf16* xb = (bf16*)(ws + WS_XB); float* ssq = (float*)(ws + WS_SSQ);
        for (int m0 = gw; m0 < NTOK; m0 += 2 * NGW) {
            f32x4 v[2][4];
#pragma unroll
            for (int rr = 0; rr < 2; ++rr) { const int m = m0 + rr * NGW; if (m < NTOK) { const f32x4* xr = (const f32x4*)(x + (size_t)m * DM) + lane;
#pragma unroll
                for (int j = 0; j < 4; ++j) v[rr][j] = xr[64 * j]; } }
#pragma unroll
            for (int rr = 0; rr < 2; ++rr) { const int m = m0 + rr * NGW; if (m < NTOK) {
                float s = 0.f;
#pragma unroll
                for (int j = 0; j < 4; ++j) s += (v[rr][j][0] * v[rr][j][0] + v[rr][j][1] * v[rr][j][1]) + (v[rr][j][2] * v[rr][j][2] + v[rr][j][3] * v[rr][j][3]);
                s = wave_sum(s);
                u32x2* o8 = (u32x2*)(xb + (size_t)m * DM) + lane;
#pragma unroll
                for (int j = 0; j < 4; ++j) { u32x2 w; w.x = pk2(v[rr][j][0], v[rr][j][1]); w.y = pk2(v[rr][j][2], v[rr][j][3]); o8[64 * j] = w; }
                if (lane < 16) ssq[(size_t)m * 16 + lane] = (lane == 0) ? s : 0.f; } }
        }
    }
    {
        const int* pos = (const int*)P.in[1]; float* cs = (float*)(ws + WS_CS);
        const int gt = gw * 64 + lane, NGT = NGW * 64;
        const int i = gt & 15;
        double inv_freq = 1.0; for (int k = 0; k < i; ++k) inv_freq *= 0.5623413251903491;
        for (int e0 = gt; e0 < NTOK * 16; e0 += 8 * NGT) {
            int pv[8];
#pragma unroll
            for (int u = 0; u < 8; ++u) { const int e = e0 + u * NGT; pv[u] = (e < NTOK * 16) ? pos[e >> 4] : 0; }
#pragma unroll
            for (int u = 0; u < 8; ++u) { const int e = e0 + u * NGT;
                if (e < NTOK * 16) {
                    const double rev = (double)pv[u] * inv_freq * 0.15915494309189535;
                    const float fr = (float)(rev - floor(rev));
                    pg8::f32x2 o; o[0] = __builtin_amdgcn_cosf(fr); o[1] = __builtin_amdgcn_sinf(fr);
                    *(pg8::f32x2*)(cs + 2 * (size_t)e) = o; } }
        }
    }
}

constexpr int A2_CAP = 64;
#ifndef A2DUP
#define A2DUP 0
#endif
constexpr int A2_QS = 8208;
constexpr int A2_T = 0, A2_MASK = 16 * A2_QS, A2_CAND = A2_MASK + 8192, A2_CCNT = A2_CAND + 8192;
__device__ __forceinline__ void phase_a2(ldsp lds, bf16* PA, unsigned* maskOut, f32x4* scr  , bf16* KN, bf16* VN  , const float* kgain, int vcu, int G, int wave) {
    const int w = wave;
    LAS unsigned* mask32 = (LAS unsigned*)(lds + A2_MASK);
    LAS unsigned long long* candk = (LAS unsigned long long*)(lds + A2_CAND);
    LAS unsigned* ccnt = (LAS unsigned*)(lds + A2_CCNT);
    { const int tid = phase_tid(wave); if (tid < 16) ccnt[tid] = 0u; }
    __syncthreads();
    int sbuf = 0;
    unsigned pm0 = 0u, pm1 = 0u, pm2 = 0u, pm3 = 0u; int prow = -1;
#define A2_FLUSH() do { if (prow >= 0) { const int m_ = phase_tid(wave) & 31; unsigned* mp_ = maskOut + (size_t)prow * 128 + m_; mp_[0] = pm0; mp_[32] = pm1; mp_[64] = pm2; mp_[96] = pm3; prow = -1; } } while (0)
    for (int p = vcu; p < 2048; p += G) {
#pragma unroll 1
      for (int half = 0; half < 2; ++half) {
        const int b = p >> 7, pr = p & 127, qt = half ? 255 - pr : pr, t0 = 16 * qt;
        const size_t rowbase = (size_t)b * SEQ;
        const int NT = qt + 1;
        const float NINF = -__builtin_inff();
        const f32x4* scrb = scr + (size_t)sbuf * 16384;
        _Pragma("unroll 1") for (int rp_ = 0; rp_ < 1 + (A2DUP & 1); ++rp_)
        {
            const int tid = phase_tid(wave); const int lane = tid & 63, j = lane & 15, g = lane >> 4; (void)lane; (void)j; (void)g;
            const int r16 = (tid >> 4) & 15, c4 = tid & 15;
            const u32x2 kvraw = *(const u32x2*)(PA + (rowbase + t0 + r16) * A_N + (tid < 256 ? A_K : A_V) + 4 * c4);
            const int nslots = (qt < 16) ? 0 : ((NT - w + 7) >> 3);
            const GAS bf16* kp = (const GAS bf16*)(PA + (rowbase + 16 * w + j) * A_N + A_KI + 8 * g);
            bf16x8 ring[4][2];
#pragma unroll
            for (int u = 0; u < 4; ++u) { ring[u][0] = *(const GAS bf16x8*)kp; ring[u][1] = *(const GAS bf16x8*)(kp + 32); kp += (size_t)128 * A_N; asm volatile("" : "+v"(kp)); }
            bf16x8 qb[8][2]; float wh[8]; v4u wr = (v4u){0u, 0u, 0u, 0u};
            if (qt >= 16) {
                const bf16* qrow = PA + (rowbase + t0 + j) * A_N;
#pragma unroll
                for (int h = 0; h < 8; ++h)
#pragma unroll
                    for (int ks = 0; ks < 2; ++ks) qb[h][ks] = *(const bf16x8*)(qrow + A_QI + 64 * h + 32 * ks + 8 * g);
                wr = *(const v4u*)(qrow + A_WI);
            }
            A2_FLUSH();
            if (tid < 256) {
                float k0 = bflo(kvraw.x), k1 = bfhi(kvraw.x), k2 = bflo(kvraw.y), k3 = bfhi(kvraw.y);
                float s = (k0 * k0 + k1 * k1) + (k2 * k2 + k3 * k3);
                s = xl::add8(xl::add4(xl::add2(xl::add1(s))));
                const float rs = 1.0f / sqrtf(s * (1.0f / 64.0f) + EPS);
                const f32x4 gk = *(const f32x4*)(kgain + 4 * c4);
                u32x2 o; o.x = cvtpk(k0 * rs * gk[0], k1 * rs * gk[1]); o.y = cvtpk(k2 * rs * gk[2], k3 * rs * gk[3]); *(u32x2*)(KN + (rowbase + t0 + r16) * 64 + 4 * c4) = o;
            } else {
                *(u32x2*)(VN + (rowbase + t0 + r16) * 64 + 4 * c4) = kvraw;
            }
            if (qt < 16) {
                for (int e = tid; e < 2048; e += NTHR) { const int q = e >> 7, wi = e & 127; const int nb = t0 + q + 1 - 32 * wi;
                    maskOut[(rowbase + t0 + q) * 128 + wi] = nb >= 32 ? 0xffffffffu : (nb <= 0 ? 0u : ((1u << nb) - 1u)); }
                break;
            }
            const float wsc = 0.5f * 0.35355339059327373f * 0.125f;
            wh[0] = bflo(wr.x) * wsc; wh[1] = bfhi(wr.x) * wsc; wh[2] = bflo(wr.y) * wsc; wh[3] = bfhi(wr.y) * wsc;
            wh[4] = bflo(wr.z) * wsc; wh[5] = bfhi(wr.z) * wsc; wh[6] = bflo(wr.w) * wsc; wh[7] = bfhi(wr.w) * wsc;
            bf16x8 ql[2];
#pragma unroll
            for (int ks = 0; ks < 2; ++ks) {
                float acc8[8] = {0.f, 0.f, 0.f, 0.f, 0.f, 0.f, 0.f, 0.f};
#pragma unroll
                for (int h = 0; h < 8; ++h) { const v4u qw = __builtin_bit_cast(v4u, qb[h][ks]);
                    acc8[0] += wh[h] * bflo(qw.x); acc8[1] += wh[h] * bfhi(qw.x); acc8[2] += wh[h] * bflo(qw.y); acc8[3] += wh[h] * bfhi(qw.y);
                    acc8[4] += wh[h] * bflo(qw.z); acc8[5] += wh[h] * bfhi(qw.z); acc8[6] += wh[h] * bflo(qw.w); acc8[7] += wh[h] * bfhi(qw.w); }
                v4u o; o.x = cvtpk(acc8[0], acc8[1]); o.y = cvtpk(acc8[2], acc8[3]); o.z = cvtpk(acc8[4], acc8[5]); o.w = cvtpk(acc8[6], acc8[7]);
                ql[ks] = __builtin_bit_cast(bf16x8, o);
            }
            GAS char* spw = (GAS char*)(scr + (size_t)sbuf * 16384) + (size_t)w * 64; asm volatile("" : "+s"(spw));
            const unsigned voff = (unsigned)j * 16384u + (unsigned)g * 16u;
            const unsigned toff = (unsigned)j * A2_QS + (unsigned)g * 16u + (unsigned)w * 64u;
            const int ngroups = (((NT + 7) >> 3) + 3) >> 2;
#define A2_TILE(i_, u_, STORE_) do { \
                    const int kt_ = w + 8 * (i_); \
                    const bf16x8 ka0 = ring[u_][0], ka1 = ring[u_][1]; \
                    f32x4 s = __builtin_amdgcn_mfma_f32_16x16x32_bf16(ka0, ql[0], (f32x4){0.f, 0.f, 0.f, 0.f}, 0, 0, 0); \
                    s = __builtin_amdgcn_mfma_f32_16x16x32_bf16(ka1, ql[1], s, 0, 0, 0); \
                    _Pragma("unroll") for (int h = 0; h < 8; ++h) { \
                        f32x4 a = __builtin_amdgcn_mfma_f32_16x16x32_bf16(ka0, qb[h][0], (f32x4){0.f, 0.f, 0.f, 0.f}, 0, 0, 0); \
                        a = __builtin_amdgcn_mfma_f32_16x16x32_bf16(ka1, qb[h][1], a, 0, 0, 0); \
                          \
                        _Pragma("unroll") for (int r = 0; r < 4; ++r) { float t_ = __builtin_fmaf(__builtin_fabsf(a[r]), wh[h], s[r]); asm("" : "+v"(t_)); s[r] = t_; } } \
                    if (kt_ >= qt) { asm volatile("" ::: "memory");     \
                        _Pragma("unroll") for (int r = 0; r < 4; ++r) if (kt_ > qt || 4 * g + r > j) s[r] = NINF; } \
                    __builtin_amdgcn_sched_barrier(0);        \
                    ring[u_][0] = *(const GAS bf16x8*)kp; ring[u_][1] = *(const GAS bf16x8*)(kp + 32); \
                    __builtin_amdgcn_sched_barrier(0); \
                    STORE_; \
                    kp += (size_t)128 * A_N; asm volatile("" : "+v"(kp)); } while (0)
            const int ng_lds = ngroups < 4 ? ngroups : 4;
#pragma unroll 1
            for (int gi = 0; gi < ng_lds; ++gi) {
#pragma unroll
                for (int u = 0; u < 4; ++u) A2_TILE(4 * gi + u, u, *(LAS f32x4*)(lds + A2_T + toff + (unsigned)(4 * gi + u) * 512u) = s);
            }
#pragma unroll 1
            for (int gi = 4; gi < ngroups; ++gi) {
#pragma unroll
                for (int u = 0; u < 4; ++u) A2_TILE(4 * gi + u, u, *(GAS f32x4*)(spw + (size_t)(4 * gi + u) * 512 + voff) = s);
            }
#undef A2_TILE
        }
        if (qt < 16) continue;
        asm volatile("s_waitcnt vmcnt(0)" ::: "memory");
        __syncthreads();
        _Pragma("unroll 1") for (int rp_ = 0; rp_ < 1 + ((A2DUP >> 1) & 1); ++rp_)
        {
            const int tid = phase_tid(wave); const int lane = tid & 63, hq0 = lane >> 5, m0 = lane & 31, q0 = 2 * w + hq0;
#define A2_SQ ((const GAS f32x4*)scrb + (size_t)q0 * 1024 + m0)
            const int imax = (NT + 7) >> 3;
            f32x4 sc[32];
            {
                const LAS f32x4* tq = (const LAS f32x4*)(lds + A2_T + (unsigned)q0 * A2_QS) + m0;
#pragma unroll
                for (int gi = 0; gi < 8; ++gi) {
                    if (4 * gi < imax) {
#pragma unroll
                        for (int ii = 0; ii < 4; ++ii) { if (gi < 4) sc[4 * gi + ii] = tq[(4 * gi + ii) * 32]; else sc[4 * gi + ii] = A2_SQ[(4 * gi + ii) * 32]; }
                    } else {
#pragma unroll
                        for (int ii = 0; ii < 4; ++ii) sc[4 * gi + ii] = (f32x4){NINF, NINF, NINF, NINF};
                    }
                }
            }
            asm volatile("s_waitcnt lgkmcnt(0)" ::: "memory");
            __syncthreads();
            float mx = NINF, mn = __builtin_inff();
#pragma unroll
            for (int gi = 0; gi < 8; ++gi) {
                if (4 * gi < imax) {
#pragma unroll
                    for (int ii = 0; ii < 4; ++ii) { const int i = 4 * gi + ii; const f32x4 v = sc[i];
                        mx = fmaxf(fmaxf(mx, fmaxf(v[0], v[1])), fmaxf(v[2], v[3]));
                        if (i >= imax - 2) {
#pragma unroll
                            for (int r = 0; r < 4; ++r) mn = fminf(mn, v[r] == NINF ? __builtin_inff() : v[r]);
                        } else mn = fminf(fminf(mn, fminf(v[0], v[1])), fminf(v[2], v[3]));
                    }
                }
            }
            mx = xl::max16(xl::max8(xl::max4(xl::max2(xl::max1(mx))))); mn = xl::min16(xl::min8(xl::min4(xl::min2(xl::min1(mn)))));
            float lo = mn, hi = mx + (fabsf(mx) * 1e-6f + 1e-30f);
            int clo = t0 + q0 + 1, chi = 0; bool done = false, tie = false;
            for (int it = 0; it < 96; ++it) {
                if (!done && clo - chi <= A2_CAP) done = true;
                const float mid = 0.5f * (lo + hi);
                if (!done && !(mid > lo && mid < hi)) { tie = true; done = true; }
                if (__all(done)) break;
                int c0 = 0, c1 = 0, c2 = 0, c3 = 0;
#define A2_CNT16(A_) do { unsigned long long m0_, m1_, m2_; \
                    asm("v_cmp_ge_f32_e64 %[m0], %[a0], %[mid]\n\tv_cmp_ge_f32_e64 %[m1], %[a1], %[mid]\n\tv_cmp_ge_f32_e64 %[m2], %[a2], %[mid]\n\tv_addc_co_u32_e64 %[c0], %[m0], 0, %[c0], %[m0]\n\tv_cmp_ge_f32_e64 %[m0], %[a3], %[mid]\n\tv_addc_co_u32_e64 %[c1], %[m1], 0, %[c1], %[m1]\n\tv_cmp_ge_f32_e64 %[m1], %[a4], %[mid]\n\tv_addc_co_u32_e64 %[c2], %[m2], 0, %[c2], %[m2]\n\tv_cmp_ge_f32_e64 %[m2], %[a5], %[mid]\n\tv_addc_co_u32_e64 %[c3], %[m0], 0, %[c3], %[m0]\n\tv_cmp_ge_f32_e64 %[m0], %[a6], %[mid]\n\tv_addc_co_u32_e64 %[c0], %[m1], 0, %[c0], %[m1]\n\tv_cmp_ge_f32_e64 %[m1], %[a7], %[mid]\n\tv_addc_co_u32_e64 %[c1], %[m2], 0, %[c1], %[m2]\n\tv_cmp_ge_f32_e64 %[m2], %[a8], %[mid]\n\tv_addc_co_u32_e64 %[c2], %[m0], 0, %[c2], %[m0]\n\tv_cmp_ge_f32_e64 %[m0], %[a9], %[mid]\n\tv_addc_co_u32_e64 %[c3], %[m1], 0, %[c3], %[m1]\n\tv_cmp_ge_f32_e64 %[m1], %[a10], %[mid]\n\tv_addc_co_u32_e64 %[c0], %[m2], 0, %[c0], %[m2]\n\tv_cmp_ge_f32_e64 %[m2], %[a11], %[mid]\n\tv_addc_co_u32_e64 %[c1], %[m0], 0, %[c1], %[m0]\n\tv_cmp_ge_f32_e64 %[m0], %[a12], %[mid]\n\tv_addc_co_u32_e64 %[c2], %[m1], 0, %[c2], %[m1]\n\tv_cmp_ge_f32_e64 %[m1], %[a13], %[mid]\n\tv_addc_co_u32_e64 %[c3], %[m2], 0, %[c3], %[m2]\n\tv_cmp_ge_f32_e64 %[m2], %[a14], %[mid]\n\tv_addc_co_u32_e64 %[c0], %[m0], 0, %[c0], %[m0]\n\tv_cmp_ge_f32_e64 %[m0], %[a15], %[mid]\n\tv_addc_co_u32_e64 %[c1], %[m1], 0, %[c1], %[m1]\n\tv_addc_co_u32_e64 %[c2], %[m2], 0, %[c2], %[m2]\n\tv_addc_co_u32_e64 %[c3], %[m0], 0, %[c3], %[m0]" \
                        : [c0] "+v"(c0), [c1] "+v"(c1), [c2] "+v"(c2), [c3] "+v"(c3), [m0] "=&s"(m0_), [m1] "=&s"(m1_), [m2] "=&s"(m2_) \
                        : [a0] "v"(A_[0][0]), [a1] "v"(A_[0][1]), [a2] "v"(A_[0][2]), [a3] "v"(A_[0][3]), [a4] "v"(A_[1][0]), [a5] "v"(A_[1][1]), [a6] "v"(A_[1][2]), [a7] "v"(A_[1][3]), [a8] "v"(A_[2][0]), [a9] "v"(A_[2][1]), [a10] "v"(A_[2][2]), [a11] "v"(A_[2][3]), [a12] "v"(A_[3][0]), [a13] "v"(A_[3][1]), [a14] "v"(A_[3][2]), [a15] "v"(A_[3][3]), [mid] "v"(mid)); } while (0)
#pragma unroll
                for (int gi = 0; gi < 8; ++gi) {
                    if (4 * gi < imax) { const f32x4 (&G_)[4] = *(const f32x4 (*)[4])&sc[4 * gi]; A2_CNT16(G_); }
                }
#undef A2_CNT16
                int c = (c0 + c1) + (c2 + c3);
                c = xl::iadd16(xl::iadd8(xl::iadd4(xl::iadd2(xl::iadd1(c)))));
                if (!done) { if (c >= 256) { lo = mid; clo = c; } else { hi = mid; chi = c; } }
            }
            const int need = 256 - chi;
            const int lane2 = phase_tid(wave) & 63, m = lane2 & 31, q = 2 * w + (lane2 >> 5);
            const bool bigtie = tie && (clo - chi > A2_CAP);
            int J = -1;
            if (__any(bigtie)) {
                { GAS f32x4* sqw = (GAS f32x4*)A2_SQ;
#pragma unroll
                for (int i = 0; i < 16; ++i) sqw[i * 32] = sc[i]; }
                asm volatile("s_waitcnt vmcnt(0)" ::: "memory");
                int jlo = -1, jhi = SEQ - 1;
                for (int it = 0; it < 13; ++it) {
                    const int jm = (jlo + jhi) >> 1;
                    int c = 0;
#pragma unroll 1
                    for (int i = 0; i < 32; ++i) {
                        const f32x4 s4 = A2_SQ[i * 32];
#pragma unroll
                        for (int r = 0; r < 4; ++r) c += (s4[r] == lo && (4 * (i * 32 + m) + r) <= jm) ? 1 : 0;
                    }
                    c = xl::iadd16(xl::iadd8(xl::iadd4(xl::iadd2(xl::iadd1(c)))));
                    if (jhi - jlo > 1) { if (c >= need) jhi = jm; else jlo = jm; }
                }
                J = jhi;
            }
            int ctot = 0;
            {
                const float loc = bigtie ? hi : lo;
                unsigned bcw[4] = {0u, 0u, 0u, 0u}; int ccn = 0;
#pragma unroll
                for (int gi = 0; gi < 8; ++gi) {
                    if (4 * gi < imax) {
                        unsigned bs16, bx16;
                        { unsigned long long m0_, m1_, m2_;
                          asm("v_cmp_ge_f32_e64 %[m0], %[a15], %[hi]\n\tv_cmp_ge_f32_e64 %[m1], %[a15], %[loc]\n\tv_cmp_ge_f32_e64 %[m2], %[a14], %[hi]\n\tv_addc_co_u32_e64 %[bs], %[m0], 0, 0, %[m0]\n\tv_cmp_ge_f32_e64 %[m0], %[a14], %[loc]\n\tv_addc_co_u32_e64 %[bx], %[m1], 0, 0, %[m1]\n\tv_cmp_ge_f32_e64 %[m1], %[a13], %[hi]\n\tv_addc_co_u32_e64 %[bs], %[m2], %[bs], %[bs], %[m2]\n\tv_cmp_ge_f32_e64 %[m2], %[a13], %[loc]\n\tv_addc_co_u32_e64 %[bx], %[m0], %[bx], %[bx], %[m0]\n\tv_cmp_ge_f32_e64 %[m0], %[a12], %[hi]\n\tv_addc_co_u32_e64 %[bs], %[m1], %[bs], %[bs], %[m1]\n\tv_cmp_ge_f32_e64 %[m1], %[a12], %[loc]\n\tv_addc_co_u32_e64 %[bx], %[m2], %[bx], %[bx], %[m2]\n\tv_cmp_ge_f32_e64 %[m2], %[a11], %[hi]\n\tv_addc_co_u32_e64 %[bs], %[m0], %[bs], %[bs], %[m0]\n\tv_cmp_ge_f32_e64 %[m0], %[a11], %[loc]\n\tv_addc_co_u32_e64 %[bx], %[m1], %[bx], %[bx], %[m1]\n\tv_cmp_ge_f32_e64 %[m1], %[a10], %[hi]\n\tv_addc_co_u32_e64 %[bs], %[m2], %[bs], %[bs], %[m2]\n\tv_cmp_ge_f32_e64 %[m2], %[a10], %[loc]\n\tv_addc_co_u32_e64 %[bx], %[m0], %[bx], %[bx], %[m0]\n\tv_cmp_ge_f32_e64 %[m0], %[a9], %[hi]\n\tv_addc_co_u32_e64 %[bs], %[m1], %[bs], %[bs], %[m1]\n\tv_cmp_ge_f32_e64 %[m1], %[a9], %[loc]\n\tv_addc_co_u32_e64 %[bx], %[m2], %[bx], %[bx], %[m2]\n\tv_cmp_ge_f32_e64 %[m2], %[a8], %[hi]\n\tv_addc_co_u32_e64 %[bs], %[m0], %[bs], %[bs], %[m0]\n\tv_cmp_ge_f32_e64 %[m0], %[a8], %[loc]\n\tv_addc_co_u32_e64 %[bx], %[m1], %[bx], %[bx], %[m1]\n\tv_cmp_ge_f32_e64 %[m1], %[a7], %[hi]\n\tv_addc_co_u32_e64 %[bs], %[m2], %[bs], %[bs], %[m2]\n\tv_cmp_ge_f32_e64 %[m2], %[a7], %[loc]\n\tv_addc_co_u32_e64 %[bx], %[m0], %[bx], %[bx], %[m0]\n\tv_cmp_ge_f32_e64 %[m0], %[a6], %[hi]\n\tv_addc_co_u32_e64 %[bs], %[m1], %[bs], %[bs], %[m1]\n\tv_cmp_ge_f32_e64 %[m1], %[a6], %[loc]\n\tv_addc_co_u32_e64 %[bx], %[m2], %[bx], %[bx], %[m2]\n\tv_cmp_ge_f32_e64 %[m2], %[a5], %[hi]\n\tv_addc_co_u32_e64 %[bs], %[m0], %[bs], %[bs], %[m0]\n\tv_cmp_ge_f32_e64 %[m0], %[a5], %[loc]\n\tv_addc_co_u32_e64 %[bx], %[m1], %[bx], %[bx], %[m1]\n\tv_cmp_ge_f32_e64 %[m1], %[a4], %[hi]\n\tv_addc_co_u32_e64 %[bs], %[m2], %[bs], %[bs], %[m2]\n\tv_cmp_ge_f32_e64 %[m2], %[a4], %[loc]\n\tv_addc_co_u32_e64 %[bx], %[m0], %[bx], %[bx], %[m0]\n\tv_cmp_ge_f32_e64 %[m0], %[a3], %[hi]\n\tv_addc_co_u32_e64 %[bs], %[m1], %[bs], %[bs], %[m1]\n\tv_cmp_ge_f32_e64 %[m1], %[a3], %[loc]\n\tv_addc_co_u32_e64 %[bx], %[m2], %[bx], %[bx], %[m2]\n\tv_cmp_ge_f32_e64 %[m2], %[a2], %[hi]\n\tv_addc_co_u32_e64 %[bs], %[m0], %[bs], %[bs], %[m0]\n\tv_cmp_ge_f32_e64 %[m0], %[a2], %[loc]\n\tv_addc_co_u32_e64 %[bx], %[m1], %[bx], %[bx], %[m1]\n\tv_cmp_ge_f32_e64 %[m1], %[a1], %[hi]\n\tv_addc_co_u32_e64 %[bs], %[m2], %[bs], %[bs], %[m2]\n\tv_cmp_ge_f32_e64 %[m2], %[a1], %[loc]\n\tv_addc_co_u32_e64 %[bx], %[m0], %[bx], %[bx], %[m0]\n\tv_cmp_ge_f32_e64 %[m0], %[a0], %[hi]\n\tv_addc_co_u32_e64 %[bs], %[m1], %[bs], %[bs], %[m1]\n\tv_cmp_ge_f32_e64 %[m1], %[a0], %[loc]\n\tv_addc_co_u32_e64 %[bx], %[m2], %[bx], %[bx], %[m2]\n\tv_addc_co_u32_e64 %[bs], %[m0], %[bs], %[bs], %[m0]\n\tv_addc_co_u32_e64 %[bx], %[m1], %[bx], %[bx], %[m1]"
                              : [bs] "=&v"(bs16), [bx] "=&v"(bx16), [m0] "=&s"(m0_), [m1] "=&s"(m1_), [m2] "=&s"(m2_)
                              : [a0] "v"(sc[4 * gi + 0][0]), [a1] "v"(sc[4 * gi + 0][1]), [a2] "v"(sc[4 * gi + 0][2]), [a3] "v"(sc[4 * gi + 0][3]), [a4] "v"(sc[4 * gi + 1][0]), [a5] "v"(sc[4 * gi + 1][1]), [a6] "v"(sc[4 * gi + 1][2]), [a7] "v"(sc[4 * gi + 1][3]), [a8] "v"(sc[4 * gi + 2][0]), [a9] "v"(sc[4 * gi + 2][1]), [a10] "v"(sc[4 * gi + 2][2]), [a11] "v"(sc[4 * gi + 2][3]), [a12] "v"(sc[4 * gi + 3][0]), [a13] "v"(sc[4 * gi + 3][1]), [a14] "v"(sc[4 * gi + 3][2]), [a15] "v"(sc[4 * gi + 3][3]), [hi] "v"(hi), [loc] "v"(loc)); }
                        const unsigned bc16 = bx16 & ~bs16;
#pragma unroll
                        for (int ii = 0; ii < 4; ++ii) {
                            const int i = 4 * gi + ii;
                            const unsigned bs = (bs16 >> (4 * ii)) & 15u, bc = (bc16 >> (4 * ii)) & 15u;
                            unsigned v = bs << (4 * (m & 7));
                            v = xl::or4(xl::or2(xl::or1(v)));
                            if ((m & 7) == 0) mask32[q * 128 + 4 * i + (m >> 3)] = v;
                            bcw[gi >> 1] |= bc << (16 * (gi & 1) + 4 * ii); ccn += __popc(bc);
                        }
                    } else {
#pragma unroll
                        for (int ii = 0; ii < 4; ++ii) if ((m & 7) == 0) mask32[q * 128 + 4 * (4 * gi + ii) + (m >> 3)] = 0u;
                    }
                }
                {
                    int ln_ = lane2; asm volatile("" : "+v"(ln_));
                    const int mm_ = ln_ & 31; int pre_ = ccn;
                    pre_ = xl::scan32(pre_); (void)mm_;
                    ctot = __builtin_amdgcn_ds_bpermute((ln_ | 31) << 2, pre_);
                    unsigned pos = (unsigned)(pre_ - ccn);
#pragma unroll
                    for (int gi = 0; gi < 8; ++gi) {
                        if (4 * gi < imax) {
#pragma unroll
                            for (int ii = 0; ii < 4; ++ii) {
                                const int i = 4 * gi + ii; const unsigned bc = (bcw[gi >> 1] >> (16 * (gi & 1) + 4 * ii)) & 15u;
                                if (bc) {
#pragma unroll
                                    for (int r = 0; r < 4; ++r) if ((bc >> r) & 1u) {
                                        if (pos < (unsigned)A2_CAP) {
                                            const unsigned sb_ = __float_as_uint(sc[i][r] + 0.0f), sk_ = sb_ ^ ((unsigned)((int)sb_ >> 31) | 0x80000000u);
                                            candk[q * A2_CAP + pos] = ((unsigned long long)sk_ << 32) | (unsigned long long)(~(unsigned)(4 * (i * 32 + m) + r)); }
                                        ++pos;
                                    }
                                }
                            }
                        }
                    }
                }
            }
            LDS_WAIT(); asm volatile("" ::: "memory");
            if (__any(bigtie)) {
#pragma unroll 1
                for (int i = 0; i < 32; ++i) {
                    const f32x4 s4 = A2_SQ[i * 32];
#pragma unroll
                    for (int r = 0; r < 4; ++r) { const int idx = 4 * (i * 32 + m) + r;
                        if (bigtie && s4[r] == lo && idx <= J) atomicOr((unsigned*)(mask32 + q * 128 + (idx >> 5)), 1u << (idx & 31)); }
                }
            }
            {
                const int C = min(ctot, A2_CAP), nd = bigtie ? 0 : need;
                LAS unsigned long long* cl = candk + q * A2_CAP;
                unsigned long long z_ = 0ull; asm volatile("" : "+v"(z_));
                if (m >= C) cl[m] = z_;
                if (m + 32 >= C) cl[m + 32] = z_;
                LDS_WAIT(); asm volatile("" ::: "memory");
                const unsigned long long me0 = cl[m], me1 = cl[m + 32];
                int rank0 = 0, rank1 = 0;
                for (int o0 = 0; o0 < C; o0 += 8) {
                    unsigned long long e_[8];
#pragma unroll
                    for (int k = 0; k < 8; ++k) e_[k] = cl[o0 + k];
                    unsigned long long m0_, m1_, m2_;
                    asm("v_cmp_gt_u64_e64 %[m0], %[o0], %[me0]\n\tv_cmp_gt_u64_e64 %[m1], %[o0], %[me1]\n\tv_cmp_gt_u64_e64 %[m2], %[o1], %[me0]\n\tv_addc_co_u32_e64 %[r0], %[m0], 0, %[r0], %[m0]\n\tv_cmp_gt_u64_e64 %[m0], %[o1], %[me1]\n\tv_addc_co_u32_e64 %[r1], %[m1], 0, %[r1], %[m1]\n\tv_cmp_gt_u64_e64 %[m1], %[o2], %[me0]\n\tv_addc_co_u32_e64 %[r0], %[m2], 0, %[r0], %[m2]\n\tv_cmp_gt_u64_e64 %[m2], %[o2], %[me1]\n\tv_addc_co_u32_e64 %[r1], %[m0], 0, %[r1], %[m0]\n\tv_cmp_gt_u64_e64 %[m0], %[o3], %[me0]\n\tv_addc_co_u32_e64 %[r0], %[m1], 0, %[r0], %[m1]\n\tv_cmp_gt_u64_e64 %[m1], %[o3], %[me1]\n\tv_addc_co_u32_e64 %[r1], %[m2], 0, %[r1], %[m2]\n\tv_cmp_gt_u64_e64 %[m2], %[o4], %[me0]\n\tv_addc_co_u32_e64 %[r0], %[m0], 0, %[r0], %[m0]\n\tv_cmp_gt_u64_e64 %[m0], %[o4], %[me1]\n\tv_addc_co_u32_e64 %[r1], %[m1], 0, %[r1], %[m1]\n\tv_cmp_gt_u64_e64 %[m1], %[o5], %[me0]\n\tv_addc_co_u32_e64 %[r0], %[m2], 0, %[r0], %[m2]\n\tv_cmp_gt_u64_e64 %[m2], %[o5], %[me1]\n\tv_addc_co_u32_e64 %[r1], %[m0], 0, %[r1], %[m0]\n\tv_cmp_gt_u64_e64 %[m0], %[o6], %[me0]\n\tv_addc_co_u32_e64 %[r0], %[m1], 0, %[r0], %[m1]\n\tv_cmp_gt_u64_e64 %[m1], %[o6], %[me1]\n\tv_addc_co_u32_e64 %[r1], %[m2], 0, %[r1], %[m2]\n\tv_cmp_gt_u64_e64 %[m2], %[o7], %[me0]\n\tv_addc_co_u32_e64 %[r0], %[m0], 0, %[r0], %[m0]\n\tv_cmp_gt_u64_e64 %[m0], %[o7], %[me1]\n\tv_addc_co_u32_e64 %[r1], %[m1], 0, %[r1], %[m1]\n\tv_addc_co_u32_e64 %[r0], %[m2], 0, %[r0], %[m2]\n\tv_addc_co_u32_e64 %[r1], %[m0], 0, %[r1], %[m0]"
                        : [r0] "+v"(rank0), [r1] "+v"(rank1), [m0] "=&s"(m0_), [m1] "=&s"(m1_), [m2] "=&s"(m2_)
                        : [o0] "v"(e_[0]), [o1] "v"(e_[1]), [o2] "v"(e_[2]), [o3] "v"(e_[3]), [o4] "v"(e_[4]), [o5] "v"(e_[5]), [o6] "v"(e_[6]), [o7] "v"(e_[7]), [me0] "v"(me0), [me1] "v"(me1));
                }
                if (m < C && rank0 < nd) { const int idx = (int)~(unsigned)me0; atomicOr((unsigned*)(mask32 + q * 128 + (idx >> 5)), 1u << (idx & 31)); }
                if (m + 32 < C && rank1 < nd) { const int idx = (int)~(unsigned)me1; atomicOr((unsigned*)(mask32 + q * 128 + (idx >> 5)), 1u << (idx & 31)); }
            }
            LDS_WAIT(); asm volatile("" ::: "memory");
            pm0 = mask32[q * 128 + m]; pm1 = mask32[q * 128 + m + 32]; pm2 = mask32[q * 128 + m + 64]; pm3 = mask32[q * 128 + m + 96]; prow = (int)(rowbase + t0 + q);
            if (m == 0) ccnt[q] = 0u;
            LDS_WAIT(); asm volatile("" ::: "memory");
        }
        sbuf ^= 1;
      }
    }
    A2_FLUSH();
    __syncthreads();
}
#undef A2_FLUSH
#undef A2_SQ

constexpr int A3_BIAS = 0, A3_GAIN = 8448, A3_WAVE0 = 8704, A3_WSTRIDE = 10240, A3_VS = 144;
__device__ __forceinline__ void phase_a3(ldsp lds, const bf16* PA, const bf16* KN, const bf16* VN, const unsigned* maskIn, bf16* O, const float* qgain, const float* rel_bias, int gw, int NGW, int wave) {
    const int tid = phase_tid(wave);
    const int lane = tid & 63, w = wave, j = lane & 15, g = lane >> 4;
    LAS float* biasT = (LAS float*)(lds + A3_BIAS);
    for (int e = tid; e < 129 * 16; e += NTHR) { const int n = e >> 4, h = e & 15; biasT[e] = rel_bias[t5_bucket(n) * 16 + h] * LOG2E; }
    LAS float* gainT = (LAS float*)(lds + A3_GAIN);
    if (tid < 64) gainT[tid] = qgain[tid];
    __syncthreads();
    const ldsp selb = lds + A3_WAVE0 + w * A3_WSTRIDE;
    const ldsp Vl = lds + A3_WAVE0 + w * A3_WSTRIDE + 1024;
    const ldsp Kl = Vl + 32 * A3_VS;
    const float QS = 0.125f * LOG2E;
    unsigned long long mw_n = 0ull; v4u r0_n = (v4u){0u, 0u, 0u, 0u}, r1_n = (v4u){0u, 0u, 0u, 0u};
    const unsigned moff = (unsigned)lane * 8u, qoff = (unsigned)(64 * j + 8 * g) * 2u, koff = (unsigned)g * 16u, voff = (unsigned)(lane & 7) * 16u;
#define A3_REQM(qq) do { unsigned mo_ = moff; asm volatile("" : "+v"(mo_));     \
        mw_n = *(const unsigned long long*)((const char*)(maskIn + (size_t)(qq) * 128) + mo_); } while (0)
#define A3_REQQ(qq) do { unsigned qo_ = qoff; asm volatile("" : "+v"(qo_)); const char* qp_ = (const char*)(PA + (size_t)(qq) * A_N); r0_n = *(const v4u*)(qp_ + qo_); r1_n = *(const v4u*)(qp_ + qo_ + 64); } while (0)
#define A3_BUILD(mw_, sel_, nk_, tq_, nf_) do { const int cnt_ = __popcll(mw_); int pre_ = cnt_; int ln_ = lane; asm volatile("" : "+v"(ln_));     \
        pre_ = xl::scan64(pre_);        \
        nk_ = __builtin_amdgcn_readlane(pre_, 63); \
          \
        { const int lim_ = (tq_) - 127; nf_ = 0; \
          if (lim_ > 0) { const int L_ = lim_ >> 6; const int ex_ = __builtin_amdgcn_readlane(pre_ - cnt_, L_); \
              const unsigned wl_ = (unsigned)__builtin_amdgcn_readlane((int)(unsigned)(mw_), L_), wh_ = (unsigned)__builtin_amdgcn_readlane((int)(unsigned)((mw_) >> 32), L_); \
              const unsigned long long ww_ = ((unsigned long long)wh_ << 32) | wl_; nf_ = ex_ + __popcll(ww_ & ((1ull << (lim_ & 63)) - 1ull)); } } \
        { int off_ = pre_ - cnt_; unsigned long long m_ = (mw_); while (m_) { const int bpos_ = __ffsll((long long)m_) - 1; (sel_)[off_++] = (unsigned short)(64 * ln_ + bpos_); m_ &= m_ - 1; } } \
        for (int e_ = nk_ + ln_; e_ < 256; e_ += 64) (sel_)[e_] = 0; } while (0)
    v4u kb[4][4]; v4u vb[4][4];
#define A3_LOADKV(sel_, Kb_, Vb_, c, bf) do { \
        _Pragma("unroll") for (int m = 0; m < 4; ++m) { const unsigned vo = (unsigned)(sel_)[32 * (c) + 8 * m + (lane >> 3)] * 128u + voff; kb[bf][m] = *(const v4u*)((Kb_) + vo); vb[bf][m] = *(const v4u*)((Vb_) + vo); } } while (0)
    int nkeys_n = 0, nfar_n = 0;
    const float b128 = biasT[128 * 16 + j];
    if (gw < NTOK) {
        A3_REQM(gw); A3_REQQ(gw);
        LAS unsigned short* s0_ = (LAS unsigned short*)selb;
        A3_BUILD(mw_n, s0_, nkeys_n, (gw & (SEQ - 1)), nfar_n);
        LDS_WAIT(); asm volatile("" ::: "memory");
        const int b0_ = gw >> 12; const char* Kb0 = (const char*)(KN + (size_t)b0_ * SEQ * 64); const char* Vb0 = (const char*)(VN + (size_t)b0_ * SEQ * 64);
        A3_LOADKV(s0_, Kb0, Vb0, 0, 0); A3_LOADKV(s0_, Kb0, Vb0, 1, 1); A3_LOADKV(s0_, Kb0, Vb0, 2, 2);
    }
    int par = 0;
#pragma unroll 1
    for (int qi = gw; qi < NTOK; qi += NGW) {
        const int b = qi >> 12, t = qi & (SEQ - 1);
        const char* Kb = (const char*)(KN + (size_t)b * SEQ * 64); const char* Vb = (const char*)(VN + (size_t)b * SEQ * 64);
        const v4u r0 = r0_n, r1 = r1_n; const int nkeys = nkeys_n, nfar = nfar_n;
        LAS unsigned short* sel = (LAS unsigned short*)(selb + 512 * par); LAS unsigned short* seln = (LAS unsigned short*)(selb + 512 * (par ^ 1));
        const int qn = (qi + NGW < NTOK) ? qi + NGW : qi;
        const int bn = qn >> 12; const char* Kbn = (const char*)(KN + (size_t)bn * SEQ * 64); const char* Vbn = (const char*)(VN + (size_t)bn * SEQ * 64);
        A3_REQM(qn);
        bf16x8 qf0, qf1;
        {
            const f32x4 gq0 = *(const LAS f32x4*)(gainT + 8 * g), gq1 = *(const LAS f32x4*)(gainT + 8 * g + 4), gq2 = *(const LAS f32x4*)(gainT + 32 + 8 * g), gq3 = *(const LAS f32x4*)(gainT + 32 + 8 * g + 4);
            float x[16] = {bflo(r0.x), bfhi(r0.x), bflo(r0.y), bfhi(r0.y), bflo(r0.z), bfhi(r0.z), bflo(r0.w), bfhi(r0.w),
                           bflo(r1.x), bfhi(r1.x), bflo(r1.y), bfhi(r1.y), bflo(r1.z), bfhi(r1.z), bflo(r1.w), bfhi(r1.w)};
            float s = 0.f;
#pragma unroll
            for (int e = 0; e < 16; ++e) s += x[e] * x[e];
            s = xl::add32(xl::add16(s));
            const float rs = QS / sqrtf(s * (1.0f / 64.0f) + EPS);
            v4u a, c;
            a.x = cvtpk(x[0] * rs * gq0[0], x[1] * rs * gq0[1]); a.y = cvtpk(x[2] * rs * gq0[2], x[3] * rs * gq0[3]); a.z = cvtpk(x[4] * rs * gq1[0], x[5] * rs * gq1[1]); a.w = cvtpk(x[6] * rs * gq1[2], x[7] * rs * gq1[3]);
            c.x = cvtpk(x[8] * rs * gq2[0], x[9] * rs * gq2[1]); c.y = cvtpk(x[10] * rs * gq2[2], x[11] * rs * gq2[3]); c.z = cvtpk(x[12] * rs * gq3[0], x[13] * rs * gq3[1]); c.w = cvtpk(x[14] * rs * gq3[2], x[15] * rs * gq3[3]);
            qf0 = __builtin_bit_cast(bf16x8, a); qf1 = __builtin_bit_cast(bf16x8, c);
        }
        f32x4 o[4]; float lsum = 0.f;
#pragma unroll
        for (int nd = 0; nd < 4; ++nd) o[nd] = (f32x4){0.f, 0.f, 0.f, 0.f};
#pragma unroll
        for (int c = 0; c < 8; ++c) {
            if (c == 4) { A3_BUILD(mw_n, seln, nkeys_n, (qn & (SEQ - 1)), nfar_n); LDS_WAIT(); asm volatile("" ::: "memory"); }
            if (c == 6) A3_REQQ(qn);
            if (c < 5) A3_LOADKV(sel, Kb, Vb, c + 3, (c + 3) & 3);
            else A3_LOADKV(seln, Kbn, Vbn, c - 5, (c + 3) & 3);
#pragma unroll
            for (int m = 0; m < 4; ++m) { *(LAS v4u*)(Kl + (8 * m + (lane >> 3)) * A3_VS + 16 * (lane & 7)) = kb[c & 3][m]; *(LAS v4u*)(Vl + (8 * m + (lane >> 3)) * A3_VS + 16 * (lane & 7)) = vb[c & 3][m]; }
            LDS_WAIT(); asm volatile("" ::: "memory");
            bf16x8 vfr[4];
#pragma unroll
            for (int nd = 0; nd < 4; ++nd) { const ldsp a0 = Vl + (4 * g + (j >> 2)) * A3_VS + (16 * nd + 4 * (j & 3)) * 2; vfr[nd] = cat8(lds_tr(a0), lds_tr(a0 + 16 * A3_VS)); }
            asm volatile("" ::: "memory");
            f32x4 pr[2];
            if (32 * c + 32 <= nfar) {
#pragma unroll
            for (int tt = 0; tt < 2; ++tt) {
                const bf16x8 kf0 = *(const LAS bf16x8*)(Kl + (16 * tt + j) * A3_VS + 16 * g), kf1 = *(const LAS bf16x8*)(Kl + (16 * tt + j) * A3_VS + 64 + 16 * g);
                f32x4 s = __builtin_amdgcn_mfma_f32_16x16x32_bf16(kf0, qf0, (f32x4){0.f, 0.f, 0.f, 0.f}, 0, 0, 0);
                s = __builtin_amdgcn_mfma_f32_16x16x32_bf16(kf1, qf1, s, 0, 0, 0);
                const float p0 = __builtin_amdgcn_exp2f(s[0] + b128), p1 = __builtin_amdgcn_exp2f(s[1] + b128), p2 = __builtin_amdgcn_exp2f(s[2] + b128), p3 = __builtin_amdgcn_exp2f(s[3] + b128);
                lsum += (p0 + p1) + (p2 + p3);
                pr[tt] = (f32x4){p0, p1, p2, p3};
            }
            } else {
#pragma unroll
            for (int tt = 0; tt < 2; ++tt) {
                const bf16x8 kf0 = *(const LAS bf16x8*)(Kl + (16 * tt + j) * A3_VS + 16 * g), kf1 = *(const LAS bf16x8*)(Kl + (16 * tt + j) * A3_VS + 64 + 16 * g);
                f32x4 s = __builtin_amdgcn_mfma_f32_16x16x32_bf16(kf0, qf0, (f32x4){0.f, 0.f, 0.f, 0.f}, 0, 0, 0);
                s = __builtin_amdgcn_mfma_f32_16x16x32_bf16(kf1, qf1, s, 0, 0, 0);
                const int kbase = 32 * c + 16 * tt + 4 * g;
                const u32x2 iw = *(const LAS u32x2*)(sel + kbase);
                const int i0 = iw.x & 0xffff, i1 = iw.x >> 16, i2 = iw.y & 0xffff, i3 = iw.y >> 16;
                float p0 = __builtin_amdgcn_exp2f(s[0] + biasT[min(t - i0, 128) * 16 + j]);
                float p1 = __builtin_amdgcn_exp2f(s[1] + biasT[min(t - i1, 128) * 16 + j]);
                float p2 = __builtin_amdgcn_exp2f(s[2] + biasT[min(t - i2, 128) * 16 + j]);
                float p3 = __builtin_amdgcn_exp2f(s[3] + biasT[min(t - i3, 128) * 16 + j]);
                if (kbase + 0 >= nkeys) p0 = 0.f; if (kbase + 1 >= nkeys) p1 = 0.f; if (kbase + 2 >= nkeys) p2 = 0.f; if (kbase + 3 >= nkeys) p3 = 0.f;
                lsum += (p0 + p1) + (p2 + p3);
                pr[tt] = (f32x4){p0, p1, p2, p3};
            }
            }
            {
                v4u pw; pw.x = cvtpk(pr[0][0], pr[0][1]); pw.y = cvtpk(pr[0][2], pr[0][3]); pw.z = cvtpk(pr[1][0], pr[1][1]); pw.w = cvtpk(pr[1][2], pr[1][3]);
                const bf16x8 pfrag = __builtin_bit_cast(bf16x8, pw);
#pragma unroll
                for (int nd = 0; nd < 4; ++nd) o[nd] = __builtin_amdgcn_mfma_f32_16x16x32_bf16(vfr[nd], pfrag, o[nd], 0, 0, 0);
            }
            LDS_WAIT(); asm volatile("" ::: "memory");
        }
        lsum = xl::add32(xl::add16(lsum));
        const float il = 1.0f / lsum;
        char* op = (char*)(O + (size_t)qi * DM); unsigned ooff = (unsigned)(64 * j + 4 * g) * 2u; asm volatile("" : "+v"(ooff));
#pragma unroll
        for (int nd = 0; nd < 4; ++nd) { u32x2 wv; wv.x = cvtpk(o[nd][0] * il, o[nd][1] * il); wv.y = cvtpk(o[nd][2] * il, o[nd][3] * il); *(u32x2*)(op + ooff + 32 * nd) = wv; }
        par ^= 1;
    }
#undef A3_LOADKV
#undef A3_BUILD
#undef A3_REQM
#undef A3_REQQ
    __syncthreads();
}

constexpr int B2_BIAS = 0, B2_K = 8192, B2_V = 8192 + 36864, B2_KS = 144, B2_GAIN = 8192 + 2 * 36864;
__device__ __forceinline__ void phase_b2(ldsp lds, const bf16* PB, bf16* O, const float* qgain, const float* kgain, const float* sinks, const float* rel_bias, int vcu, int G, int wave) {
    const int tid = phase_tid(wave);
    const int lane = tid & 63, w = wave, r32 = lane & 31, hh = lane >> 5, g16 = (lane >> 4) & 1, i16 = lane & 15;
    LAS float* biasT = (LAS float*)(lds + B2_BIAS);
    for (int e = tid; e < 128 * 16; e += NTHR) { const int n = e & 127, h = e >> 7; biasT[e] = rel_bias[t5_bucket(n) * 16 + h] * LOG2E; }
    LAS float* gT = (LAS float*)(lds + B2_GAIN);
    if (tid < 64) { gT[tid] = qgain[tid]; gT[64 + tid] = kgain[tid]; } if (tid < 16) gT[128 + tid] = sinks[tid];
    const ldsp Kl = lds + B2_K, Vl = lds + B2_V;
    const float QS = 0.125f * LOG2E;
    v4u kreg[4], vreg[4];
#define B2_LOADKV(uu) do { const int nb_ = (uu) & 31, kvh_ = ((uu) >> 5) & 3, b_ = (uu) >> 7; \
        _Pragma("unroll") for (int m = 0; m < 4; ++m) { const int kj = 64 * m + (tid >> 3), pc = tid & 7; const int tok = 128 * (nb_ - 1) + kj; \
              \
            const bf16* rp = PB + ((size_t)b_ * SEQ + (tok < 0 ? tok + 128 : tok)) * B_N; kreg[m] = *(const v4u*)(rp + 1024 + 64 * kvh_ + 8 * pc); vreg[m] = *(const v4u*)(rp + 1280 + 64 * kvh_ + 8 * pc); } } while (0)
    if (vcu < 2048) B2_LOADKV(vcu);
    v4u rq[4] = {(v4u){0u, 0u, 0u, 0u}, (v4u){0u, 0u, 0u, 0u}, (v4u){0u, 0u, 0u, 0u}, (v4u){0u, 0u, 0u, 0u}};
#define B2_LOADQ(uu, qb_) do { const int nb_ = (uu) & 31, kvh_ = ((uu) >> 5) & 3, b_ = (uu) >> 7; \
        const bf16* qp_ = PB + ((size_t)b_ * SEQ + 128 * nb_ + 64 * (w & 1) + 32 * (qb_) + r32) * B_N + 64 * (4 * kvh_ + (w >> 1)) + 8 * hh; \
        _Pragma("unroll") for (int ks = 0; ks < 4; ++ks) rq[ks] = *(const v4u*)(qp_ + 16 * ks); } while (0)
    if (vcu < 2048) B2_LOADQ(vcu, 0);
    for (int u = vcu; u < 2048; u += G) {
        const int nb = u & 31, kvh = (u >> 5) & 3, b = u >> 7;
        const size_t rowbase = (size_t)b * SEQ;
        __syncthreads();
        {
            const f32x4 gk0 = *(const LAS f32x4*)(gT + 64 + 8 * (tid & 7)), gk1 = *(const LAS f32x4*)(gT + 64 + 8 * (tid & 7) + 4);
#pragma unroll
            for (int m = 0; m < 4; ++m) {
                const int kj = 64 * m + (tid >> 3), pc = tid & 7;
                const v4u kk = kreg[m], vv = vreg[m];
                float x[8] = {bflo(kk.x), bfhi(kk.x), bflo(kk.y), bfhi(kk.y), bflo(kk.z), bfhi(kk.z), bflo(kk.w), bfhi(kk.w)};
                float s = 0.f;
#pragma unroll
                for (int e = 0; e < 8; ++e) s += x[e] * x[e];
                s = xl::add4(xl::add2(xl::add1(s)));
                const float rs = 1.0f / sqrtf(s * (1.0f / 64.0f) + EPS);
                v4u ko; ko.x = cvtpk(x[0] * rs * gk0[0], x[1] * rs * gk0[1]); ko.y = cvtpk(x[2] * rs * gk0[2], x[3] * rs * gk0[3]); ko.z = cvtpk(x[4] * rs * gk1[0], x[5] * rs * gk1[1]); ko.w = cvtpk(x[6] * rs * gk1[2], x[7] * rs * gk1[3]);
                *(LAS v4u*)(Kl + kj * B2_KS + 16 * pc) = ko; *(LAS v4u*)(Vl + kj * B2_KS + 16 * pc) = vv;
            }
        }
        const int un = (u + G < 2048) ? u + G : u;
        B2_LOADKV(un);
        __syncthreads();
        const int hq = 4 * kvh + (w >> 1);
        const float sinkp = __builtin_amdgcn_exp2f(gT[128 + hq] * LOG2E);
#pragma unroll 1
        for (int qblk = 0; qblk < 2; ++qblk) {
            const int qs = 64 * (w & 1) + 32 * qblk;
            const int ql = qs + r32;
            bf16x8 qf[4];
            {
                float s = 0.f;
#pragma unroll
                for (int ks = 0; ks < 4; ++ks) {
                    const float a0 = bflo(rq[ks].x), a1 = bfhi(rq[ks].x), a2 = bflo(rq[ks].y), a3 = bfhi(rq[ks].y), a4 = bflo(rq[ks].z), a5 = bfhi(rq[ks].z), a6 = bflo(rq[ks].w), a7 = bfhi(rq[ks].w);
                    s += (a0 * a0 + a1 * a1) + (a2 * a2 + a3 * a3) + (a4 * a4 + a5 * a5) + (a6 * a6 + a7 * a7); }
                s = xl::add32(s);
                const float rs = QS / sqrtf(s * (1.0f / 64.0f) + EPS);
#pragma unroll
                for (int ks = 0; ks < 4; ++ks) {
                    const f32x4 g0 = *(const LAS f32x4*)(gT + 16 * ks + 8 * hh), g1 = *(const LAS f32x4*)(gT + 16 * ks + 8 * hh + 4);
                    v4u o; o.x = cvtpk(bflo(rq[ks].x) * rs * g0[0], bfhi(rq[ks].x) * rs * g0[1]); o.y = cvtpk(bflo(rq[ks].y) * rs * g0[2], bfhi(rq[ks].y) * rs * g0[3]);
                    o.z = cvtpk(bflo(rq[ks].z) * rs * g1[0], bfhi(rq[ks].z) * rs * g1[1]); o.w = cvtpk(bflo(rq[ks].w) * rs * g1[2], bfhi(rq[ks].w) * rs * g1[3]);
                    qf[ks] = __builtin_bit_cast(bf16x8, o);
                }
                asm volatile("" ::: "memory");
                if (qblk == 0) B2_LOADQ(u, 1); else B2_LOADQ(un, 0);
            }
            f32x16 o0 = {}, o1 = {}; float lsum = 0.f;
#pragma unroll 1
            for (int kt5 = 0; kt5 < 5; ++kt5) {
                const int kt = (qs >> 5) + kt5;
                if (nb == 0 && kt < 4) continue;
                bf16x8 ka[4]; bf16x8 vf0[2], vf1[2]; float bvv[16];
#pragma unroll
                for (int ks = 0; ks < 4; ++ks) ka[ks] = *(const LAS bf16x8*)(Kl + (32 * kt + r32) * B2_KS + (16 * ks + 8 * hh) * 2);
#pragma unroll
                for (int s = 0; s < 2; ++s) {
                    const ldsp va = Vl + (32 * kt + 16 * s + 4 * hh + (i16 >> 2)) * B2_KS + (16 * g16 + 4 * (i16 & 3)) * 2;
                    vf0[s] = cat8(lds_tr(va), lds_tr(va + 8 * B2_KS)); vf1[s] = cat8(lds_tr(va + 64), lds_tr(va + 8 * B2_KS + 64));
                }
#pragma unroll
                for (int r = 0; r < 16; ++r) { const int kj = 32 * kt + (r & 3) + 8 * (r >> 2) + 4 * hh; const int rel = ql + 128 - kj; bvv[r] = biasT[hq * 128 + (rel & 127)]; }
                __builtin_amdgcn_sched_barrier(0);
                f32x16 p = {};
#pragma unroll
                for (int ks = 0; ks < 4; ++ks) p = __builtin_amdgcn_mfma_f32_32x32x16_bf16(ka[ks], qf[ks], p, 0, 0, 0);
#pragma unroll
                for (int r = 0; r < 16; ++r) p[r] = __builtin_amdgcn_exp2f(p[r] + bvv[r]);
                if (kt5 == 0 || kt5 == 4) {
                    asm volatile("" ::: "memory");
#pragma unroll
                    for (int r = 0; r < 16; ++r) {
                        const int kj = 32 * kt + (r & 3) + 8 * (r >> 2) + 4 * hh; const int rel = ql + 128 - kj;
                        p[r] = ((rel >= 0) && (rel < 128)) ? p[r] : 0.f;
                    }
                }
#pragma unroll
                for (int r = 0; r < 16; ++r) lsum += p[r];
                v4u pw0, pw1;
                pw0.x = cvtpk(p[0], p[1]); pw0.y = cvtpk(p[2], p[3]); pw0.z = cvtpk(p[4], p[5]); pw0.w = cvtpk(p[6], p[7]);
                pw1.x = cvtpk(p[8], p[9]); pw1.y = cvtpk(p[10], p[11]); pw1.z = cvtpk(p[12], p[13]); pw1.w = cvtpk(p[14], p[15]);
                const bf16x8 pf0 = __builtin_bit_cast(bf16x8, pw0), pf1 = __builtin_bit_cast(bf16x8, pw1);
#pragma unroll
                for (int s = 0; s < 2; ++s) {
                    o0 = __builtin_amdgcn_mfma_f32_32x32x16_bf16(vf0[s], s == 0 ? pf0 : pf1, o0, 0, 0, 0);
                    o1 = __builtin_amdgcn_mfma_f32_32x32x16_bf16(vf1[s], s == 0 ? pf0 : pf1, o1, 0, 0, 0);
                }
            }
            lsum = xl::add32(lsum);
            const float il = 1.0f / (lsum + sinkp);
            bf16* op = O + (rowbase + 128 * nb + ql) * DM + 64 * hq + 8 * hh;
#define OUT16(acc, p_, il_, dst_) do { v4u w_; { const unsigned e0_ = cvtpk(acc[8 * (p_)] * il_, acc[8 * (p_) + 1] * il_), e1_ = cvtpk(acc[8 * (p_) + 2] * il_, acc[8 * (p_) + 3] * il_); \
            const unsigned d0_ = cvtpk(acc[8 * (p_) + 4] * il_, acc[8 * (p_) + 5] * il_), d1_ = cvtpk(acc[8 * (p_) + 6] * il_, acc[8 * (p_) + 7] * il_); \
              \
            const auto s0_ = __builtin_amdgcn_permlane32_swap(e0_, d0_, false, false); const auto s1_ = __builtin_amdgcn_permlane32_swap(e1_, d1_, false, false); \
            w_.x = s0_[0]; w_.y = s1_[0]; w_.z = s0_[1]; w_.w = s1_[1]; } *(v4u*)(dst_) = w_; } while (0)
#pragma unroll
            for (int p2 = 0; p2 < 2; ++p2) { OUT16(o0, p2, il, op + 16 * p2); OUT16(o1, p2, il, op + 32 + 16 * p2); }
#undef OUT16
        }
    }
    __syncthreads();
}
#undef B2_LOADKV
#undef B2_LOADQ

__device__ __forceinline__ void phase_cfin(bf16* Q, bf16* KV, const bf16* LAT, bf16* KR, const float* cs, const float* qgain, const float* kgain, int gw, int NGW, int wave) {
    const int lane = phase_tid(wave) & 63;
    const int hd = lane >> 2, sub = lane & 3;
    const float QS = 0.10206207261596575f * LOG2E;
    f32x4 gqn[4], gkn[4]; f32x4 gq1, gq2, gk1, gk2;
#pragma unroll
    for (int e = 0; e < 4; ++e) { gqn[e] = *(const f32x4*)(qgain + 16 * sub + 4 * e); gkn[e] = *(const f32x4*)(kgain + 16 * sub + 4 * e); }
    gq1 = *(const f32x4*)(qgain + 64 + 4 * sub); gq2 = *(const f32x4*)(qgain + 80 + 4 * sub); gk1 = *(const f32x4*)(kgain + 64 + 4 * sub); gk2 = *(const f32x4*)(kgain + 80 + 4 * sub);
    f32x4 csa_n = {}, csb_n = {}; v4u n0_n = (v4u){0u, 0u, 0u, 0u}, n1_n = (v4u){0u, 0u, 0u, 0u}; u32x2 t1_n = {0u, 0u}, t2_n = {0u, 0u};
#define CF_LOAD(tk) do { csa_n = *(const f32x4*)(cs + (size_t)(tk) * 32 + 8 * sub); csb_n = *(const f32x4*)(cs + (size_t)(tk) * 32 + 8 * sub + 4); \
        const bf16* np_ = KV + (size_t)(tk) * C_NKV + 128 * hd + 16 * sub; const bf16* r1p_ = LAT + (size_t)(tk) * C_N1 + 384 + 4 * sub; \
        n0_n = *(const v4u*)np_; n1_n = *(const v4u*)(np_ + 8); t1_n = *(const u32x2*)r1p_; t2_n = *(const u32x2*)(r1p_ + 16); } while (0)
    if (gw < NTOK) CF_LOAD(gw);
    for (int tok = gw; tok < NTOK; tok += NGW) {
        const f32x4 csa = csa_n, csb = csb_n;
        const float cv[4] = {csa[0], csa[2], csb[0], csb[2]}, sv[4] = {csa[1], csa[3], csb[1], csb[3]};
        v4u n0s[2], n1s[2]; u32x2 t1s[2], t2s[2];
        n0s[1] = n0_n; n1s[1] = n1_n; t1s[1] = t1_n; t2s[1] = t2_n;
        if (tok + NGW < NTOK) CF_LOAD(tok + NGW);
#pragma unroll
        for (int isk = 1; isk < 2; ++isk) {
            bf16* np = isk ? (KV + (size_t)tok * C_NKV + 128 * hd + 16 * sub) : (Q + (size_t)tok * C_NQ + 96 * hd + 16 * sub);
            const v4u n0 = n0s[isk], n1 = n1s[isk]; const u32x2 t1 = t1s[isk], t2 = t2s[isk];
            float x[16] = {bflo(n0.x), bfhi(n0.x), bflo(n0.y), bfhi(n0.y), bflo(n0.z), bfhi(n0.z), bflo(n0.w), bfhi(n0.w), bflo(n1.x), bfhi(n1.x), bflo(n1.y), bfhi(n1.y), bflo(n1.z), bfhi(n1.z), bflo(n1.w), bfhi(n1.w)};
            float a[4] = {bflo(t1.x), bfhi(t1.x), bflo(t1.y), bfhi(t1.y)}, c[4] = {bflo(t2.x), bfhi(t2.x), bflo(t2.y), bfhi(t2.y)};
            float s = 0.f;
#pragma unroll
            for (int e = 0; e < 16; ++e) s += x[e] * x[e];
#pragma unroll
            for (int e = 0; e < 4; ++e) s += a[e] * a[e] + c[e] * c[e];
            s = xl::add2(xl::add1(s));
            const float rs = (isk ? 1.0f : QS) / sqrtf(s * (1.0f / 96.0f) + EPS);
            v4u o0, o1;
            const f32x4* gn = isk ? gkn : gqn;
            o0.x = cvtpk(x[0] * rs * gn[0][0], x[1] * rs * gn[0][1]); o0.y = cvtpk(x[2] * rs * gn[0][2], x[3] * rs * gn[0][3]); o0.z = cvtpk(x[4] * rs * gn[1][0], x[5] * rs * gn[1][1]); o0.w = cvtpk(x[6] * rs * gn[1][2], x[7] * rs * gn[1][3]);
            o1.x = cvtpk(x[8] * rs * gn[2][0], x[9] * rs * gn[2][1]); o1.y = cvtpk(x[10] * rs * gn[2][2], x[11] * rs * gn[2][3]); o1.z = cvtpk(x[12] * rs * gn[3][0], x[13] * rs * gn[3][1]); o1.w = cvtpk(x[14] * rs * gn[3][2], x[15] * rs * gn[3][3]);
            const f32x4 g1 = isk ? gk1 : gq1, g2 = isk ? gk2 : gq2;
            float r1[4], r2[4];
#pragma unroll
            for (int e = 0; e < 4; ++e) { const float u1 = a[e] * rs * g1[e], u2 = c[e] * rs * g2[e]; r1[e] = u1 * cv[e] - u2 * sv[e]; r2[e] = u2 * cv[e] + u1 * sv[e]; }
            u32x2 w1, w2; w1.x = cvtpk(r1[0], r1[1]); w1.y = cvtpk(r1[2], r1[3]); w2.x = cvtpk(r2[0], r2[1]); w2.y = cvtpk(r2[2], r2[3]);
            *(v4u*)np = o0; *(v4u*)(np + 8) = o1;
            bf16* rop = isk ? (KR + (size_t)tok * 512 + 32 * hd + 4 * sub) : (Q + (size_t)tok * C_NQ + 96 * hd + 64 + 4 * sub);
            *(u32x2*)rop = w1; *(u32x2*)(rop + 16) = w2;
        }
    }
}

#undef CF_LOAD
constexpr int C3_KS = 208, C3_VS = 64, C3_VH = 4096 + 64, C3_KB = 64 * C3_KS, C3_VB = 2 * 4096 + 128, C3_K = 0, C3_V = 3 * C3_KB;
__device__ __forceinline__ void phase_c3(ldsp lds, const bf16* Q, const bf16* KV, const bf16* KR, bf16* O, const float* cs, const float* qgain, int vcu, int G, int wave) {
    const int tid = phase_tid(wave);
    const int lane = tid & 63, w = wave, r32 = lane & 31, hh = lane >> 5, g16 = (lane >> 4) & 1, i16 = lane & 15;
    const int srow = tid >> 3, spc = tid & 7, rrow = (tid >> 2) & 63, rpc = tid & 3;
    v4u po0 = (v4u){0u, 0u, 0u, 0u}, po1 = po0, po2 = po0, po3 = po0; char* pop = nullptr; unsigned poo = 0u;
#define C3_FLUSH() do { if (pop) { *(v4u*)(pop + poo) = po0; *(v4u*)(pop + poo + 64) = po1; *(v4u*)(pop + poo + 32) = po2; *(v4u*)(pop + poo + 96) = po3; pop = nullptr; } } while (0)
    for (int p = vcu; p < 2048; p += G) {
#pragma unroll 1
      for (int half = 0; half < 2; ++half) {
        const int bh = p >> 3, b = bh >> 4, h = bh & 15, qb = half ? 15 - (p & 7) : (p & 7);
        const size_t rowbase = (size_t)b * SEQ;
        const int NT = 4 * (qb + 1), tw = 4 * qb + (w >> 1);
        const bf16* kvb = KV + rowbase * C_NKV + 128 * h; const bf16* krb = KR + rowbase * 512 + 32 * h;
        v4u skA, svA, srA = (v4u){0u, 0u, 0u, 0u};
        const unsigned kvo = (unsigned)(srow * C_NKV + 8 * spc) * 2u, kro = (unsigned)(rrow * 512 + 8 * rpc) * 2u;
#define C3_LOAD(T, sk_, sv_, sr_) do { const char* kb_ = (const char*)(kvb + (size_t)(64 * (T)) * C_NKV); sk_ = *(const v4u*)(kb_ + kvo); sv_ = *(const v4u*)(kb_ + kvo + 128); \
            if (tid < 256) sr_ = *(const v4u*)((const char*)(krb + (size_t)(64 * (T)) * 512) + kro); } while (0)
#define C3_STORE(SLOT, sk_, sv_, sr_) do { *(LAS v4u*)(lds + C3_K + (SLOT) * C3_KB + srow * C3_KS + 16 * spc) = sk_; *(LAS v4u*)(lds + C3_V + (SLOT) * C3_VB + (spc >> 2) * C3_VH + srow * C3_VS + 16 * (spc & 3)) = sv_; \
            if (tid < 256) *(LAS v4u*)(lds + C3_K + (SLOT) * C3_KB + rrow * C3_KS + 128 + 16 * rpc) = sr_; } while (0)
        C3_LOAD(0, skA, svA, srA);
        bf16x8 qf[6];
        {
            const char* qp = (const char*)(Q + (rowbase + 256 * qb + 32 * w) * C_NQ + 96 * h); const unsigned qo = (unsigned)(r32 * C_NQ + 8 * hh) * 2u;
            v4u qr[6];
#pragma unroll
            for (int ks = 0; ks < 6; ++ks) qr[ks] = *(const v4u*)(qp + qo + 32 * ks);
            const float* csp = cs + (rowbase + 256 * qb + 32 * w + r32) * 32 + 16 * hh;
            f32x4 csv[4];
#pragma unroll
            for (int e = 0; e < 4; ++e) csv[e] = *(const f32x4*)(csp + 4 * e);
            C3_FLUSH();
            float x[6][8]; float ss = 0.f;
#pragma unroll
            for (int ks = 0; ks < 6; ++ks) {
                x[ks][0] = bflo(qr[ks].x); x[ks][1] = bfhi(qr[ks].x); x[ks][2] = bflo(qr[ks].y); x[ks][3] = bfhi(qr[ks].y);
                x[ks][4] = bflo(qr[ks].z); x[ks][5] = bfhi(qr[ks].z); x[ks][6] = bflo(qr[ks].w); x[ks][7] = bfhi(qr[ks].w);
#pragma unroll
                for (int e = 0; e < 8; ++e) ss += x[ks][e] * x[ks][e];
            }
            ss = xl::add32(ss);
            const float rs = (0.10206207261596575f * LOG2E) / sqrtf(ss * (1.0f / 96.0f) + EPS);
#pragma unroll
            for (int ks = 0; ks < 6; ++ks) {
                const f32x4 g0 = *(const f32x4*)(qgain + 16 * ks + 8 * hh), g1 = *(const f32x4*)(qgain + 16 * ks + 8 * hh + 4);
#pragma unroll
                for (int e = 0; e < 4; ++e) { x[ks][e] *= rs * g0[e]; x[ks][4 + e] *= rs * g1[e]; }
            }
#pragma unroll
            for (int e = 0; e < 8; ++e) { const float cc = csv[e >> 1][2 * (e & 1)], sn = csv[e >> 1][2 * (e & 1) + 1]; const float a = x[4][e], b2 = x[5][e]; x[4][e] = a * cc - b2 * sn; x[5][e] = b2 * cc + a * sn; }
#pragma unroll
            for (int ks = 0; ks < 6; ++ks) { v4u o; o.x = cvtpk(x[ks][0], x[ks][1]); o.y = cvtpk(x[ks][2], x[ks][3]); o.z = cvtpk(x[ks][4], x[ks][5]); o.w = cvtpk(x[ks][6], x[ks][7]); qf[ks] = __builtin_bit_cast(bf16x8, o); }
        }
        C3_STORE(0, skA, svA, srA);
        f32x16 o0 = {}, o1 = {}; float lsum = 0.f;
        const int qloc = 32 * w + r32;
        f32x16 s0 = {}, s1 = {};
#define C3_KF(ks_) *(const LAS bf16x8*)(Kb_ + r32 * C3_KS + (16 * (ks_) + 8 * hh) * 2)
#define C3_KG(ks_) *(const LAS bf16x8*)(Kb_ + (32 + r32) * C3_KS + (16 * (ks_) + 8 * hh) * 2)
#define C3_QK(SLOT, n0_, n1_) do { const ldsp Kb_ = lds + C3_K + (SLOT) * C3_KB; \
              \
            bf16x8 fa0_ = C3_KF(0), fa1_ = C3_KG(0), fa2_ = C3_KF(1), fa3_ = C3_KG(1); \
            bf16x8 fb0_ = C3_KF(2), fb1_ = C3_KG(2), fb2_ = C3_KF(3), fb3_ = C3_KG(3); \
            __builtin_amdgcn_sched_barrier(0); \
            n0_ = __builtin_amdgcn_mfma_f32_32x32x16_bf16(fa0_, qf[0], n0_, 0, 0, 0); n1_ = __builtin_amdgcn_mfma_f32_32x32x16_bf16(fa1_, qf[0], n1_, 0, 0, 0); \
            n0_ = __builtin_amdgcn_mfma_f32_32x32x16_bf16(fa2_, qf[1], n0_, 0, 0, 0); n1_ = __builtin_amdgcn_mfma_f32_32x32x16_bf16(fa3_, qf[1], n1_, 0, 0, 0); \
            __builtin_amdgcn_sched_barrier(0); \
            fa0_ = C3_KF(4); fa1_ = C3_KG(4); fa2_ = C3_KF(5); fa3_ = C3_KG(5); \
            __builtin_amdgcn_sched_barrier(0); \
            n0_ = __builtin_amdgcn_mfma_f32_32x32x16_bf16(fb0_, qf[2], n0_, 0, 0, 0); n1_ = __builtin_amdgcn_mfma_f32_32x32x16_bf16(fb1_, qf[2], n1_, 0, 0, 0); \
            n0_ = __builtin_amdgcn_mfma_f32_32x32x16_bf16(fb2_, qf[3], n0_, 0, 0, 0); n1_ = __builtin_amdgcn_mfma_f32_32x32x16_bf16(fb3_, qf[3], n1_, 0, 0, 0); \
            n0_ = __builtin_amdgcn_mfma_f32_32x32x16_bf16(fa0_, qf[4], n0_, 0, 0, 0); n1_ = __builtin_amdgcn_mfma_f32_32x32x16_bf16(fa1_, qf[4], n1_, 0, 0, 0); \
            n0_ = __builtin_amdgcn_mfma_f32_32x32x16_bf16(fa2_, qf[5], n0_, 0, 0, 0); n1_ = __builtin_amdgcn_mfma_f32_32x32x16_bf16(fa3_, qf[5], n1_, 0, 0, 0); } while (0)
#define C3_VA(ks_) (Vb_ + (16 * (ks_) + 4 * hh + (i16 >> 2)) * C3_VS + (16 * g16 + 4 * (i16 & 3)) * 2)
#define C3_V0(ks_) cat8(lds_tr(C3_VA(ks_)), lds_tr(C3_VA(ks_) + 8 * C3_VS))
#define C3_V1(ks_) cat8(lds_tr(C3_VA(ks_) + C3_VH), lds_tr(C3_VA(ks_) + 8 * C3_VS + C3_VH))
#define C3_SMPV(TT, SLOT) do { const ldsp Vb_ = lds + C3_V + (SLOT) * C3_VB; \
              \
            bf16x8 va0_ = C3_V0(0), va1_ = C3_V1(0), vb0_ = C3_V0(1), vb1_ = C3_V1(1), vc0_ = C3_V0(2), vc1_ = C3_V1(2), vd0_ = C3_V0(3), vd1_ = C3_V1(3);     \
            __builtin_amdgcn_sched_barrier(0); \
            _Pragma("unroll") for (int r = 0; r < 16; ++r) { \
                const float e0_ = __builtin_amdgcn_exp2f(s0[r]), e1_ = __builtin_amdgcn_exp2f(s1[r]);        \
                s0[r] = e0_; s1[r] = e1_; { float t_ = e0_ + e1_; asm volatile("" : "+v"(t_)); lsum += t_; asm volatile("" : "+v"(lsum)); } }     \
            v4u pw_[4]; \
            pw_[0].x = cvtpk(s0[0], s0[1]); pw_[0].y = cvtpk(s0[2], s0[3]); pw_[0].z = cvtpk(s0[4], s0[5]); pw_[0].w = cvtpk(s0[6], s0[7]); \
            pw_[1].x = cvtpk(s0[8], s0[9]); pw_[1].y = cvtpk(s0[10], s0[11]); pw_[1].z = cvtpk(s0[12], s0[13]); pw_[1].w = cvtpk(s0[14], s0[15]); \
            pw_[2].x = cvtpk(s1[0], s1[1]); pw_[2].y = cvtpk(s1[2], s1[3]); pw_[2].z = cvtpk(s1[4], s1[5]); pw_[2].w = cvtpk(s1[6], s1[7]); \
            pw_[3].x = cvtpk(s1[8], s1[9]); pw_[3].y = cvtpk(s1[10], s1[11]); pw_[3].z = cvtpk(s1[12], s1[13]); pw_[3].w = cvtpk(s1[14], s1[15]); \
            __builtin_amdgcn_sched_barrier(0); \
            o0 = __builtin_amdgcn_mfma_f32_32x32x16_bf16(va0_, __builtin_bit_cast(bf16x8, pw_[0]), o0, 0, 0, 0); o1 = __builtin_amdgcn_mfma_f32_32x32x16_bf16(va1_, __builtin_bit_cast(bf16x8, pw_[0]), o1, 0, 0, 0); \
            o0 = __builtin_amdgcn_mfma_f32_32x32x16_bf16(vb0_, __builtin_bit_cast(bf16x8, pw_[1]), o0, 0, 0, 0); o1 = __builtin_amdgcn_mfma_f32_32x32x16_bf16(vb1_, __builtin_bit_cast(bf16x8, pw_[1]), o1, 0, 0, 0); \
            o0 = __builtin_amdgcn_mfma_f32_32x32x16_bf16(vc0_, __builtin_bit_cast(bf16x8, pw_[2]), o0, 0, 0, 0); o1 = __builtin_amdgcn_mfma_f32_32x32x16_bf16(vc1_, __builtin_bit_cast(bf16x8, pw_[2]), o1, 0, 0, 0); \
            o0 = __builtin_amdgcn_mfma_f32_32x32x16_bf16(vd0_, __builtin_bit_cast(bf16x8, pw_[3]), o0, 0, 0, 0); o1 = __builtin_amdgcn_mfma_f32_32x32x16_bf16(vd1_, __builtin_bit_cast(bf16x8, pw_[3]), o1, 0, 0, 0); } while (0)
        int slot = 0, pslot = 2;
#pragma unroll 1
        for (int t2 = 0; t2 < NT; t2 += 2) {
#pragma unroll
          for (int par = 0; par < 2; ++par) {
            const int t = t2 + par;
            __syncthreads();
            if (t + 1 < NT) C3_LOAD(t + 1, skA, svA, srA);
            f32x16 n0 = {}, n1 = {};
            const bool doqk = (t <= tw), dopv = (t >= 1) && (t - 1 <= tw);
            if (t == tw) {
                asm volatile("" ::: "memory");
                const int kq = qloc - 64 * (t - 4 * qb) - 4 * hh;
#pragma unroll
                for (int r = 0; r < 16; ++r) { const int kl = (r & 3) + 8 * (r >> 2); n0[r] = (kl > kq) ? -1e30f : 0.f; n1[r] = (kl + 32 > kq) ? -1e30f : 0.f; }
            }
            if (doqk) C3_QK(slot, n0, n1);
            if (dopv) C3_SMPV(t - 1, pslot);
            s0 = n0; s1 = n1;
            const int nslot = (slot == 2) ? 0 : slot + 1;
            if (t + 1 < NT) C3_STORE(nslot, skA, svA, srA);
            pslot = slot; slot = nslot;
          }
        }
        if (NT - 1 <= tw) C3_SMPV(NT - 1, pslot);
#undef C3_QK
#undef C3_KF
#undef C3_KG
#undef C3_SMPV
#undef C3_VA
#undef C3_V0
#undef C3_V1
#undef C3_LOAD
#undef C3_STORE
        lsum = xl::add32(lsum);
        const float il = 1.0f / lsum;
        char* op = (char*)(O + (rowbase + 256 * qb + 32 * w) * DM + 64 * h); const unsigned oo = (unsigned)(r32 * DM + 8 * hh) * 2u;
#define OUT16(acc, p_, il_, dst_) do { v4u w_; { const unsigned e0_ = cvtpk(acc[8 * (p_)] * il_, acc[8 * (p_) + 1] * il_), e1_ = cvtpk(acc[8 * (p_) + 2] * il_, acc[8 * (p_) + 3] * il_); \
            const unsigned d0_ = cvtpk(acc[8 * (p_) + 4] * il_, acc[8 * (p_) + 5] * il_), d1_ = cvtpk(acc[8 * (p_) + 6] * il_, acc[8 * (p_) + 7] * il_); \
              \
            const auto s0_ = __builtin_amdgcn_permlane32_swap(e0_, d0_, false, false); const auto s1_ = __builtin_amdgcn_permlane32_swap(e1_, d1_, false, false); \
            w_.x = s0_[0]; w_.y = s1_[0]; w_.z = s0_[1]; w_.w = s1_[1]; } dst_ = w_; } while (0)
        OUT16(o0, 0, il, po0); OUT16(o1, 0, il, po1); OUT16(o0, 1, il, po2); OUT16(o1, 1, il, po3);
        pop = op; poo = oo;
#undef OUT16
        __syncthreads();
      }
    }
    C3_FLUSH();
}
#undef C3_FLUSH

#ifndef MK_SINGLE
#define MK_SINGLE 1
#endif
#ifndef DUPMASK
#define DUPMASK 0
#endif
#define REP(bit) _Pragma("unroll 1") for (int rep_ = 0; rep_ < 1 + ((DUPMASK >> (bit)) & 1); ++rep_)
struct Args { const float* in[24]; float* out; unsigned char* ws; int ph_lo, ph_hi; };

typedef __attribute__((address_space(4))) const Args* karg_t;
#define PH_BEGIN karg_t A_ = ap; int bx = bx0, G = G0, vcu = vcu0, gw = gw0, NGW = NGW0, wave = wave0; asm volatile("" : "+s"(A_), "+s"(bx), "+s"(G), "+s"(vcu), "+s"(gw), "+s"(NGW), "+s"(wave)); (void)bx; (void)G; (void)vcu; (void)gw; (void)NGW; unsigned char* const ws = A_->ws; unsigned char* const R = ws + WS_R; (void)R; \
    bf16* const xb = (bf16*)(ws + WS_XB); float* const ssq = (float*)(ws + WS_SSQ); float* const ssq2 = (float*)(ws + WS_SSQ2); (void)xb; (void)ssq; (void)ssq2;
__global__ void __launch_bounds__(NTHR, 2) mk_fwd(Args args) {
    extern __shared__ __attribute__((aligned(16))) unsigned char lds_raw[];
    const ldsp lds = (ldsp)lds_raw;
    const int tid0 = threadIdx.x, wave0 = __builtin_amdgcn_readfirstlane(tid0 >> 6);
    const int G0 = gridDim.x, bx0 = blockIdx.x;
    const int vcu0 = (G0 % 8 == 0) ? (bx0 % 8) * (G0 / 8) + bx0 / 8 : bx0;
    const int gw0 = vcu0 * NWAVES + wave0, NGW0 = G0 * NWAVES;
    const karg_t ap = (karg_t)__builtin_amdgcn_kernarg_segment_ptr();
    for (int u = tid0; u < (LDS_BYTES - LDSCTL_OFF) / 4; u += NTHR) ((LAS unsigned*)(lds + LDSCTL_OFF))[u] = 0u;
    __syncthreads();
    XcdBarrier bar; bar.bar = (unsigned*)(args.ws + WS_CTL) + CW_BAR; bar.x = 0; bar.st = nullptr;
    if (MK_SINGLE) bar = xcd_barrier_post((unsigned*)(args.ws + WS_CTL) + CW_BAR, (volatile LAS unsigned*)(lds + MISC_OFF + 32));
    const int lo = args.ph_lo, hi = args.ph_hi; int ph = 0;
#define RUN (lo <= ph && ph < hi)
#define SEAM() do { if (MK_SINGLE && lo <= ph && ph + 1 < hi) xcd_barrier(bar); ++ph; } while (0)

    if (RUN) REP(9) { PH_BEGIN Ptrs P; for (int i = 0; i < 24; ++i) P.in[i] = A_->in[i]; P.out = A_->out; P.ws = ws; prologue(P, lds, gw, NGW, wave); }
    SEAM();

#pragma unroll
    for (int L = 0; L < 4; ++L) {
        const int kind = L % 3;
        if (kind == 0) {
            const int ia = (L == 0) ? 0 : 1;
            if (RUN) REP(1) {
                PH_BEGIN
                pg8::Gemm g{xb, (const bf16*)(ws + WS_WAIN + (size_t)ia * (A_N * DM * 2)), NTOK, A_N, DM, DM, DM}; pg8::StaticOrder S; S.init(NTOK, A_N, G, bx);
                pg8::EpiScale<0, false> E{(bf16*)(R + R_PA), A_N, ssq, 0, 16, 1.0f / 1024.0f, nullptr, 0};
                pg8::gemm_phase<pg8::EpiScale<0, false>, pg8::StaticOrder, true, true>(lds, g, S, E, wave);
            }
            SEAM();
            if (RUN) REP(2) { PH_BEGIN phase_a2(lds, (bf16*)(R + R_PA), (unsigned*)(R + R_MASK), (f32x4*)(R + R_O) + (size_t)bx * 32768, (bf16*)(R + R_KN), (bf16*)(R + R_VN), A_->in[9] + ia * 64, vcu, G, wave); }
            SEAM();
            if (RUN) REP(3) { PH_BEGIN phase_a3(lds, (const bf16*)(R + R_PA), (const bf16*)(R + R_KN), (const bf16*)(R + R_VN), (const unsigned*)(R + R_MASK), (bf16*)(R + R_O), A_->in[8] + ia * 64, A_->in[2], gw, NGW, wave); }
            SEAM();
            if (RUN) {
                PH_BEGIN
                pg8::Gemm g{(const bf16*)(R + R_O), (const bf16*)(ws + WS_WAOUT + (size_t)ia * 2 * MiB), NTOK, DM, DM, DM, DM}; pg8::StaticOrder S; S.init(NTOK, DM, G, bx);
                pg8::EpiRes E{xb, ssq2, nullptr, 0, nullptr};
                pg8::gemm_phase<pg8::EpiRes, pg8::StaticOrder, true, true>(lds, g, S, E, wave);
            }
            SEAM();
        } else if (kind == 1) {
            if (RUN) REP(4) {
                PH_BEGIN
                pg8::Gemm g{xb, (const bf16*)(ws + WS_WBIN), NTOK, B_N, DM, DM, DM}; pg8::StaticOrder S; S.init(NTOK, B_N, G, bx);
                pg8::EpiScale<0, false> E{(bf16*)(R + R_PB), B_N, ssq, 0, 16, 1.0f / 1024.0f, nullptr, 0};
                pg8::gemm_phase<pg8::EpiScale<0, false>, pg8::StaticOrder, true, true>(lds, g, S, E, wave);
            }
            SEAM();
            if (RUN) REP(5) { PH_BEGIN phase_b2(lds, (const bf16*)(R + R_PB), (bf16*)(R + R_O), A_->in[12], A_->in[13], A_->in[14], A_->in[2], vcu, G, wave); }
            SEAM();
            if (RUN) {
                PH_BEGIN
                pg8::Gemm g{(const bf16*)(R + R_O), (const bf16*)(ws + WS_WBOUT), NTOK, DM, DM, DM, DM}; pg8::StaticOrder S; S.init(NTOK, DM, G, bx);
                pg8::EpiRes E{xb, ssq2, nullptr, 0, nullptr};
                pg8::gemm_phase<pg8::EpiRes, pg8::StaticOrder, true, true>(lds, g, S, E, wave);
            }
            SEAM();
        } else {
            if (RUN) REP(6) {
                PH_BEGIN
                pg8::Gemm g{xb, (const bf16*)(ws + WS_WCIN), NTOK, C_N1, DM, DM, DM}; pg8::StaticOrder S; S.init(NTOK, C_N1, G, bx);
                pg8::EpiScale<0, true> E{(bf16*)(R + R_LAT), C_N1, ssq, 0, 16, 1.0f / 1024.0f, (float*)(ws + WS_CSTAT), 0};
                pg8::gemm_phase<pg8::EpiScale<0, true>, pg8::StaticOrder, true, true>(lds, g, S, E, wave);
            }
            SEAM();
            if (RUN) REP(7) {
                { PH_BEGIN
                  pg8::Gemm g{(const bf16*)(R + R_LAT), (const bf16*)(ws + WS_WQB), NTOK, C_NQ, 256, C_N1, 256}; pg8::StaticOrder S; S.init(NTOK, C_NQ, G, bx);
                  pg8::EpiScale<0, false> E{(bf16*)(R + R_Q), C_NQ, (const float*)(ws + WS_CSTAT), 0, 8, 1.0f / 256.0f, nullptr, 0};
                  pg8::gemm_phase<pg8::EpiScale<0, false>, pg8::StaticOrder, true, true>(lds, g, S, E, wave); }
                __syncthreads();
                { PH_BEGIN
                  pg8::Gemm g{(const bf16*)(R + R_LAT) + 256, (const bf16*)(ws + WS_WKVB), NTOK, C_NKV, 128, C_N1, 128}; pg8::StaticOrder S; S.init(NTOK, C_NKV, G, bx);
                  pg8::EpiScale<0, false> E{(bf16*)(R + R_KV), C_NKV, (const float*)(ws + WS_CSTAT), 8, 4, 1.0f / 128.0f, nullptr, 0};
                  pg8::gemm_phase<pg8::EpiScale<0, false>, pg8::StaticOrder, true, true>(lds, g, S, E, wave); }
            }
            SEAM();
            if (RUN) { PH_BEGIN phase_cfin((bf16*)(R + R_Q), (bf16*)(R + R_KV), (const bf16*)(R + R_LAT), (bf16*)(R + R_KR), (const float*)(ws + WS_CS), A_->in[21], A_->in[22], gw, NGW, wave); }
            SEAM();
            if (RUN) REP(8) { PH_BEGIN phase_c3(lds, (const bf16*)(R + R_Q), (const bf16*)(R + R_KV), (const bf16*)(R + R_KR), (bf16*)(R + R_OC), (const float*)(ws + WS_CS), A_->in[21], vcu, G, wave); }
            SEAM();
            if (RUN) {
                PH_BEGIN
                pg8::Gemm g{(const bf16*)(R + R_OC), (const bf16*)(ws + WS_WCOUT), NTOK, DM, DM, DM, DM}; pg8::StaticOrder S; S.init(NTOK, DM, G, bx);
                pg8::EpiRes E{xb, ssq2, nullptr, 0, nullptr};
                pg8::gemm_phase<pg8::EpiRes, pg8::StaticOrder, true, true>(lds, g, S, E, wave);
            }
            SEAM();
        }
        if (RUN) REP(0) {
            PH_BEGIN
            pg8::Gemm g{xb, (const bf16*)(ws + WS_WUP + (size_t)L * 8 * MiB), NTOK, DFF, DM, DM, DM}; pg8::StaticOrder S; S.init(NTOK, DFF, G, bx);
            pg8::EpiSq E{(bf16*)(R + R_U), DFF};
            pg8::gemm_phase<pg8::EpiSq, pg8::StaticOrder, true, true>(lds, g, S, E, wave);
        }
        SEAM();
        if (RUN) REP(10) {
            PH_BEGIN
            pg8::Gemm g{(const bf16*)(R + R_U), (const bf16*)(ws + WS_WDN + (size_t)L * 8 * MiB), NTOK, DM, DFF, DFF, DFF}; pg8::StaticOrder S; S.init(NTOK, DM, G, bx); S.rev = (NTOK / 256 * 4) % G == 0;
            pg8::EpiRes E{xb, ssq, (L == 3) ? A_->out : (float*)nullptr, (((DUPMASK >> 10) & 1) && rep_ == 0) ? 1 : 0, ssq2};
            pg8::gemm_phase<pg8::EpiRes, pg8::StaticOrder, true, true>(lds, g, S, E, wave);
        }
        SEAM();
    }
#undef RUN
#undef SEAM
}

constexpr int N_PHASES = 1 + (4 + 2) + (3 + 2) + (5 + 2) + (4 + 2);

extern "C" void kernel_launch(void* const* d_in, const int* in_sizes, int n_in, void* d_out, int out_size, void* d_ws, size_t ws_size, hipStream_t stream) {
    static int grid = 0;
    if (grid == 0) {
        if (n_in != 24 || in_sizes[0] != NTOK * DM || out_size != NTOK * DM || ws_size < WS_END) {
            fprintf(stderr, "kernel_launch: unexpected problem shape (n_in %d, in0 %d, out %d, ws %zu < %zu); nothing launched\n", n_in, n_in > 0 ? in_sizes[0] : -1, out_size, ws_size, (size_t)WS_END); grid = -1; return; }
        int dev = 0, cus = 0, per_cu = 0;
        if (hipGetDevice(&dev) != hipSuccess || hipDeviceGetAttribute(&cus, hipDeviceAttributeMultiprocessorCount, dev) != hipSuccess) { grid = -1; return; }
        if (hipFuncSetAttribute((const void*)mk_fwd, hipFuncAttributeMaxDynamicSharedMemorySize, LDS_BYTES) != hipSuccess) { fprintf(stderr, "kernel_launch: hipFuncSetAttribute failed\n"); grid = -1; return; }
        if (hipOccupancyMaxActiveBlocksPerMultiprocessor(&per_cu, (const void*)mk_fwd, NTHR, LDS_BYTES) != hipSuccess || per_cu < 1)
            fprintf(stderr, "kernel_launch: note: occupancy query reports %d workgroups per CU\n", per_cu);
        (void)hipGetLastError();
        grid = cus;
    }
    if (grid < 0) return;
    if (hipMemsetAsync((char*)d_ws + WS_CTL, 0, CTL_ZERO_BYTES, stream) != hipSuccess) return;
    Args a{};
    for (int i = 0; i < 24; ++i) a.in[i] = (const float*)d_in[i];
    a.out = (float*)d_out; a.ws = (unsigned char*)d_ws;
#if MK_SINGLE
    a.ph_lo = 0; a.ph_hi = N_PHASES;
    hipLaunchKernelGGL(mk_fwd, dim3(grid), dim3(NTHR), LDS_BYTES, stream, a);
#else
    for (int k = 0; k < N_PHASES; ++k) { a.ph_lo = k; a.ph_hi = k + 1; hipLaunchKernelGGL(mk_fwd, dim3(grid), dim3(NTHR), LDS_BYTES, stream, a); }
#endif
}
```
